# Optimizing an MI355X kernel written in HIP

```python
import math
import jax, jax.numpy as jnp
from jax import lax
import numpy as np


D_MODEL = 2048
BATCH = 4
SEQ = 4096
DEPTH = 2

GRID_W = 64
CTX_LEN = 256
HEAD_DIM = 128
EPS = 1e-6
NEG_INF = -1e30

FOURIER_GROUPS = 4
FOURIER_WIDTH = D_MODEL // 4
FOURIER_GROUP_DIM = FOURIER_WIDTH // FOURIER_GROUPS
NA_HEADS = (D_MODEL - FOURIER_WIDTH) // HEAD_DIM
NA_WIDTH = NA_HEADS * HEAD_DIM
NA_WIN_H = 8
NA_WIN_W = 16
NA_KEY_W = 2 * NA_WIN_W
EVEN_IN = FOURIER_WIDTH + 3 * NA_WIDTH

POOL_WINDOWS = (2, 4, 8, 16)
POOL_GROUPS = 4
POOL_WIDTH = D_MODEL // 4
POOL_GROUP_DIM = POOL_WIDTH // POOL_GROUPS
MLA_HEADS = (D_MODEL - POOL_WIDTH) // HEAD_DIM
Q_LORA_RANK = 768
KV_LORA_RANK = 512
QK_NOPE_DIM = 128
QK_ROPE_DIM = 64
V_HEAD_DIM = 128
ODD_IN = POOL_WIDTH + Q_LORA_RANK + KV_LORA_RANK + QK_ROPE_DIM
ROPE_BASE = 10000.0
ATTN_BLOCK = 128

D_FF = -(-8 * D_MODEL // (3 * 256)) * 256

N_EVEN = (DEPTH + 1) // 2
N_ODD = DEPTH // 2

kernel_name = 'hybrid_fourier_natten_pool_mla_dit'


def rmsnorm(x, g):
    xf = x.astype(jnp.float32)
    y = xf * lax.rsqrt(jnp.mean(xf * xf, axis=-1, keepdims=True) + EPS)
    return (y * g.astype(jnp.float32)).astype(x.dtype)


def modulate(h, shift, scale):
    return h * (1.0 + scale) + shift


def swiglu(h, wg, wu, wd):
    return (jax.nn.silu(h @ wg) * (h @ wu)) @ wd


def rope_2d(x):
    n = x.shape[1]
    t = jnp.arange(n)
    half = QK_ROPE_DIM // 2
    nf = half // 2
    inv = ROPE_BASE ** (-jnp.arange(nf, dtype=jnp.float32) / nf)

    def rot(xa, pos):
        ang = pos.astype(jnp.float32)[:, None] * inv[None, :]
        cos = jnp.cos(ang)[None, :, None, :]
        sin = jnp.sin(ang)[None, :, None, :]
        x1 = xa[..., :nf].astype(jnp.float32)
        x2 = xa[..., nf:].astype(jnp.float32)
        return jnp.concatenate([x1 * cos - x2 * sin, x1 * sin + x2 * cos], axis=-1)

    out = jnp.concatenate([rot(x[..., :half], t // GRID_W), rot(x[..., half:], t % GRID_W)], axis=-1)
    return out.astype(x.dtype)


def fourier_mix(u, w_four):
    b, n, _ = u.shape
    ug = u.reshape(b, n, FOURIER_GROUPS, FOURIER_GROUP_DIM).astype(jnp.float32)
    f = jnp.fft.fft2(ug, axes=(1, 3), norm='ortho').real.astype(u.dtype)
    y = jnp.einsum('bngc,gcd->bngd', f, w_four)
    return y.reshape(b, n, FOURIER_WIDTH)


def pool_mix(u, w_pool, pool_scale):
    b, n, _ = u.shape
    ug = u.reshape(b, n, POOL_GROUPS, POOL_GROUP_DIM)
    cs = jnp.concatenate([jnp.zeros((b, 1, POOL_GROUPS, POOL_GROUP_DIM), jnp.float32),
                          jnp.cumsum(ug.astype(jnp.float32), axis=1)], axis=1)
    t = jnp.arange(n)
    outs = []
    for g, w in enumerate(POOL_WINDOWS):
        lo = jnp.maximum(t - w // 2, 0)
        hi = jnp.minimum(t + w // 2, n)
        s = cs[:, hi, g] - cs[:, lo, g]
        cnt = (hi - lo).astype(jnp.float32)[None, :, None]
        outs.append(s / cnt - ug[:, :, g].astype(jnp.float32))
    p = jnp.stack(outs, axis=2).astype(u.dtype)
    y = jnp.einsum('bngc,gcd->bngd', p, w_pool).reshape(b, n, POOL_WIDTH)
    return y * pool_scale


def dense_ctx_attention(q, k, v):
    b, l, h, _ = q.shape
    s = jnp.einsum('bqhd,bkhd->bhqk', q, k).astype(jnp.float32) * (q.shape[-1] ** -0.5)
    p = jax.nn.softmax(s, axis=-1).astype(v.dtype)
    return jnp.einsum('bhqk,bkhd->bqhd', p, v).reshape(b, l, h * v.shape[-1])


def dense_block_attention(q, k_all, v_all):
    b, n, h, dq = q.shape
    dv = v_all.shape[-1]
    scale = dq ** -0.5
    qb = jnp.moveaxis(q.reshape(b, n // ATTN_BLOCK, ATTN_BLOCK, h, dq), 1, 0)

    def blk(qi):
        s = jnp.einsum('bqhd,bkhd->bhqk', qi, k_all).astype(jnp.float32) * scale
        p = jax.nn.softmax(s, axis=-1).astype(v_all.dtype)
        return jnp.einsum('bhqk,bkhd->bqhd', p, v_all)

    o = lax.map(blk, qb)
    return jnp.moveaxis(o, 0, 1).reshape(b, n, h * dv)


def neighbourhood_attention(q, k, v, kc, vc, rpb):
    b, n, h, d = q.shape
    rows = n // GRID_W
    kh = min(NA_WIN_H, rows)
    n_cb = GRID_W // NA_WIN_W
    scale = d ** -0.5
    qg = q.reshape(b, rows, GRID_W, h, d)
    kg = k.reshape(b, rows, GRID_W, h, d)
    vg = v.reshape(b, rows, GRID_W, h, d)
    qcol = np.arange(n_cb)[:, None] * NA_WIN_W + np.arange(NA_WIN_W)[None, :]
    kstart = np.clip(np.arange(n_cb) * NA_WIN_W - NA_WIN_W // 2, 0, GRID_W - NA_KEY_W)
    kcol = kstart[:, None] + np.arange(NA_KEY_W)[None, :]
    cstart = np.clip(qcol - NA_WIN_W // 2, 0, GRID_W - NA_WIN_W)
    col_mask = jnp.asarray((kcol[:, None, :] >= cstart[..., None]) & (kcol[:, None, :] < cstart[..., None] + NA_WIN_W))
    col_idx = jnp.asarray(np.clip(kcol[:, None, :] - qcol[..., None] + NA_WIN_W - 1, 0, 2 * NA_WIN_W - 2))
    kcol_flat = kcol.reshape(-1)

    def row_block(r):
        rs = jnp.clip(r - kh // 2, 0, rows - kh)
        q_r = lax.dynamic_index_in_dim(qg, r, axis=1, keepdims=False).reshape(b, n_cb, NA_WIN_W, h, d)
        k_r = lax.dynamic_slice_in_dim(kg, rs, kh, axis=1)[:, :, kcol_flat].reshape(b, kh, n_cb, NA_KEY_W, h, d)
        v_r = lax.dynamic_slice_in_dim(vg, rs, kh, axis=1)[:, :, kcol_flat].reshape(b, kh, n_cb, NA_KEY_W, h, d)
        s_loc = jnp.einsum('bjqhd,brjkhd->bhjqrk', q_r, k_r).astype(jnp.float32) * scale
        row_idx = rs + jnp.arange(kh) - r + NA_WIN_H - 1
        bias = rpb[:, row_idx[:, None, None, None], col_idx[None]]
        bias = jnp.transpose(bias, (0, 2, 3, 1, 4)).astype(jnp.float32)
        s_loc = jnp.where(col_mask[:, :, None, :], s_loc + bias, NEG_INF)
        s_loc = s_loc.reshape(b, h, n_cb, NA_WIN_W, kh * NA_KEY_W)
        s_ctx = jnp.einsum('bjqhd,blhd->bhjql', q_r, kc).astype(jnp.float32) * scale
        p = jax.nn.softmax(jnp.concatenate([s_loc, s_ctx], axis=-1), axis=-1)
        p_loc = p[..., :kh * NA_KEY_W].reshape(b, h, n_cb, NA_WIN_W, kh, NA_KEY_W).astype(v.dtype)
        p_ctx = p[..., kh * NA_KEY_W:].astype(v.dtype)
        o = jnp.einsum('bhjqrk,brjkhd->bjqhd', p_loc, v_r) + jnp.einsum('bhjql,blhd->bjqhd', p_ctx, vc)
        return o.reshape(b, GRID_W, h, d)

    o = lax.map(row_block, jnp.arange(rows))
    return jnp.moveaxis(o, 0, 1).reshape(b, n, h * d)


def mla_queries(cq_raw, g_q, w_uq, rotate):
    b, n, _ = cq_raw.shape
    q = (rmsnorm(cq_raw, g_q) @ w_uq).reshape(b, n, MLA_HEADS, QK_NOPE_DIM + QK_ROPE_DIM)
    if rotate:
        q = jnp.concatenate([q[..., :QK_NOPE_DIM], rope_2d(q[..., QK_NOPE_DIM:])], axis=-1)
    return q


def mla_keys_values(ckv_raw, k_rope, g_kv, w_ukv, rotate):
    b, n, _ = ckv_raw.shape
    kv = (rmsnorm(ckv_raw, g_kv) @ w_ukv).reshape(b, n, MLA_HEADS, QK_NOPE_DIM + V_HEAD_DIM)
    k_nope, v = kv[..., :QK_NOPE_DIM], kv[..., QK_NOPE_DIM:]
    kr = k_rope[:, :, None, :]
    if rotate:
        kr = rope_2d(kr)
    k = jnp.concatenate([k_nope, jnp.broadcast_to(kr, (b, n, MLA_HEADS, QK_ROPE_DIM))], axis=-1)
    return k, v


def even_mixer(h, hc, w_in, w_four, rpb, w_out, with_ctx_out):
    b, n, _ = h.shape
    lc = hc.shape[1]
    p = h @ w_in
    u = p[..., :FOURIER_WIDTH]
    q, k, v = jnp.split(p[..., FOURIER_WIDTH:], 3, axis=-1)
    q = q.reshape(b, n, NA_HEADS, HEAD_DIM)
    k = k.reshape(b, n, NA_HEADS, HEAD_DIM)
    v = v.reshape(b, n, NA_HEADS, HEAD_DIM)
    if with_ctx_out:
        pc = hc @ w_in
        uc = pc[..., :FOURIER_WIDTH]
        qc, kc, vc = jnp.split(pc[..., FOURIER_WIDTH:], 3, axis=-1)
        qc = qc.reshape(b, lc, NA_HEADS, HEAD_DIM)
    else:
        kc, vc = jnp.split(hc @ w_in[:, FOURIER_WIDTH + NA_WIDTH:], 2, axis=-1)
    kc = kc.reshape(b, lc, NA_HEADS, HEAD_DIM)
    vc = vc.reshape(b, lc, NA_HEADS, HEAD_DIM)
    y = jnp.concatenate([fourier_mix(u, w_four), neighbourhood_attention(q, k, v, kc, vc, rpb)], axis=-1) @ w_out
    yc = None
    if with_ctx_out:
        yc = jnp.concatenate([fourier_mix(uc, w_four), dense_ctx_attention(qc, kc, vc)], axis=-1) @ w_out
    return y, yc


def odd_mixer(h, hc, w_in, w_pool, pool_scale, g_q, g_kv, w_uq, w_ukv, w_out, with_ctx_out):
    o_q = POOL_WIDTH
    o_kv = o_q + Q_LORA_RANK
    o_kr = o_kv + KV_LORA_RANK
    p = h @ w_in
    q = mla_queries(p[..., o_q:o_kv], g_q, w_uq, True)
    k, v = mla_keys_values(p[..., o_kv:o_kr], p[..., o_kr:], g_kv, w_ukv, True)
    if with_ctx_out:
        pc = hc @ w_in
        pc_kv = pc[..., o_kv:]
    else:
        pc_kv = hc @ w_in[:, o_kv:]
    kc, vc = mla_keys_values(pc_kv[..., :KV_LORA_RANK], pc_kv[..., KV_LORA_RANK:], g_kv, w_ukv, False)
    attn = dense_block_attention(q, jnp.concatenate([kc, k], axis=1), jnp.concatenate([vc, v], axis=1))
    y = jnp.concatenate([pool_mix(p[..., :o_q], w_pool, pool_scale), attn], axis=-1) @ w_out
    yc = None
    if with_ctx_out:
        qc = mla_queries(pc[..., o_q:o_kv], g_q, w_uq, False)
        yc = jnp.concatenate([pool_mix(pc[..., :o_q], w_pool, pool_scale), dense_ctx_attention(qc, kc, vc)], axis=-1) @ w_out
    return y, yc


def setup_inputs(seed: int = 0) -> dict:
    key = jax.random.key(seed)
    ks = jax.random.split(key, 24)
    f32 = jnp.float32

    def nrm(k, shape, scale):
        return jax.random.normal(k, shape, f32) * scale

    def gain(k, shape):
        return 1.0 + 0.02 * jax.random.normal(k, shape, f32)

    return {
        'x': nrm(ks[0], (BATCH, SEQ, D_MODEL), 1.0),
        'c': nrm(ks[1], (BATCH, D_MODEL), 1.0),
        'ctx': nrm(ks[2], (BATCH, CTX_LEN, D_MODEL), 1.0),
        'c_ctx': nrm(ks[3], (D_MODEL,), 1.0),
        'w_mod': nrm(ks[4], (DEPTH, D_MODEL, 6 * D_MODEL), 0.5 * D_MODEL ** -0.5),
        'b_mod': nrm(ks[5], (DEPTH, 6 * D_MODEL), 0.01),
        'norm1_g': gain(ks[6], (DEPTH, D_MODEL)),
        'norm2_g': gain(ks[7], (DEPTH, D_MODEL)),
        'w_in_ab': nrm(ks[8], (N_EVEN, D_MODEL, EVEN_IN), D_MODEL ** -0.5),
        'w_four': nrm(ks[9], (N_EVEN, FOURIER_GROUPS, FOURIER_GROUP_DIM, FOURIER_GROUP_DIM), FOURIER_GROUP_DIM ** -0.5),
        'na_rpb': nrm(ks[10], (N_EVEN, NA_HEADS, 2 * NA_WIN_H - 1, 2 * NA_WIN_W - 1), 0.1),
        'w_out_ab': nrm(ks[11], (N_EVEN, D_MODEL, D_MODEL), D_MODEL ** -0.5),
        'w_in_cd': nrm(ks[12], (N_ODD, D_MODEL, ODD_IN), D_MODEL ** -0.5),
        'w_pool': nrm(ks[13], (N_ODD, POOL_GROUPS, POOL_GROUP_DIM, POOL_GROUP_DIM), POOL_GROUP_DIM ** -0.5),
        'pool_scale': 1.0 + 0.1 * jax.random.normal(ks[14], (N_ODD, POOL_WIDTH), f32),
        'mla_gq': gain(ks[15], (N_ODD, Q_LORA_RANK)),
        'mla_gkv': gain(ks[16], (N_ODD, KV_LORA_RANK)),
        'w_uq': nrm(ks[17], (N_ODD, Q_LORA_RANK, MLA_HEADS * (QK_NOPE_DIM + QK_ROPE_DIM)), Q_LORA_RANK ** -0.5),
        'w_ukv': nrm(ks[18], (N_ODD, KV_LORA_RANK, MLA_HEADS * (QK_NOPE_DIM + V_HEAD_DIM)), KV_LORA_RANK ** -0.5),
        'w_out_cd': nrm(ks[19], (N_ODD, D_MODEL, D_MODEL), D_MODEL ** -0.5),
        'w_ffn_gate': nrm(ks[20], (DEPTH, D_MODEL, D_FF), D_MODEL ** -0.5),
        'w_ffn_up': nrm(ks[21], (DEPTH, D_MODEL, D_FF), D_MODEL ** -0.5),
        'w_ffn_down': nrm(ks[22], (DEPTH, D_FF, D_MODEL), D_FF ** -0.5),
        'final_g': gain(ks[23], (D_MODEL,)),
    }


def reference(x, c, ctx, c_ctx, w_mod, b_mod, norm1_g, norm2_g, w_in_ab, w_four, na_rpb, w_out_ab,
              w_in_cd, w_pool, pool_scale, mla_gq, mla_gkv, w_uq, w_ukv, w_out_cd,
              w_ffn_gate, w_ffn_up, w_ffn_down, final_g):
    silu_c = jax.nn.silu(c)
    silu_cc = jax.nn.silu(c_ctx)
    xc = ctx
    for l in range(DEPTH):
        last = l == DEPTH - 1
        mod = (silu_c @ w_mod[l] + b_mod[l])[:, None, :]
        modc = (silu_cc @ w_mod[l] + b_mod[l])[None, None, :]
        sh1, sc1, g1, sh2, sc2, g2 = jnp.split(mod, 6, axis=-1)
        csh1, csc1, cg1, csh2, csc2, cg2 = jnp.split(modc, 6, axis=-1)
        h = modulate(rmsnorm(x, norm1_g[l]), sh1, sc1)
        hc = modulate(rmsnorm(xc, norm1_g[l]), csh1, csc1)
        i = l // 2
        if l % 2 == 0:
            y, yc = even_mixer(h, hc, w_in_ab[i], w_four[i], na_rpb[i], w_out_ab[i], not last)
        else:
            y, yc = odd_mixer(h, hc, w_in_cd[i], w_pool[i], pool_scale[i], mla_gq[i], mla_gkv[i],
                              w_uq[i], w_ukv[i], w_out_cd[i], not last)
        x = x + g1 * y
        x = x + g2 * swiglu(modulate(rmsnorm(x, norm2_g[l]), sh2, sc2), w_ffn_gate[l], w_ffn_up[l], w_ffn_down[l])
        if not last:
            xc = xc + cg1 * yc
            xc = xc + cg2 * swiglu(modulate(rmsnorm(xc, norm2_g[l]), csh2, csc2), w_ffn_gate[l], w_ffn_up[l], w_ffn_down[l])
    return rmsnorm(x, final_g)
```

```cpp
#include <hip/hip_runtime.h>
#include <hip/hip_cooperative_groups.h>
#include <cstdio>
#include <cstdint>
namespace cg = cooperative_groups;

typedef _Float16 h16;
typedef _Float16 h16x8 __attribute__((ext_vector_type(8)));
typedef _Float16 h16x4 __attribute__((ext_vector_type(4)));
typedef float f32x16 __attribute__((ext_vector_type(16)));
typedef float f32x4 __attribute__((ext_vector_type(4)));

#define DEVI __device__ __forceinline__

#ifndef SINGLE_LAUNCH
#define SINGLE_LAUNCH 1
#endif
#ifndef REPEAT_MASK
#define REPEAT_MASK 0x0
#endif

constexpr int DM = 2048;
constexpr int TL = 16384;
constexpr int TC = 1024;
constexpr int TA = 17408;
constexpr int DFF = 5632;
constexpr int NPHASE = 18;

constexpr size_t SZ_WT_IN_AB = (size_t)5632 * 2048 * 2;
constexpr size_t SZ_WT_OUT = (size_t)2048 * 2048 * 2;
constexpr size_t SZ_WT_GU = (size_t)11264 * 2048 * 2;
constexpr size_t SZ_WT_D = (size_t)2048 * 5632 * 2;
constexpr size_t SZ_WT_IN_CD = (size_t)2048 * 2048 * 2;
constexpr size_t SZ_WT_UQ = (size_t)2304 * 768 * 2;
constexpr size_t SZ_WT_UKV = (size_t)3072 * 512 * 2;
constexpr size_t SZ_DFTA = (size_t)4096 * 8192 * 2;
constexpr size_t SZ_DFTAC = (size_t)256 * 512 * 2;
constexpr size_t SZ_MOD = (size_t)2 * 5 * 12288 * 4;
constexpr size_t SZ_XRES = (size_t)TA * 2048 * 4;
constexpr size_t SZ_H = (size_t)TA * 2048 * 2;
constexpr size_t SZ_CAT = (size_t)TA * 2048 * 2;
constexpr size_t SZ_BIG = (size_t)TA * 5632 * 2;

constexpr size_t OFF_WT_IN_AB = 0;
constexpr size_t OFF_WT_OUT_AB = OFF_WT_IN_AB + SZ_WT_IN_AB;
constexpr size_t OFF_WT_GU0 = OFF_WT_OUT_AB + SZ_WT_OUT;
constexpr size_t OFF_WT_GU1 = OFF_WT_GU0 + SZ_WT_GU;
constexpr size_t OFF_WT_D0 = OFF_WT_GU1 + SZ_WT_GU;
constexpr size_t OFF_WT_D1 = OFF_WT_D0 + SZ_WT_D;
constexpr size_t OFF_WT_IN_CD = OFF_WT_D1 + SZ_WT_D;
constexpr size_t OFF_WT_UQ = OFF_WT_IN_CD + SZ_WT_IN_CD;
constexpr size_t OFF_WT_UKV = OFF_WT_UQ + SZ_WT_UQ;
constexpr size_t OFF_WT_OUT_CD = OFF_WT_UKV + SZ_WT_UKV;
constexpr size_t OFF_DFTA = OFF_WT_OUT_CD + SZ_WT_OUT;
constexpr size_t OFF_DFTAC = OFF_DFTA + SZ_DFTA;
constexpr size_t OFF_MOD = OFF_DFTAC + SZ_DFTAC;
constexpr size_t OFF_XRES = OFF_MOD + SZ_MOD;
constexpr size_t OFF_H = OFF_XRES + SZ_XRES;
constexpr size_t OFF_CAT = OFF_H + SZ_H;
constexpr size_t OFF_BIG = OFF_CAT + SZ_CAT;
constexpr size_t OFF_CTR = OFF_BIG + SZ_BIG;
constexpr size_t OFF_BAR = OFF_CTR + 256;
constexpr size_t BAR_BYTES = 16384;
constexpr size_t WS_NEEDED = OFF_BAR + BAR_BYTES;

constexpr size_t OFF_Q0 = OFF_BIG;
constexpr size_t OFF_K0 = OFF_Q0 + (size_t)TA * 1536 * 2;
constexpr size_t OFF_VT0 = OFF_K0 + (size_t)TA * 1536 * 2;
constexpr size_t OFF_VCT0 = OFF_VT0 + (size_t)48 * 128 * 4096 * 2;
constexpr size_t OFF_UCT = OFF_VCT0 + (size_t)48 * 128 * 256 * 2;
constexpr size_t OFF_UCTC = OFF_UCT + (size_t)2048 * 8192 * 2;
static_assert(OFF_UCTC + (size_t)2048 * 512 * 2 <= OFF_BIG + SZ_BIG, "layer0 scratch overflow");
constexpr size_t OFF_P1 = OFF_BIG;
constexpr size_t OFF_CQN = OFF_P1 + (size_t)TA * 2048 * 2;
constexpr size_t OFF_CKVN = OFF_CQN + (size_t)TL * 768 * 2;
constexpr size_t OFF_KR = OFF_CKVN + (size_t)TA * 512 * 2;
constexpr size_t OFF_Q1 = OFF_KR + (size_t)4 * 4352 * 64 * 2;
static_assert(OFF_Q1 + (size_t)TL * 2304 * 2 <= OFF_BIG + SZ_BIG, "layer1 scratch overflow");
constexpr size_t OFF_KN = OFF_H;
constexpr size_t OFF_VT1 = OFF_DFTA;
static_assert((size_t)4 * 4352 * 1536 * 2 <= SZ_H, "kn alias");
static_assert((size_t)48 * 128 * 4352 * 2 <= SZ_DFTA, "vt1 alias");

struct Params {
  const float *x, *c, *ctx, *c_ctx, *w_mod, *b_mod, *norm1_g, *norm2_g, *w_in_ab, *w_four, *na_rpb, *w_out_ab;
  const float *w_in_cd, *w_pool, *pool_scale, *mla_gq, *mla_gkv, *w_uq, *w_ukv, *w_out_cd;
  const float *w_ffn_gate, *w_ffn_up, *w_ffn_down, *final_g;
  float* out;
  char* ws;
};

constexpr int NTHR = 512;
constexpr int SMEM_BYTES = 147456;

__shared__ uint4 g_sh[2];
__device__ __forceinline__ int lbid() { return (int)g_sh[1].x; }
DEVI f32x16 mfma32(h16x8 a, h16x8 b, f32x16 c) { return __builtin_amdgcn_mfma_f32_32x32x16_f16(a, b, c, 0, 0, 0); }
DEVI f32x4 mfma16(h16x8 a, h16x8 b, f32x4 c) { return __builtin_amdgcn_mfma_f32_16x16x32_f16(a, b, c, 0, 0, 0); }
DEVI int tidx() { int t = threadIdx.x; asm volatile("" : "+v"(t)); return t; }
DEVI float wave_sum(float v) {
#pragma unroll
  for (int o = 32; o >= 1; o >>= 1) v += __shfl_xor(v, o);
  return v;
}
DEVI float fexp2(float x) { return __builtin_amdgcn_exp2f(x); }
DEVI float cos_rev(float r) { return __builtin_amdgcn_cosf(r); }
DEVI float sin_rev(float r) { return __builtin_amdgcn_sinf(r); }
DEVI float silu_f(float v) { return v * __builtin_amdgcn_rcpf(1.0f + __builtin_amdgcn_exp2f(-1.4426950408889634f * v)); }
DEVI float4 ld4f(const float* p) { return *(const float4*)p; }
DEVI float4 ldnt4(const float* p) { const f32x4 v = __builtin_nontemporal_load((const f32x4*)p); return make_float4(v[0], v[1], v[2], v[3]); }
DEVI void stnt4(float* p, const float4& v) { f32x4 t; t[0] = v.x; t[1] = v.y; t[2] = v.z; t[3] = v.w; __builtin_nontemporal_store(t, (f32x4*)p); }
DEVI float4 ld4f(const h16* p) { const h16x4 v = *(const h16x4*)p; return make_float4((float)v[0], (float)v[1], (float)v[2], (float)v[3]); }
DEVI void store_h8(h16* dst, const f32x4& a, const f32x4& b, float sc = 1.0f) {
  h16x8 v;
#pragma unroll
  for (int j = 0; j < 4; ++j) { v[j] = (h16)(a[j] * sc); v[4 + j] = (h16)(b[j] * sc); }
  *(h16x8*)dst = v;
}
DEVI void store_h4(h16* dst, float a, float b, float c, float d) {
  h16x4 v;
  v[0] = (h16)a; v[1] = (h16)b; v[2] = (h16)c; v[3] = (h16)d;
  *(h16x4*)dst = v;
}

#define LAS __attribute__((address_space(3)))
namespace g8 {
constexpr int BM = 256, BK = 64, HALF = 128, HTB = HALF * BK * 2, NXCD = 8, WGM = 8;
DEVI int lds_byte(int r, int c) { const int st = (r >> 4) * 2 + (c >> 5), rr = r & 15, cc = c & 31, ob = rr * 64 + cc * 2; return st * 1024 + (ob ^ (((ob >> 9) & 1) << 5)); }
DEVI void stage_rc(int b, int& R, int& C) { const int st = b / 1024, sb = b % 1024, swz = sb ^ (((sb >> 9) & 1) << 5); R = (st >> 1) * 16 + swz / 64; C = (st & 1) * 32 + (swz % 64) / 2; }
DEVI int perm32(int rho) { const int n = rho >> 4, i = rho & 15; return 8 * (i >> 2) + 4 * n + (i & 3); }
struct Unit { int pm, pn; };
struct Gemm { const h16* A; const h16* Bt; int M, N, K, ld; };
struct StaticOrder {
  int nM, nN, nwg, G, c;
  DEVI void init(int M, int N, int G_, int c_) { nM = M / BM; nN = N / BM; nwg = nM * nN; G = G_; c = c_; }
  DEVI bool next(int i, Unit& u) const {
    if (c < 0) return false;
    const long L = (long)i * G + c; if (L >= nwg) return false;
    int wgid = (int)L; { const int q = nwg / NXCD, r = nwg % NXCD, xcd = wgid % NXCD, off = wgid / NXCD; wgid = (xcd < r ? xcd * (q + 1) : r * (q + 1) + (xcd - r) * q) + off; }
    const int nig = WGM * nN, gid = wgid / nig, fm = gid * WGM, gsz = (nM - fm) < WGM ? (nM - fm) : WGM;
    u.pm = fm + ((wgid % nig) % gsz); u.pn = (wgid % nig) / gsz; return true;
  }
};

template <class Epi>
DEVI void gemm_phase(LAS unsigned char* lds, const Gemm g, const StaticOrder& S, const Epi& E) {
  const int tid = tidx(), wid = __builtin_amdgcn_readfirstlane(tid >> 6), lane = tid & 63, wr = wid >> 2, wc = wid & 3, fr = lane & 15, fq = lane >> 4;
  const int K = g.K, nt = K / BK;
  unsigned voffA[2], voffB[2];
#pragma unroll
  for (int i = 0; i < 2; ++i) { int R, C; stage_rc(tid * 16 + i * 8192, R, C); const int Rb = Epi::PERM ? ((R & ~31) + perm32(R & 31)) : R;
    voffA[i] = (unsigned)(R * g.ld + C) * 2u; voffB[i] = (unsigned)(Rb * g.ld + C) * 2u; }
  const size_t kstep = (size_t)(BK * 2);
  const size_t hstep = (size_t)HALF * g.ld * 2;
  const size_t tstep = 2 * hstep;
  const unsigned ldsw = (unsigned)wid * 1024u;
  const int aoff = lds_byte(wr * 64 + fr, fq * 8), boff = lds_byte(wc * 32 + fr, fq * 8);
#define G8_SA(b, h) (((b) * 2 + (h)) * HTB)
#define G8_SB(b, h) ((4 + (b) * 2 + (h)) * HTB)
#define G8_STAGE(bufoff, gbase, voff) do { _Pragma("unroll") for (int _i = 0; _i < 2; ++_i) \
    __builtin_amdgcn_global_load_lds((const unsigned*)((const char*)(gbase) + (voff)[_i]), (LAS unsigned*)(lds + (bufoff) + ldsw + _i * 8192), 16, 0, 0); } while (0)
#define G8_LDA(dst, b, h) do { _Pragma("unroll") for (int m = 0; m < 4; ++m) _Pragma("unroll") for (int k = 0; k < 2; ++k) dst[m][k] = *(const LAS h16x8*)(lds + G8_SA(b, h) + aoff + m * 2048 + k * 1024); } while (0)
#define G8_LDB(dst, b, h) do { _Pragma("unroll") for (int n = 0; n < 2; ++n) _Pragma("unroll") for (int k = 0; k < 2; ++k) dst[n][k] = *(const LAS h16x8*)(lds + G8_SB(b, h) + boff + n * 2048 + k * 1024); } while (0)
#define G8_MMA(ai, bj, At, Bt) do { __builtin_amdgcn_s_setprio(1); _Pragma("unroll") for (int m = 0; m < 4; ++m) _Pragma("unroll") for (int n = 0; n < 2; ++n) _Pragma("unroll") for (int k = 0; k < 2; ++k) \
    acc[ai][bj][m][n] = __builtin_amdgcn_mfma_f32_16x16x32_f16(Bt[n][k], At[m][k], acc[ai][bj][m][n], 0, 0, 0); __builtin_amdgcn_s_setprio(0); } while (0)
#define G8_WAIT_V(n) asm volatile("s_waitcnt vmcnt(" #n ")" ::: "memory")
#define G8_WAIT_L(n) asm volatile("s_waitcnt lgkmcnt(" #n ")" ::: "memory")
#define G8_BAR __builtin_amdgcn_s_barrier()
#define G8_SCHED __builtin_amdgcn_sched_barrier(0)
  Unit cur, nxt; int ui = 0;
  if (!S.next(0, cur)) return;
  f32x4 acc[2][2][4][2];
#pragma unroll
  for (int a = 0; a < 2; ++a)
#pragma unroll
    for (int b = 0; b < 2; ++b)
#pragma unroll
      for (int m = 0; m < 4; ++m)
#pragma unroll
        for (int n = 0; n < 2; ++n) acc[a][b][m][n] = (f32x4){0.f, 0.f, 0.f, 0.f};
  h16x8 At[4][2], B0[2][2], B1[2][2];
  const char* cA = (const char*)g.A + (size_t)cur.pm * tstep; const char* cB = (const char*)g.Bt + (size_t)cur.pn * tstep;
  G8_STAGE(G8_SB(0, 0), cB, voffB); G8_STAGE(G8_SA(0, 0), cA, voffA); G8_STAGE(G8_SB(0, 1), cB + hstep, voffB); G8_STAGE(G8_SA(0, 1), cA + hstep, voffA);
  if (wr == 1) G8_BAR;
  G8_WAIT_V(4); G8_BAR;
  G8_STAGE(G8_SB(1, 0), cB + kstep, voffB); G8_STAGE(G8_SA(1, 0), cA + kstep, voffA); G8_STAGE(G8_SB(1, 1), cB + hstep + kstep, voffB);
  G8_WAIT_V(6); G8_BAR;
  for (;;) {
    const bool has_next = S.next(ui + 1, nxt);
    const char* nA = has_next ? (const char*)g.A + (size_t)nxt.pm * tstep : cA; const char* nB = has_next ? (const char*)g.Bt + (size_t)nxt.pn * tstep : cB;
    for (int t = 0; t < nt; t += 2) {
      const bool last = (t == nt - 2);
      const char* a1 = cA + (size_t)(t + 1) * kstep;
      const char* a2 = last ? nA : cA + (size_t)(t + 2) * kstep; const char* b2 = last ? nB : cB + (size_t)(t + 2) * kstep;
      const char* a3 = a2 + kstep; const char* b3 = b2 + kstep;
      G8_LDB(B0, 0, 0); G8_SCHED; G8_LDA(At, 0, 0); G8_STAGE(G8_SA(1, 1), a1 + hstep, voffA);
      G8_WAIT_L(8); G8_BAR; G8_WAIT_L(0); G8_MMA(0, 0, At, B0); G8_BAR; G8_SCHED;
      G8_LDB(B1, 0, 1); G8_STAGE(G8_SB(0, 0), b2, voffB);
      G8_BAR; G8_WAIT_L(0); G8_MMA(0, 1, At, B1); G8_BAR;
      G8_LDA(At, 0, 1); G8_STAGE(G8_SA(0, 0), a2, voffA);
      G8_BAR; G8_WAIT_L(0); G8_MMA(1, 0, At, B0); G8_BAR; G8_SCHED;
      G8_STAGE(G8_SB(0, 1), b2 + hstep, voffB);
      G8_WAIT_V(6); G8_BAR; G8_MMA(1, 1, At, B1); G8_BAR;
      G8_LDB(B0, 1, 0); G8_SCHED; G8_LDA(At, 1, 0); G8_STAGE(G8_SA(0, 1), a2 + hstep, voffA);
      G8_WAIT_L(8); G8_BAR; G8_WAIT_L(0); G8_MMA(0, 0, At, B0); G8_BAR; G8_SCHED;
      G8_LDB(B1, 1, 1); G8_STAGE(G8_SB(1, 0), b3, voffB);
      G8_BAR; G8_WAIT_L(0); G8_MMA(0, 1, At, B1); G8_BAR;
      G8_LDA(At, 1, 1); G8_STAGE(G8_SA(1, 0), a3, voffA);
      G8_BAR; G8_WAIT_L(0); G8_MMA(1, 0, At, B0); G8_BAR; G8_SCHED;
      G8_STAGE(G8_SB(1, 1), b3 + hstep, voffB);
      G8_WAIT_V(6); G8_BAR; G8_MMA(1, 1, At, B1); G8_BAR;
    }
    E(acc, cur, wr, wc, fr, fq);
    if (!has_next) break;
#pragma unroll
    for (int a = 0; a < 2; ++a)
#pragma unroll
      for (int b = 0; b < 2; ++b)
#pragma unroll
        for (int m = 0; m < 4; ++m)
#pragma unroll
          for (int n = 0; n < 2; ++n) acc[a][b][m][n] = (f32x4){0.f, 0.f, 0.f, 0.f};
    cur = nxt; cA = nA; cB = nB; ++ui;
  }
  G8_WAIT_V(0);
  if (wr == 0) G8_BAR;
  G8_BAR;
#undef G8_SA
#undef G8_SB
#undef G8_STAGE
#undef G8_LDA
#undef G8_LDB
#undef G8_MMA
}
}
using g8::Unit;

template <class Epi>
DEVI void run_gemm(h16* smem, const h16* A, const h16* Bt, int M, int N, int K, const Epi& e, int c_override = -2, int ld = 0) {
  g8::Gemm g{A, Bt, M, N, K, ld ? ld : K};
  g8::StaticOrder S;
  S.init(M, N, (int)gridDim.x, c_override == -2 ? lbid() : c_override);
  g8::gemm_phase((LAS unsigned char*)smem, g, S, e);
}

#define E8_FOR                                      \
  _Pragma("unroll") for (int ai = 0; ai < 2; ++ai)   \
  _Pragma("unroll") for (int m = 0; m < 4; ++m)      \
  _Pragma("unroll") for (int bj = 0; bj < 2; ++bj)   \
  _Pragma("unroll") for (int n = 0; n < 2; ++n)
#define E8_ROW (u.pm * 256 + ai * 128 + wr * 64 + m * 16 + fr)
#define E8_COL (u.pn * 256 + bj * 128 + wc * 32 + n * 16 + fq * 4)
#define E8_COLP (u.pn * 256 + bj * 128 + wc * 32 + fq * 8 + n * 4)
typedef const f32x4 (&AccRef)[2][2][4][2];

#define E8P_FOR                                     \
  _Pragma("unroll") for (int ai = 0; ai < 2; ++ai)   \
  _Pragma("unroll") for (int m = 0; m < 4; ++m)      \
  _Pragma("unroll") for (int bj = 0; bj < 2; ++bj)
#define E8P_COL (u.pn * 256 + bj * 128 + wc * 32 + fq * 8)
struct EpiG1 {
  static constexpr bool PERM = true, AFTER_DRAIN = false;
  h16 *q0, *k0, *vT, *vcT, *ucT, *ucTc;
  DEVI void operator()(AccRef acc, const Unit& u, int wr, int wc, int fr, int fq) const {
    const bool isctx = u.pm >= 64;
    E8P_FOR {
      const int row = E8_ROW, col = E8P_COL;
      const f32x4 va = acc[ai][bj][m][0], vb = acc[ai][bj][m][1];
      int b, n_;
      if (!isctx) { b = row >> 12; n_ = row & 4095; } else { b = (row - TL) >> 8; n_ = (row - TL) & 255; }
      if (u.pn < 4) {
        const int g = u.pn, part = bj, mm = col & 127;
        const size_t ld = isctx ? 512 : 8192;
        h16* d = isctx ? ucTc + (size_t)((b * 4 + g) * 128 + mm) * 512 + part * 256 + n_
                       : ucT + (size_t)((b * 4 + g) * 128 + mm) * 8192 + part * 4096 + n_;
#pragma unroll
        for (int j = 0; j < 4; ++j) { d[j * ld] = (h16)va[j]; d[(4 + j) * ld] = (h16)vb[j]; }
      } else if (u.pn < 10) {
        store_h8(q0 + (size_t)row * 1536 + (col - 1024), va, vb);
      } else if (u.pn < 16) {
        store_h8(k0 + (size_t)row * 1536 + (col - 2560), va, vb);
      } else {
        const int c3 = col - 4096, hh = c3 >> 7, dv = c3 & 127;
        const size_t ld = isctx ? 256 : 4096;
        h16* d = isctx ? vcT + (size_t)((b * 12 + hh) * 128 + dv) * 256 + n_
                       : vT + (size_t)((b * 12 + hh) * 128 + dv) * 4096 + n_;
#pragma unroll
        for (int j = 0; j < 4; ++j) { d[j * ld] = (h16)va[j]; d[(4 + j) * ld] = (h16)vb[j]; }
      }
    }
  }
};

struct EpiDft {
  static constexpr bool PERM = true, AFTER_DRAIN = false;
  h16* cat; float scale; int is_ctx; int mirror;
  DEVI void operator()(AccRef acc, const Unit& u, int wr, int wc, int fr, int fq) const {
    E8P_FOR {
      const int row = E8_ROW, col = E8P_COL;
      const f32x4 va = acc[ai][bj][m][0], vb = acc[ai][bj][m][1];
      const int b = col >> 9, g = (col >> 7) & 3, mm = col & 127;
      const size_t rbase = is_ctx ? (size_t)(TL + b * 256) : (size_t)b * 4096;
      if (!mirror || row <= 2048) store_h8(cat + (rbase + row) * 2048 + g * 128 + mm, va, vb, scale);
      if (mirror && row >= 1 && row <= 2047) {
        h16* mr = cat + (rbase + (4096 - row)) * 2048 + g * 128;
        mr[(128 - mm) & 127] = (h16)(va[0] * scale);
#pragma unroll
        for (int j = 1; j < 4; ++j) mr[128 - mm - j] = (h16)(va[j] * scale);
#pragma unroll
        for (int j = 0; j < 4; ++j) mr[124 - mm - j] = (h16)(vb[j] * scale);
      }
    }
  }
};

DEVI void ld8f(const float* p, float (&o)[8]) { const float4 a = *(const float4*)p, b = *(const float4*)(p + 4); o[0] = a.x; o[1] = a.y; o[2] = a.z; o[3] = a.w; o[4] = b.x; o[5] = b.y; o[6] = b.z; o[7] = b.w; }
DEVI void ld8f(const h16* p, float (&o)[8]) { const h16x8 v = *(const h16x8*)p;
#pragma unroll
  for (int i = 0; i < 8; ++i) o[i] = (float)v[i]; }
template <class TS>
struct EpiRes {
  static constexpr bool PERM = true, AFTER_DRAIN = false;
  const TS *src_lat, *src_ctx;
  h16* xres; const float* gate;
  DEVI void operator()(AccRef acc, const Unit& u, int wr, int wc, int fr, int fq) const {
    const int midx = (u.pm < 64) ? (u.pm >> 4) : 4;
    float gt[2][8];
#pragma unroll
    for (int bj = 0; bj < 2; ++bj) ld8f(gate + midx * 12288 + u.pn * 256 + bj * 128 + wc * 32 + fq * 8, gt[bj]);
#pragma unroll
    for (int ai = 0; ai < 2; ++ai)
#pragma unroll
      for (int m = 0; m < 4; ++m)
#pragma unroll
        for (int bj = 0; bj < 2; ++bj) {
          const int row = u.pm * 256 + ai * 128 + wr * 64 + m * 16 + fr;
          const int col = u.pn * 256 + bj * 128 + wc * 32 + fq * 8;
          const f32x4 v0 = acc[ai][bj][m][0], v1 = acc[ai][bj][m][1];
          float sv[8];
          ld8f(u.pm < 64 ? src_lat + (size_t)row * 2048 + col : src_ctx + (size_t)(row - TL) * 2048 + col, sv);
          h16x8 o;
#pragma unroll
          for (int j = 0; j < 4; ++j) { o[j] = (h16)(sv[j] + gt[bj][j] * v0[j]); o[4 + j] = (h16)(sv[4 + j] + gt[bj][4 + j] * v1[j]); }
          *(h16x8*)(xres + (size_t)row * 2048 + col) = o;
        }
  }
};

struct EpiPartial {
  static constexpr bool PERM = false, AFTER_DRAIN = false;
  float* part;
  DEVI void operator()(AccRef acc, const Unit& u, int wr, int wc, int fr, int fq) const {
    E8_FOR {
      const int row = E8_ROW, col = E8_COL;
      *(f32x4*)(part + (size_t)row * 2048 + col) = acc[ai][bj][m][n];
    }
  }
};

struct EpiGU {
  static constexpr bool PERM = true, AFTER_DRAIN = false;
  h16* act;
  DEVI void operator()(AccRef acc, const Unit& u, int wr, int wc, int fr, int fq) const {
#pragma unroll
    for (int ai = 0; ai < 2; ++ai)
#pragma unroll
      for (int m = 0; m < 4; ++m) {
        const int row = u.pm * 256 + ai * 128 + wr * 64 + m * 16 + fr;
        const int ocol = u.pn * 128 + wc * 32 + fq * 8;
        const f32x4 g0 = acc[ai][0][m][0], g1 = acc[ai][0][m][1], u0 = acc[ai][1][m][0], u1 = acc[ai][1][m][1];
        h16x8 o;
#pragma unroll
        for (int j = 0; j < 4; ++j) { o[j] = (h16)(silu_f(g0[j]) * u0[j]); o[4 + j] = (h16)(silu_f(g1[j]) * u1[j]); }
        __builtin_nontemporal_store(o, (h16x8*)(act + (size_t)row * DFF + ocol));
      }
  }
};

struct EpiStore {
  static constexpr bool PERM = true, AFTER_DRAIN = false;
  h16* dst; int ldd;
  DEVI void operator()(AccRef acc, const Unit& u, int wr, int wc, int fr, int fq) const {
    E8P_FOR {
      const int row = E8_ROW, col = E8P_COL;
      store_h8(dst + (size_t)row * ldd + col, acc[ai][bj][m][0], acc[ai][bj][m][1]);
    }
  }
};

constexpr float LOG2E = 1.4426950408889634f;

struct EpiQ1 {
  static constexpr bool PERM = false, AFTER_DRAIN = false;
  h16* q1;
  DEVI void operator()(AccRef acc, const Unit& u, int wr, int wc, int fr, int fq) const {
    const float qs = 0.07216878364870322f * LOG2E;
#pragma unroll
    for (int bj = 0; bj < 2; ++bj) {
      const int cgb = u.pn * 256 + bj * 128 + wc * 32;
      const int w = cgb % 192;
      if (w < 128) {
#pragma unroll
        for (int ai = 0; ai < 2; ++ai)
#pragma unroll
          for (int m = 0; m < 4; ++m)
#pragma unroll
            for (int n = 0; n < 2; ++n) {
              const int row = u.pm * 256 + ai * 128 + wr * 64 + m * 16 + fr;
              const f32x4 v = acc[ai][bj][m][n];
              store_h4(q1 + (size_t)row * 2304 + cgb + n * 16 + fq * 4, v[0] * qs, v[1] * qs, v[2] * qs, v[3] * qs);
            }
      } else {
        const int half = (w - 128) >> 5;
        float inv[4];
#pragma unroll
        for (int j = 0; j < 4; ++j) inv[j] = fexp2(-(float)(fq * 4 + j) * (13.287712379549449f / 16.0f)) * 0.15915494309189535f;
#pragma unroll
        for (int ai = 0; ai < 2; ++ai)
#pragma unroll
          for (int m = 0; m < 4; ++m) {
            const int row = u.pm * 256 + ai * 128 + wr * 64 + m * 16 + fr;
            const int t = row & 4095;
            const float pos = (float)(half ? (t & 63) : (t >> 6));
            const f32x4 a = acc[ai][bj][m][0], bb = acc[ai][bj][m][1];
            float o1[4], o2[4];
#pragma unroll
            for (int j = 0; j < 4; ++j) {
              const float rev = pos * inv[j];
              const float cs = cos_rev(rev), sn = sin_rev(rev);
              o1[j] = (a[j] * cs - bb[j] * sn) * qs;
              o2[j] = (a[j] * sn + bb[j] * cs) * qs;
            }
            h16* d = q1 + (size_t)row * 2304 + cgb + fq * 4;
            store_h4(d, o1[0], o1[1], o1[2], o1[3]);
            store_h4(d + 16, o2[0], o2[1], o2[2], o2[3]);
          }
      }
    }
  }
};

struct EpiKV1 {
  static constexpr bool PERM = true, AFTER_DRAIN = false;
  h16 *kn, *vT1;
  DEVI void operator()(AccRef acc, const Unit& u, int wr, int wc, int fr, int fq) const {
    const int hh = u.pn;
    E8P_FOR {
      const int row = E8_ROW;
      const f32x4 va = acc[ai][bj][m][0], vb = acc[ai][bj][m][1];
      int b, key;
      if (row < TL) { b = row >> 12; key = 256 + (row & 4095); } else { b = (row - TL) >> 8; key = (row - TL) & 255; }
      const int w = wc * 32 + fq * 8;
      if (bj == 0) {
        store_h8(kn + ((size_t)b * 4352 + key) * 1536 + hh * 128 + w, va, vb);
      } else {
        h16* d = vT1 + (size_t)((b * 12 + hh) * 128 + w) * 4352 + key;
#pragma unroll
        for (int j = 0; j < 4; ++j) { d[(size_t)j * 4352] = (h16)va[j]; d[(size_t)(4 + j) * 4352] = (h16)vb[j]; }
      }
    }
  }
};

DEVI void mod_units(const Params& p, float* smemf) {
  float* mod = (float*)(p.ws + OFF_MOD);
  const int tid = tidx();
  float* ss = smemf;
  float* red = smemf + 5 * 2048;
  for (int i = tid; i < 5 * 2048; i += NTHR) {
    const int s = i >> 11, k = i & 2047;
    const float v = s < 4 ? p.c[s * 2048 + k] : p.c_ctx[k];
    ss[i] = silu_f(v);
  }
  __syncthreads();
  for (int u = blockIdx.x; u < 768; u += gridDim.x) {
    const int l = u / 384, n0 = (u % 384) * 32;
    const int cl = (tid & 7) * 4, kg = tid >> 3;
    const float* wp = p.w_mod + ((size_t)l * 2048 + kg * 32) * 12288 + n0 + cl;
    float4 a0 = {0, 0, 0, 0}, a1 = a0, a2 = a0, a3 = a0, a4 = a0;
#pragma unroll 8
    for (int kk = 0; kk < 32; ++kk) {
      const float4 w = ldnt4(wp + (size_t)kk * 12288);
      const int k = kg * 32 + kk;
      const float s0 = ss[k], s1 = ss[2048 + k], s2 = ss[4096 + k], s3 = ss[6144 + k], s4 = ss[8192 + k];
      a0.x += s0 * w.x; a0.y += s0 * w.y; a0.z += s0 * w.z; a0.w += s0 * w.w;
      a1.x += s1 * w.x; a1.y += s1 * w.y; a1.z += s1 * w.z; a1.w += s1 * w.w;
      a2.x += s2 * w.x; a2.y += s2 * w.y; a2.z += s2 * w.z; a2.w += s2 * w.w;
      a3.x += s3 * w.x; a3.y += s3 * w.y; a3.z += s3 * w.z; a3.w += s3 * w.w;
      a4.x += s4 * w.x; a4.y += s4 * w.y; a4.z += s4 * w.z; a4.w += s4 * w.w;
    }
    *(float4*)(red + (kg * 5 + 0) * 32 + cl) = a0;
    *(float4*)(red + (kg * 5 + 1) * 32 + cl) = a1;
    *(float4*)(red + (kg * 5 + 2) * 32 + cl) = a2;
    *(float4*)(red + (kg * 5 + 3) * 32 + cl) = a3;
    *(float4*)(red + (kg * 5 + 4) * 32 + cl) = a4;
    __syncthreads();
    if (tid < 160) {
      const int s = tid >> 5, cc = tid & 31;
      float sum = 0.f;
#pragma unroll 16
      for (int g = 0; g < 64; ++g) sum += red[(g * 5 + s) * 32 + cc];
      mod[(size_t)(l * 5 + s) * 12288 + n0 + cc] = sum + p.b_mod[l * 12288 + n0 + cc];
    }
    __syncthreads();
  }
}

DEVI int maprow(int mode, int n) {
  if (mode == 0) return n;
  if (mode == 1) return (n >> 7) * 256 + (n & 127);
  return (n >> 7) * 256 + 128 + (n & 127);
}
DEVI unsigned pack_h2(float lo, float hi) {
  typedef _Float16 h16x2 __attribute__((ext_vector_type(2)));
  h16x2 v; v[0] = (h16)lo; v[1] = (h16)hi;
  return __builtin_bit_cast(unsigned, v);
}
DEVI void transpose_job(const float* __restrict__ src, int ldsrc, int K, int N, int ncol0, h16* __restrict__ dst,
                        int ldd, int dcol0, int mode, float* tile_base, int worker, int nworkers) {
  const int tid = tidx();
  const int half = tid >> 8, tl = tid & 255;
  h16* tile = (h16*)tile_base + half * (64 * 68);
  const int nkt = K >> 6, nnt = N >> 6;
  const int ntiles = nkt * nnt;
  const int kp2 = (tl >> 4) * 2, lc4 = (tl & 15) * 4;
  float4 cur[4], nxt[4];
  int t = worker * 2 + half;
  const int tstride = nworkers * 2;
  if (t < ntiles) {
    const int kt = t / nnt, nt = t - kt * nnt;
    const float* sp = src + (size_t)(kt * 64 + kp2) * ldsrc + ncol0 + nt * 64 + lc4;
    cur[0] = ldnt4(sp); cur[1] = ldnt4(sp + ldsrc);
    cur[2] = ldnt4(sp + (size_t)32 * ldsrc); cur[3] = ldnt4(sp + (size_t)33 * ldsrc);
  }
  for (int t0 = worker * 2; t0 < ntiles; t0 += tstride, t += tstride) {
    const bool active = t < ntiles;
    const int tn = t + tstride;
    if (tn < ntiles) {
      const int kt = tn / nnt, nt = tn - kt * nnt;
      const float* sp = src + (size_t)(kt * 64 + kp2) * ldsrc + ncol0 + nt * 64 + lc4;
      nxt[0] = ldnt4(sp); nxt[1] = ldnt4(sp + ldsrc);
      nxt[2] = ldnt4(sp + (size_t)32 * ldsrc); nxt[3] = ldnt4(sp + (size_t)33 * ldsrc);
    }
    const int kt = t / nnt, nt = t - kt * nnt;
    const int k0 = kt * 64, n0 = nt * 64;
    if (active) {
      unsigned* tw = (unsigned*)tile;
#pragma unroll
      for (int i = 0; i < 2; ++i) {
        const int kd = (i * 32 + kp2) >> 1;
        const float4 a = cur[2 * i], bq = cur[2 * i + 1];
        tw[(lc4 + 0) * 34 + kd] = pack_h2(a.x, bq.x);
        tw[(lc4 + 1) * 34 + kd] = pack_h2(a.y, bq.y);
        tw[(lc4 + 2) * 34 + kd] = pack_h2(a.z, bq.z);
        tw[(lc4 + 3) * 34 + kd] = pack_h2(a.w, bq.w);
      }
    }
    __syncthreads();
    if (active) {
      const int n = tl >> 2, ks = (tl & 3) * 16;
      const uint2* rp = (const uint2*)(tile + n * 68 + ks);
      const uint2 r0 = rp[0], r1 = rp[1], r2 = rp[2], r3 = rp[3];
      h16* d = dst + (size_t)maprow(mode, n0 + n) * ldd + dcol0 + k0 + ks;
      *(uint4*)d = make_uint4(r0.x, r0.y, r1.x, r1.y);
      *(uint4*)(d + 8) = make_uint4(r2.x, r2.y, r3.x, r3.y);
    }
    __syncthreads();
#pragma unroll
    for (int i = 0; i < 4; ++i) cur[i] = nxt[i];
  }
}

DEVI void dft_gen(const Params& p) {
  h16* A = (h16*)(p.ws + OFF_DFTA);
  h16* Ac = (h16*)(p.ws + OFF_DFTAC);
  const size_t nthr = (size_t)gridDim.x * NTHR;
  const size_t gtid = (size_t)blockIdx.x * NTHR + tidx();
  if (gtid < 8) ((int*)(p.ws + OFF_CTR))[gtid * 8] = 0;
  for (size_t ch = gtid; ch < (size_t)2304 * 1024; ch += nthr) {
    const int k = (int)(ch >> 10), n8 = (int)(ch & 1023) * 8;
    h16x8 o;
#pragma unroll
    for (int e = 0; e < 8; ++e) {
      const int nn = n8 + e;
      const int n = nn & 4095;
      const float rev = (float)((k * n) & 4095) * (1.0f / 4096.0f);
      o[e] = (h16)((nn < 4096) ? cos_rev(rev) : -sin_rev(rev));
    }
    *(h16x8*)(A + (size_t)k * 8192 + n8) = o;
  }
  for (size_t ch = gtid; ch < (size_t)256 * 64; ch += nthr) {
    const int k = (int)(ch >> 6), n8 = (int)(ch & 63) * 8;
    h16x8 o;
#pragma unroll
    for (int e = 0; e < 8; ++e) {
      const int nn = n8 + e;
      const int n = nn & 255;
      const float rev = (float)((k * n) & 255) * (1.0f / 256.0f);
      o[e] = (h16)((nn < 256) ? cos_rev(rev) : -sin_rev(rev));
    }
    *(h16x8*)(Ac + (size_t)k * 512 + n8) = o;
  }
  h16* z = (h16*)(p.ws + OFF_WT_IN_CD) + (size_t)1856 * 2048;
  for (size_t ch = gtid; ch < (size_t)192 * 2048 / 8; ch += nthr) {
    uint4 zz = {0, 0, 0, 0};
    *(uint4*)(z + ch * 8) = zz;
  }
}

DEVI void fold_uc(const Params& p, float* smemf) {
  h16* wt = (h16*)(p.ws + OFF_WT_IN_AB);
  float* wl = smemf;
  float* ct = smemf + 128 * 64;
  float* st = ct + 128;
  const int tid = tidx();
  for (int u = blockIdx.x; u < 128; u += gridDim.x) {
    const int kb = u >> 2, g = u & 3, k0 = kb * 64;
    for (int i = tid; i < 64 * 32; i += NTHR) {
      const int kk = i >> 5, c4 = (i & 31) * 4;
      const float4 v = *(const float4*)(p.w_in_ab + (size_t)(k0 + kk) * 5120 + g * 128 + c4);
      wl[(c4 + 0) * 64 + kk] = v.x; wl[(c4 + 1) * 64 + kk] = v.y; wl[(c4 + 2) * 64 + kk] = v.z; wl[(c4 + 3) * 64 + kk] = v.w;
    }
    if (tid < 128) { ct[tid] = cos_rev((float)tid * (1.0f / 128.0f)); st[tid] = sin_rev((float)tid * (1.0f / 128.0f)); }
    __syncthreads();
    const int kh = tid >> 8, t2 = tid & 255;
    const int part = t2 >> 7, m = t2 & 127;
    const float* tab = part ? st : ct;
    float acc[32];
#pragma unroll
    for (int i = 0; i < 32; ++i) acc[i] = 0.f;
    for (int c = 0; c < 128; ++c) {
      const float tw = tab[(c * m) & 127];
#pragma unroll
      for (int k4 = 0; k4 < 8; ++k4) {
        const float4 w = *(const float4*)(wl + c * 64 + kh * 32 + k4 * 4);
        acc[k4 * 4 + 0] += w.x * tw; acc[k4 * 4 + 1] += w.y * tw; acc[k4 * 4 + 2] += w.z * tw; acc[k4 * 4 + 3] += w.w * tw;
      }
    }
    h16* d = wt + (size_t)(g * 256 + t2) * 2048 + k0 + kh * 32;
#pragma unroll
    for (int c8 = 0; c8 < 4; ++c8) {
      h16x8 o;
#pragma unroll
      for (int e = 0; e < 8; ++e) o[e] = (h16)acc[c8 * 8 + e];
      *(h16x8*)(d + c8 * 8) = o;
    }
    __syncthreads();
  }
}

DEVI void fold_out(const float* __restrict__ wg, const float* __restrict__ ps, const float* __restrict__ w_out,
                   h16* __restrict__ wt, float* smemf, int worker, int nworkers) {
  float* wl = smemf;
  float* wgl = smemf + 128 * 64;
  const int tid = tidx();
  for (int u = worker; u < 128; u += nworkers) {
    const int g = u >> 5, j0 = (u & 31) * 64;
    for (int i = tid; i < 128 * 16; i += NTHR) {
      const int d = i >> 4, c4 = (i & 15) * 4;
      float4 v = *(const float4*)(w_out + (size_t)(g * 128 + d) * 2048 + j0 + c4);
      const float sc = ps ? ps[g * 128 + d] : 1.0f;
      v.x *= sc; v.y *= sc; v.z *= sc; v.w *= sc;
      *(float4*)(wl + d * 64 + c4) = v;
    }
    for (int i = tid; i < 128 * 32; i += NTHR) {
      const int c = i >> 5, d4 = (i & 31) * 4;
      *(float4*)(wgl + c * 132 + d4) = *(const float4*)(wg + (size_t)(g * 128 + c) * 128 + d4);
    }
    __syncthreads();
    const int j = tid & 63;
    const int cg_ = __builtin_amdgcn_readfirstlane(tid >> 6);
    float acc[16];
#pragma unroll
    for (int i = 0; i < 16; ++i) acc[i] = 0.f;
    const float* wgp = wgl + (cg_ * 16) * 132;
    for (int d4 = 0; d4 < 32; ++d4) {
      const float w0 = wl[(d4 * 4 + 0) * 64 + j], w1 = wl[(d4 * 4 + 1) * 64 + j], w2 = wl[(d4 * 4 + 2) * 64 + j], w3 = wl[(d4 * 4 + 3) * 64 + j];
#pragma unroll
      for (int cc = 0; cc < 16; ++cc) {
        const float4 gq = *(const float4*)(wgp + cc * 132 + d4 * 4);
        acc[cc] += gq.x * w0 + gq.y * w1 + gq.z * w2 + gq.w * w3;
      }
    }
    h16* dst = wt + (size_t)(j0 + j) * 2048 + g * 128 + cg_ * 16;
#pragma unroll
    for (int c8 = 0; c8 < 2; ++c8) {
      h16x8 o;
#pragma unroll
      for (int e = 0; e < 8; ++e) o[e] = (h16)acc[c8 * 8 + e];
      *(h16x8*)(dst + c8 * 8) = o;
    }
    __syncthreads();
  }
}

DEVI void phase0(const Params& p, float* smemf) {
  const int w = blockIdx.x, nw = gridDim.x;
  mod_units(p, smemf);
  dft_gen(p);
  fold_uc(p, smemf);
  fold_out(p.w_four, nullptr, p.w_out_ab, (h16*)(p.ws + OFF_WT_OUT_AB), smemf, w, nw);
  transpose_job(p.w_in_ab, 5120, 2048, 4608, 512, (h16*)(p.ws + OFF_WT_IN_AB) + (size_t)1024 * 2048, 2048, 0, 0, smemf, w, nw);
  transpose_job(p.w_out_ab + (size_t)512 * 2048, 2048, 1536, 2048, 0, (h16*)(p.ws + OFF_WT_OUT_AB), 2048, 512, 0, smemf, w, nw);
}
DEVI void prep_ffn_gu(const Params& p, int l, float* smemf, int w, int nw) {
  h16* gu = (h16*)(p.ws + (l ? OFF_WT_GU1 : OFF_WT_GU0));
  transpose_job(p.w_ffn_gate + (size_t)l * 2048 * DFF, DFF, 2048, DFF, 0, gu, 2048, 0, 1, smemf, w, nw);
  transpose_job(p.w_ffn_up + (size_t)l * 2048 * DFF, DFF, 2048, DFF, 0, gu, 2048, 0, 2, smemf, w, nw);
}
DEVI void prep_ffn_dn(const Params& p, int l, float* smemf, int w, int nw) {
  h16* dn = (h16*)(p.ws + (l ? OFF_WT_D1 : OFF_WT_D0));
  transpose_job(p.w_ffn_down + (size_t)l * DFF * 2048, 2048, DFF, 2048, 0, dn, DFF, 0, 0, smemf, w, nw);
}
DEVI void prep_ffn(const Params& p, int l, float* smemf, int w, int nw) {
  prep_ffn_gu(p, l, smemf, w, nw);
  prep_ffn_dn(p, l, smemf, w, nw);
}
DEVI void prep_layer1(const Params& p, float* smemf, int w, int nw, bool with_ffn = true) {
  fold_out(p.w_pool, p.pool_scale, p.w_out_cd, (h16*)(p.ws + OFF_WT_OUT_CD), smemf, w, nw);
  transpose_job(p.w_out_cd + (size_t)512 * 2048, 2048, 1536, 2048, 0, (h16*)(p.ws + OFF_WT_OUT_CD), 2048, 512, 0, smemf, w, nw);
  transpose_job(p.w_in_cd, 1856, 2048, 1856, 0, (h16*)(p.ws + OFF_WT_IN_CD), 2048, 0, 0, smemf, w, nw);
  transpose_job(p.w_uq, 2304, 768, 2304, 0, (h16*)(p.ws + OFF_WT_UQ), 768, 0, 0, smemf, w, nw);
  transpose_job(p.w_ukv, 3072, 512, 3072, 0, (h16*)(p.ws + OFF_WT_UKV), 512, 0, 0, smemf, w, nw);
  if (with_ffn) prep_ffn(p, 1, smemf, w, nw);
}

template <class TS>
DEVI void norm_mod_phase(const TS* src_lat, const TS* src_ctx, int nrows, const float* gvec, const float* modl,
                         int sh_idx, int sc_idx, h16* dst) {
  const int tid_ = tidx();
  const int lane = tid_ & 63, wid = tid_ >> 6;
  const int w = blockIdx.x * 8 + wid, nw = gridDim.x * 8;
  const int rbeg = (int)(((long)w * nrows) / nw), rend = (int)(((long)(w + 1) * nrows) / nw);
  if (rbeg >= rend) return;
  float4 fa[8], fb[8], v[8], vn[8];
  int cur_midx = -1;
  {
    const TS* s = rbeg < TL ? src_lat + (size_t)rbeg * 2048 : src_ctx + (size_t)(rbeg - TL) * 2048;
#pragma unroll
    for (int i = 0; i < 8; ++i) v[i] = ld4f(s + (i * 64 + lane) * 4);
  }
  for (int row = rbeg; row < rend; ++row) {
    if (row + 1 < rend) {
      const int r2 = row + 1;
      const TS* s = r2 < TL ? src_lat + (size_t)r2 * 2048 : src_ctx + (size_t)(r2 - TL) * 2048;
#pragma unroll
      for (int i = 0; i < 8; ++i) vn[i] = ld4f(s + (i * 64 + lane) * 4);
    }
    const int midx = row < TL ? (row >> 12) : 4;
    if (midx != cur_midx) {
      cur_midx = midx;
      const float* shp = modl + (size_t)midx * 12288 + sh_idx * 2048;
      const float* scp = modl + (size_t)midx * 12288 + sc_idx * 2048;
#pragma unroll
      for (int i = 0; i < 8; ++i) {
        const int col = (i * 64 + lane) * 4;
        const float4 g = *(const float4*)(gvec + col);
        const float4 sc = *(const float4*)(scp + col);
        fb[i] = *(const float4*)(shp + col);
        fa[i].x = g.x * (1.f + sc.x); fa[i].y = g.y * (1.f + sc.y); fa[i].z = g.z * (1.f + sc.z); fa[i].w = g.w * (1.f + sc.w);
      }
    }
    float ss = 0.f;
#pragma unroll
    for (int i = 0; i < 8; ++i) ss += v[i].x * v[i].x + v[i].y * v[i].y + v[i].z * v[i].z + v[i].w * v[i].w;
    ss = wave_sum(ss);
    const float rstd = rsqrtf(ss * (1.0f / 2048.0f) + 1e-6f);
#pragma unroll
    for (int i = 0; i < 8; ++i) {
      const int col = (i * 64 + lane) * 4;
      store_h4(dst + (size_t)row * 2048 + col, v[i].x * rstd * fa[i].x + fb[i].x, v[i].y * rstd * fa[i].y + fb[i].y,
               v[i].z * rstd * fa[i].z + fb[i].z, v[i].w * rstd * fa[i].w + fb[i].w);
    }
#pragma unroll
    for (int i = 0; i < 8; ++i) v[i] = vn[i];
  }
}

DEVI void ctx_norm_partial_phase(const h16* src_ctx, const float* gvec, const float* modl, int sh_idx, int sc_idx, h16* dst,
                                 const float* part, int nsplit, const float* pgate) {
  const int tid_ = tidx();
  const int lane = tid_ & 63, wid = tid_ >> 6;
  const int w = blockIdx.x * 8 + wid, nw = gridDim.x * 8;
  const float* shp = modl + (size_t)4 * 12288 + sh_idx * 2048;
  const float* scp = modl + (size_t)4 * 12288 + sc_idx * 2048;
  for (int r = w; r < TC; r += nw) {
    float4 v[8];
    float ss = 0.f;
#pragma unroll
    for (int i = 0; i < 8; ++i) {
      const int col = (i * 64 + lane) * 4;
      float4 acc = make_float4(0.f, 0.f, 0.f, 0.f);
      for (int sp = 0; sp < nsplit; ++sp) {
        const float4 q = *(const float4*)(part + ((size_t)sp * TC + r) * 2048 + col);
        acc.x += q.x; acc.y += q.y; acc.z += q.z; acc.w += q.w;
      }
      const float4 gq = *(const float4*)(pgate + col);
      const float4 x = ld4f(src_ctx + (size_t)r * 2048 + col);
      v[i].x = x.x + gq.x * acc.x; v[i].y = x.y + gq.y * acc.y; v[i].z = x.z + gq.z * acc.z; v[i].w = x.w + gq.w * acc.w;
      ss += v[i].x * v[i].x + v[i].y * v[i].y + v[i].z * v[i].z + v[i].w * v[i].w;
    }
    ss = wave_sum(ss);
    const float rstd = rsqrtf(ss * (1.0f / 2048.0f) + 1e-6f);
#pragma unroll
    for (int i = 0; i < 8; ++i) {
      const int col = (i * 64 + lane) * 4;
      const float4 g = *(const float4*)(gvec + col);
      const float4 sh = *(const float4*)(shp + col);
      const float4 sc = *(const float4*)(scp + col);
      store_h4(dst + (size_t)(TL + r) * 2048 + col, v[i].x * rstd * g.x * (1.f + sc.x) + sh.x, v[i].y * rstd * g.y * (1.f + sc.y) + sh.y,
               v[i].z * rstd * g.z * (1.f + sc.z) + sh.z, v[i].w * rstd * g.w * (1.f + sc.w) + sh.w);
    }
  }
}

DEVI void final_norm_phase(const h16* xres, const float* gvec, float* out) {
  const int tid_ = tidx();
  const int lane = tid_ & 63, wid = tid_ >> 6;
  const int w = blockIdx.x * 8 + wid, nw = gridDim.x * 8;
  const int rbeg = (int)(((long)w * TL) / nw), rend = (int)(((long)(w + 1) * TL) / nw);
  if (rbeg >= rend) return;
  float4 fa[8], v[8], vn[8];
#pragma unroll
  for (int i = 0; i < 8; ++i) {
    fa[i] = *(const float4*)(gvec + (i * 64 + lane) * 4);
    v[i] = ld4f(xres + (size_t)rbeg * 2048 + (i * 64 + lane) * 4);
  }
  for (int row = rbeg; row < rend; ++row) {
    if (row + 1 < rend) {
#pragma unroll
      for (int i = 0; i < 8; ++i) vn[i] = ld4f(xres + (size_t)(row + 1) * 2048 + (i * 64 + lane) * 4);
    }
    float ss = 0.f;
#pragma unroll
    for (int i = 0; i < 8; ++i) ss += v[i].x * v[i].x + v[i].y * v[i].y + v[i].z * v[i].z + v[i].w * v[i].w;
    ss = wave_sum(ss);
    const float rstd = rsqrtf(ss * (1.0f / 2048.0f) + 1e-6f);
#pragma unroll
    for (int i = 0; i < 8; ++i) {
      float4 o;
      o.x = v[i].x * rstd * fa[i].x; o.y = v[i].y * rstd * fa[i].y; o.z = v[i].z * rstd * fa[i].z; o.w = v[i].w * rstd * fa[i].w;
      stnt4(out + (size_t)row * 2048 + (i * 64 + lane) * 4, o);
    }
#pragma unroll
    for (int i = 0; i < 8; ++i) v[i] = vn[i];
  }
}

constexpr int NA_KS = 136;
constexpr int NA_VS = 136;
constexpr int NA_BUF = 128 * NA_KS + 128 * NA_VS;
template <int VAR>
DEVI void na_block_unit(const Params& p, int bu, h16* smem) {
  const h16* q0 = (const h16*)(p.ws + OFF_Q0);
  const h16* k0 = (const h16*)(p.ws + OFF_K0);
  const h16* vT = (const h16*)(p.ws + OFF_VT0);
  const h16* vcT = (const h16*)(p.ws + OFF_VCT0);
  h16* cat = VAR ? (h16*)p.out : (h16*)(p.ws + OFF_CAT);
  const int tid = tidx(), lane = tid & 63, wid = tid >> 6;
  const int q_ = lane & 15, g = lane >> 4;
  const bool is_ctx = bu >= 1536;
  int bh, rp = 0, half = 0;
  if (!is_ctx) { rp = bu & 31; bh = bu >> 5; } else { const int uu = bu - 1536; half = uu & 1; bh = uu >> 1; }
  const int hd = bh % 12, b = bh / 12;
  const int rw = 2 * rp + (wid >> 2), j = wid & 3;
  const size_t qrow = is_ctx ? (size_t)(TL + b * 256 + half * 128 + wid * 16 + q_) : (size_t)(b * 4096 + rw * 64 + j * 16 + q_);
  const int rs0 = min(max(2 * rp - 4, 0), 56), rs1 = min(max(2 * rp - 3, 0), 56);
  const int nrows = is_ctx ? 0 : (rs1 - rs0 + 8);
  const int nloc = (nrows + 1) >> 1;
  const int T = nloc + 2;
  const int rsw = min(max(rw - 4, 0), 56);
  const h16* qp = q0 + qrow * 1536 + hd * 128 + g * 8;
  h16x8 qf[4];
#pragma unroll
  for (int s = 0; s < 4; ++s) qf[s] = *(const h16x8*)(qp + s * 32);
  f32x4 o[8];
#pragma unroll
  for (int d = 0; d < 8; ++d) { o[d][0] = 0.f; o[d][1] = 0.f; o[d][2] = 0.f; o[d][3] = 0.f; }
  float m = -1e30f, lsum = 0.f;
  const int kstart = min(max(j * 16 - 8, 0), 32);
  const int qc = j * 16 + q_;
  const int cstart = min(max(qc - 8, 0), 48);
  const float scale = 0.08838834764831845f * LOG2E;
  float* rpb = (float*)(smem + 2 * NA_BUF);
  if (!is_ctx && tid < 465) rpb[tid] = p.na_rpb[hd * 465 + tid] * LOG2E;
  const int srow = tid >> 4, sch = tid & 15;
  const h16* kloc = k0 + (size_t)b * 4096 * 1536 + hd * 128 + (size_t)srow * 1536 + sch * 8;
  const h16* kctx = k0 + ((size_t)TL + b * 256) * 1536 + hd * 128 + (size_t)srow * 1536 + sch * 8;
  const h16* vloc = vT + ((size_t)(b * 12 + hd) * 128 + srow) * 4096 + sch * 8;
  const h16* vctx = vcT + ((size_t)(b * 12 + hd) * 128 + srow) * 256 + sch * 8;
  uint4 A0, A1, A2, A3, A4, A5, A6, A7;
#define NA_GLOAD(t, R0, R1, R2, R3, R4, R5, R6, R7)                                                    \
  {                                                                                                    \
    if ((t) < nloc) {                                                                                  \
      const int krow = rs0 + 2 * (t);                        \
      const h16* kb = kloc + (size_t)krow * 64 * 1536;                                                 \
      const h16* vb = vloc + krow * 64;                                                                \
      R0 = *(const uint4*)kb; R1 = *(const uint4*)(kb + 32 * 1536);                                    \
      R2 = *(const uint4*)(kb + 64 * 1536); R3 = *(const uint4*)(kb + 96 * 1536);                      \
      R4 = *(const uint4*)vb; R5 = *(const uint4*)(vb + (size_t)32 * 4096);                            \
      R6 = *(const uint4*)(vb + (size_t)64 * 4096); R7 = *(const uint4*)(vb + (size_t)96 * 4096);      \
    } else {                                                                                           \
      const int c = (t) - nloc;                                                                        \
      const h16* kb = kctx + (size_t)c * 128 * 1536;                                                   \
      const h16* vb = vctx + c * 128;                                                                  \
      R0 = *(const uint4*)kb; R1 = *(const uint4*)(kb + 32 * 1536);                                    \
      R2 = *(const uint4*)(kb + 64 * 1536); R3 = *(const uint4*)(kb + 96 * 1536);                      \
      R4 = *(const uint4*)vb; R5 = *(const uint4*)(vb + 32 * 256);                                     \
      R6 = *(const uint4*)(vb + 64 * 256); R7 = *(const uint4*)(vb + 96 * 256);                        \
    }                                                                                                  \
  }
#define NA_SSTORE(buf, R0, R1, R2, R3, R4, R5, R6, R7)                                                 \
  {                                                                                                    \
    h16* bk = smem + (buf) * NA_BUF;                                                                   \
    h16* bv = bk + 128 * NA_KS;                                                                        \
    *(uint4*)(bk + srow * NA_KS + sch * 8) = R0;                                                       \
    *(uint4*)(bk + (srow + 32) * NA_KS + sch * 8) = R1;                                                \
    *(uint4*)(bk + (srow + 64) * NA_KS + sch * 8) = R2;                                                \
    *(uint4*)(bk + (srow + 96) * NA_KS + sch * 8) = R3;                                                \
    *(uint4*)(bv + srow * NA_VS + sch * 8) = R4;                                                       \
    *(uint4*)(bv + (srow + 32) * NA_VS + sch * 8) = R5;                                                \
    *(uint4*)(bv + (srow + 64) * NA_VS + sch * 8) = R6;                                                \
    *(uint4*)(bv + (srow + 96) * NA_VS + sch * 8) = R7;                                                \
  }
  auto iter32 = [&](const h16* sKw, const h16* sVw, bool loc, int ridx) {
    f32x4 s0 = {0.f, 0.f, 0.f, 0.f}, s1 = {0.f, 0.f, 0.f, 0.f};
    const h16* kp = sKw + q_ * NA_KS + g * 8;
#pragma unroll
    for (int s = 0; s < 4; ++s) {
      const h16x8 ka = *(const h16x8*)(kp + s * 32);
      const h16x8 kb = *(const h16x8*)(kp + 16 * NA_KS + s * 32);
      s0 = mfma16(ka, qf[s], s0);
      s1 = mfma16(kb, qf[s], s1);
    }
    float sc[8];
#pragma unroll
    for (int i = 0; i < 4; ++i) { sc[i] = s0[i] * scale; sc[4 + i] = s1[i] * scale; }
    if (loc) {
#pragma unroll
      for (int i = 0; i < 8; ++i) {
        const int kcol = kstart + (i >> 2) * 16 + g * 4 + (i & 3);
        const bool valid = (kcol >= cstart) && (kcol < cstart + 16);
        const int cidx = min(max(kcol - qc + 15, 0), 30);
        const float bias = rpb[ridx * 31 + cidx];
        sc[i] = valid ? (sc[i] + bias) : -1e30f;
      }
    }
    float mx = sc[0];
#pragma unroll
    for (int i = 1; i < 8; ++i) mx = fmaxf(mx, sc[i]);
    mx = fmaxf(mx, __shfl_xor(mx, 16));
    mx = fmaxf(mx, __shfl_xor(mx, 32));
    const float mn = fmaxf(m, mx);
    const float alpha = fexp2(m - mn);
    m = mn;
    float ps = 0.f;
    h16x8 pf;
#pragma unroll
    for (int i = 0; i < 8; ++i) {
      const float pv = fexp2(sc[i] - mn);
      ps += pv;
      pf[i] = (h16)pv;
    }
    lsum = lsum * alpha + ps;
#pragma unroll
    for (int d = 0; d < 8; ++d) {
      o[d][0] *= alpha; o[d][1] *= alpha; o[d][2] *= alpha; o[d][3] *= alpha;
      const h16* vp = sVw + (d * 16 + q_) * NA_VS + g * 4;
      const h16x4 lo = *(const h16x4*)vp;
      const h16x4 hi = *(const h16x4*)(vp + 16);
      h16x8 vf;
      vf[0] = lo[0]; vf[1] = lo[1]; vf[2] = lo[2]; vf[3] = lo[3];
      vf[4] = hi[0]; vf[5] = hi[1]; vf[6] = hi[2]; vf[7] = hi[3];
      o[d] = mfma16(vf, pf, o[d]);
    }
  };
  auto iter64 = [&](const h16* sK0, const h16* sV0, const h16* sK1, const h16* sV1, bool loc, int ridx0, int ridx1) {
    f32x4 s00 = {0.f, 0.f, 0.f, 0.f}, s01 = s00, s10 = s00, s11 = s00;
    const h16* kp0 = sK0 + q_ * NA_KS + g * 8;
    const h16* kp1 = sK1 + q_ * NA_KS + g * 8;
#pragma unroll
    for (int s = 0; s < 4; ++s) {
      s00 = mfma16(*(const h16x8*)(kp0 + s * 32), qf[s], s00);
      s01 = mfma16(*(const h16x8*)(kp0 + 16 * NA_KS + s * 32), qf[s], s01);
      s10 = mfma16(*(const h16x8*)(kp1 + s * 32), qf[s], s10);
      s11 = mfma16(*(const h16x8*)(kp1 + 16 * NA_KS + s * 32), qf[s], s11);
    }
    float sc[16];
#pragma unroll
    for (int i = 0; i < 4; ++i) { sc[i] = s00[i] * scale; sc[4 + i] = s01[i] * scale; sc[8 + i] = s10[i] * scale; sc[12 + i] = s11[i] * scale; }
    if (loc) {
#pragma unroll
      for (int i = 0; i < 8; ++i) {
        const int kcol = kstart + (i >> 2) * 16 + g * 4 + (i & 3);
        const bool valid = (kcol >= cstart) && (kcol < cstart + 16);
        const int cidx = min(max(kcol - qc + 15, 0), 30);
        sc[i] = valid ? (sc[i] + rpb[ridx0 * 31 + cidx]) : -1e30f;
        sc[8 + i] = valid ? (sc[8 + i] + rpb[ridx1 * 31 + cidx]) : -1e30f;
      }
    }
    float mx = sc[0];
#pragma unroll
    for (int i = 1; i < 16; ++i) mx = fmaxf(mx, sc[i]);
    mx = fmaxf(mx, __shfl_xor(mx, 16));
    mx = fmaxf(mx, __shfl_xor(mx, 32));
    const float mn = fmaxf(m, mx);
    const float alpha = fexp2(m - mn);
    m = mn;
    float ps = 0.f;
    h16x8 pf0, pf1;
#pragma unroll
    for (int i = 0; i < 8; ++i) {
      const float pa = fexp2(sc[i] - mn), pb = fexp2(sc[8 + i] - mn);
      ps += pa + pb;
      pf0[i] = (h16)pa; pf1[i] = (h16)pb;
    }
    lsum = lsum * alpha + ps;
#pragma unroll
    for (int d = 0; d < 8; ++d) {
      o[d][0] *= alpha; o[d][1] *= alpha; o[d][2] *= alpha; o[d][3] *= alpha;
      const h16* vp0 = sV0 + (d * 16 + q_) * NA_VS + g * 4;
      const h16* vp1 = sV1 + (d * 16 + q_) * NA_VS + g * 4;
      const h16x4 lo0 = *(const h16x4*)vp0, hi0 = *(const h16x4*)(vp0 + 16);
      const h16x4 lo1 = *(const h16x4*)vp1, hi1 = *(const h16x4*)(vp1 + 16);
      h16x8 vf0, vf1;
      vf0[0] = lo0[0]; vf0[1] = lo0[1]; vf0[2] = lo0[2]; vf0[3] = lo0[3]; vf0[4] = hi0[0]; vf0[5] = hi0[1]; vf0[6] = hi0[2]; vf0[7] = hi0[3];
      vf1[0] = lo1[0]; vf1[1] = lo1[1]; vf1[2] = lo1[2]; vf1[3] = lo1[3]; vf1[4] = hi1[0]; vf1[5] = hi1[1]; vf1[6] = hi1[2]; vf1[7] = hi1[3];
      o[d] = mfma16(vf0, pf0, o[d]);
      o[d] = mfma16(vf1, pf1, o[d]);
    }
  };
  auto compute = [&](int t) {
    const h16* sK = smem + (t & 1) * NA_BUF;
    const h16* sV = sK + 128 * NA_KS;
    if (t < nloc) {
      const int kr0 = rs0 + 2 * t, kr1 = kr0 + 1;
      const bool m0 = (kr0 >= rsw) && (kr0 < rsw + 8);
      const bool m1 = (kr1 >= rsw) && (kr1 < rsw + 8);
      if (m0 && m1) iter64(sK + kstart * NA_KS, sV + kstart, sK + (64 + kstart) * NA_KS, sV + 64 + kstart, true, kr0 - rw + 7, kr1 - rw + 7);
      else if (m0) iter32(sK + kstart * NA_KS, sV + kstart, true, kr0 - rw + 7);
      else if (m1) iter32(sK + (64 + kstart) * NA_KS, sV + 64 + kstart, true, kr1 - rw + 7);
    } else {
      iter64(sK, sV, sK + 32 * NA_KS, sV + 32, false, 0, 0);
      iter64(sK + 64 * NA_KS, sV + 64, sK + 96 * NA_KS, sV + 96, false, 0, 0);
    }
  };
  NA_GLOAD(0, A0, A1, A2, A3, A4, A5, A6, A7);
  NA_SSTORE(0, A0, A1, A2, A3, A4, A5, A6, A7);
  NA_GLOAD(1, A0, A1, A2, A3, A4, A5, A6, A7);
  __syncthreads();
  for (int t = 0; t < T; ++t) {
    if (VAR != 1) compute(t);
    if (t + 1 < T && VAR != 2) NA_SSTORE((t + 1) & 1, A0, A1, A2, A3, A4, A5, A6, A7);
    if (t + 2 < T && VAR != 2) NA_GLOAD(t + 2, A0, A1, A2, A3, A4, A5, A6, A7);
    __syncthreads();
  }
  lsum += __shfl_xor(lsum, 16);
  lsum += __shfl_xor(lsum, 32);
  const float rl = 1.0f / lsum;
  h16* op = cat + qrow * 2048 + 512 + hd * 128 + g * 4;
#pragma unroll
  for (int d = 0; d < 8; ++d) store_h4(op + d * 16, o[d][0] * rl, o[d][1] * rl, o[d][2] * rl, o[d][3] * rl);
#undef NA_GLOAD
#undef NA_SSTORE
}

constexpr int MLA_KS = 200;
constexpr int MLA_VS = 72;
constexpr int MLA_BUF = 64 * MLA_KS + 128 * MLA_VS;
template <int VAR>
DEVI void mla_unit(const Params& p, int unit, h16* smem) {
  const h16* q1 = (const h16*)(p.ws + OFF_Q1);
  const h16* kn = (const h16*)(p.ws + OFF_KN);
  const h16* kr = (const h16*)(p.ws + OFF_KR);
  const h16* vT1 = (const h16*)(p.ws + OFF_VT1);
  h16* cat = VAR ? (h16*)p.out : (h16*)(p.ws + OFF_CAT);
  const int tid = tidx(), lane = tid & 63, wid = tid >> 6;
  const int qblk = unit & 15, bh = unit >> 4, hd = bh % 12, b = bh / 12;
  const int q_ = lane & 31, hh = lane >> 5;
  const size_t qrow = (size_t)b * 4096 + qblk * 256 + wid * 32 + q_;
  const h16* qp = q1 + qrow * 2304 + hd * 192 + hh * 8;
  h16x8 qf[12];
#pragma unroll
  for (int s = 0; s < 12; ++s) qf[s] = *(const h16x8*)(qp + s * 16);
  const int skey = tid >> 3, sc0 = tid & 7;
  const h16* gk = kn + ((size_t)b * 4352 + skey) * 1536 + hd * 128 + sc0 * 8;
  const h16* gr = kr + ((size_t)b * 4352 + skey) * 64 + sc0 * 8;
  const h16* gv = vT1 + ((size_t)(b * 12 + hd) * 128 + skey) * 4352 + sc0 * 8;
  uint4 rk0, rk1, rk2, rv0, rv1;
#define MLA_GLOAD(KT)                                             \
  {                                                               \
    const size_t key0 = (size_t)(KT) * 64;                        \
    rk0 = *(const uint4*)(gk + key0 * 1536);                      \
    rk1 = *(const uint4*)(gk + key0 * 1536 + 64);                 \
    rk2 = *(const uint4*)(gr + key0 * 64);                        \
    rv0 = *(const uint4*)(gv + key0);                             \
    rv1 = *(const uint4*)(gv + (size_t)64 * 4352 + key0);         \
  }
#define MLA_SSTORE(BUF)                                           \
  {                                                               \
    h16* bk = smem + (BUF) * MLA_BUF;                             \
    h16* bv = bk + 64 * MLA_KS;                                   \
    *(uint4*)(bk + skey * MLA_KS + sc0 * 8) = rk0;                \
    *(uint4*)(bk + skey * MLA_KS + 64 + sc0 * 8) = rk1;           \
    *(uint4*)(bk + skey * MLA_KS + 128 + sc0 * 8) = rk2;          \
    h16* d0 = bv + skey * MLA_VS + (sc0 >> 1) * 16 + (sc0 & 1) * 4;  \
    *(uint2*)d0 = make_uint2(rv0.x, rv0.y);                       \
    *(uint2*)(d0 + 8) = make_uint2(rv0.z, rv0.w);                 \
    h16* d1 = d0 + 64 * MLA_VS;                                   \
    *(uint2*)d1 = make_uint2(rv1.x, rv1.y);                       \
    *(uint2*)(d1 + 8) = make_uint2(rv1.z, rv1.w);                 \
  }
  f32x16 o[4];
#pragma unroll
  for (int d = 0; d < 4; ++d)
#pragma unroll
    for (int i = 0; i < 16; ++i) o[d][i] = 0.f;
  float m = -1e30f, lsum = 0.f;
  f32x16 sc, sn;
#define MLA_SUBSTEP(HAVE_NEXT, KNEXT, VCUR)                                                       \
  {                                                                                               \
    _Pragma("unroll") for (int i = 0; i < 16; ++i) sn[i] = 0.f;                                   \
    if (HAVE_NEXT) {                                                                              \
      const h16* kp = (KNEXT) + q_ * MLA_KS + hh * 8;                                             \
      _Pragma("unroll") for (int st = 0; st < 12; ++st) sn = mfma32(*(const h16x8*)(kp + st * 16), qf[st], sn); \
    }                                                                                             \
    float mx = sc[0];                                                                             \
    _Pragma("unroll") for (int i = 1; i < 16; ++i) mx = fmaxf(mx, sc[i]);                         \
    mx = fmaxf(mx, __shfl_xor(mx, 32));                                                           \
    const float mn = fmaxf(m, mx);                                                                \
    const float alpha = fexp2(m - mn);                                                            \
    m = mn;                                                                                       \
    float ps = 0.f;                                                                               \
    h16x8 pf0, pf1;                                                                               \
    _Pragma("unroll") for (int i = 0; i < 8; ++i) {                                               \
      const float pa = (VAR == 2) ? (sc[i] - mn) : fexp2(sc[i] - mn), pb = (VAR == 2) ? (sc[8 + i] - mn) : fexp2(sc[8 + i] - mn); \
      ps += pa + pb;                                                                              \
      pf0[i] = (h16)pa; pf1[i] = (h16)pb;                                                         \
    }                                                                                             \
    lsum = lsum * alpha + ps;                                                                     \
    __builtin_amdgcn_sched_group_barrier(0x100, 4, 0);                                            \
    _Pragma("unroll") for (int i = 0; i < 12; ++i) {                                              \
      __builtin_amdgcn_sched_group_barrier(0x008, 1, 0);                                          \
      __builtin_amdgcn_sched_group_barrier(0x002, 7, 0);                                          \
      __builtin_amdgcn_sched_group_barrier(0x100, 1, 0);                                          \
    }                                                                                             \
    if (__builtin_amdgcn_ballot_w64(alpha != 1.0f) != 0) {                                        \
      _Pragma("unroll") for (int d = 0; d < 4; ++d)                                               \
        _Pragma("unroll") for (int i = 0; i < 16; ++i) o[d][i] *= alpha;                          \
    }                                                                                             \
    _Pragma("unroll") for (int s2 = 0; s2 < 2; ++s2) {                                            \
      _Pragma("unroll") for (int d = 0; d < 4; ++d) {                                             \
        const h16x8 vf = *(const h16x8*)((VCUR) + (d * 32 + q_) * MLA_VS + s2 * 16 + hh * 8);     \
        if (VAR != 3) o[d] = mfma32(vf, s2 ? pf1 : pf0, o[d]); else o[d][0] += (float)vf[0] * (float)pf0[0]; \
      }                                                                                           \
    }                                                                                             \
    sc = sn;                                                                                      \
  }
  constexpr int NT = 4352 / 64;
  MLA_GLOAD(0);
  MLA_SSTORE(0);
  MLA_GLOAD(1);
  MLA_SSTORE(1);
  __syncthreads();
  {
#pragma unroll
    for (int i = 0; i < 16; ++i) sc[i] = 0.f;
    const h16* kp = smem + q_ * MLA_KS + hh * 8;
#pragma unroll
    for (int st = 0; st < 12; ++st) sc = mfma32(*(const h16x8*)(kp + st * 16), qf[st], sc);
  }
  int bc = 0;
  for (int kt = 0; kt < NT; ++kt) {
    const int bn = (bc == 2) ? 0 : bc + 1;
    const int bw = (bn == 2) ? 0 : bn + 1;
    const bool pre = kt + 2 < NT;
    if (pre && VAR != 1) MLA_GLOAD(kt + 2);
    const h16* sK = smem + bc * MLA_BUF;
    const h16* sV = sK + 64 * MLA_KS;
    const h16* sKn = smem + bn * MLA_BUF;
    MLA_SUBSTEP(true, sK + 32 * MLA_KS, sV);
    MLA_SUBSTEP(kt + 1 < NT, sKn, sV + 32);
    if (pre && VAR != 1) MLA_SSTORE(bw);
    __syncthreads();
    bc = bn;
  }
  lsum += __shfl_xor(lsum, 32);
  const float rl = 1.0f / lsum;
  h16* op = cat + qrow * 2048 + 512 + hd * 128 + hh * 4;
#pragma unroll
  for (int d = 0; d < 4; ++d)
#pragma unroll
    for (int i4 = 0; i4 < 4; ++i4)
      store_h4(op + d * 32 + i4 * 8, o[d][i4 * 4 + 0] * rl, o[d][i4 * 4 + 1] * rl, o[d][i4 * 4 + 2] * rl, o[d][i4 * 4 + 3] * rl);
#undef MLA_GLOAD
#undef MLA_SSTORE
#undef MLA_SUBSTEP
}

DEVI void l1_prep_phase(const Params& p) {
  const h16* p1 = (const h16*)(p.ws + OFF_P1);
  h16* cqn = (h16*)(p.ws + OFF_CQN);
  h16* ckvn = (h16*)(p.ws + OFF_CKVN);
  h16* kr = (h16*)(p.ws + OFF_KR);
  h16* cat = (h16*)(p.ws + OFF_CAT);
  const int tid_ = tidx(); const int lane = tid_ & 63, wid = tid_ >> 6;
  for (int row = blockIdx.x * 8 + wid; row < TA; row += gridDim.x * 8) {
    const h16* pr = p1 + (size_t)row * 2048;
    const bool lat = row < TL;
    {
      const h16x8 v = *(const h16x8*)(pr + 1280 + lane * 8);
      float f[8], ss = 0.f;
#pragma unroll
      for (int e = 0; e < 8; ++e) { f[e] = (float)v[e]; ss += f[e] * f[e]; }
      ss = wave_sum(ss);
      const float rstd = rsqrtf(ss * (1.0f / 512.0f) + 1e-6f);
      h16x8 o;
#pragma unroll
      for (int e = 0; e < 8; ++e) o[e] = (h16)(f[e] * rstd * p.mla_gkv[lane * 8 + e]);
      *(h16x8*)(ckvn + (size_t)row * 512 + lane * 8) = o;
    }
    {
      const float xv = (float)pr[1792 + lane];
      const float xo = __shfl_xor(xv, 16);
      float outv = xv;
      int b, key;
      if (lat) {
        const int t = row & 4095;
        b = row >> 12; key = 256 + t;
        const int fi = lane & 15;
        const int pos = (lane < 32) ? (t >> 6) : (t & 63);
        const float inv = fexp2(-(float)fi * (13.287712379549449f / 16.0f));
        const float rev = (float)pos * inv * 0.15915494309189535f;
        const float cs = cos_rev(rev), sn = sin_rev(rev);
        outv = (lane & 16) ? (xo * sn + xv * cs) : (xv * cs - xo * sn);
      } else {
        b = (row - TL) >> 8; key = (row - TL) & 255;
      }
      kr[((size_t)b * 4352 + key) * 64 + lane] = (h16)outv;
    }
    if (lat) {
      {
        float f[12], ss = 0.f;
#pragma unroll
        for (int i = 0; i < 3; ++i) {
          const h16x4 v = *(const h16x4*)(pr + 512 + (i * 64 + lane) * 4);
#pragma unroll
          for (int e = 0; e < 4; ++e) { f[i * 4 + e] = (float)v[e]; ss += f[i * 4 + e] * f[i * 4 + e]; }
        }
        ss = wave_sum(ss);
        const float rstd = rsqrtf(ss * (1.0f / 768.0f) + 1e-6f);
#pragma unroll
        for (int i = 0; i < 3; ++i) {
          const int col = (i * 64 + lane) * 4;
          store_h4(cqn + (size_t)row * 768 + col, f[i * 4 + 0] * rstd * p.mla_gq[col + 0], f[i * 4 + 1] * rstd * p.mla_gq[col + 1],
                   f[i * 4 + 2] * rstd * p.mla_gq[col + 2], f[i * 4 + 3] * rstd * p.mla_gq[col + 3]);
        }
      }
      {
        const int t = row & 4095;
        const int grp = lane >> 4;
        const int hw = 1 << grp;
        const int lo = max(t - hw, 0), hi = min(t + hw, 4096);
        float acc[8];
#pragma unroll
        for (int e = 0; e < 8; ++e) acc[e] = 0.f;
        const h16* base = p1 + (size_t)(row - t) * 2048 + lane * 8;
        for (int tt = lo; tt < hi; ++tt) {
          const h16x8 v = *(const h16x8*)(base + (size_t)tt * 2048);
#pragma unroll
          for (int e = 0; e < 8; ++e) acc[e] += (float)v[e];
        }
        const h16x8 self = *(const h16x8*)(pr + lane * 8);
        const float rc = 1.0f / (float)(hi - lo);
        h16x8 o;
#pragma unroll
        for (int e = 0; e < 8; ++e) o[e] = (h16)(acc[e] * rc - (float)self[e]);
        *(h16x8*)(cat + (size_t)row * 2048 + lane * 8) = o;
      }
    }
  }
}

#define XB_TMO      128
#define XB_XCNT(j)  (256  + 64 * (j))
#define XB_XSUB(j)  (1280 + 64 * (j))
#define XB_XGEN(j)  (2304 + 64 * (j))
#define XB_TOP      3328
#define XB_TOPGEN   3392
#define XCD_BAR_WORDS 3456
#define XB_SPIN_CAP (1u << 20)
DEVI unsigned xb_ld(unsigned* p) { return __hip_atomic_load(p, __ATOMIC_RELAXED, __HIP_MEMORY_SCOPE_AGENT); }
DEVI unsigned xb_add(unsigned* p, unsigned v) { return __hip_atomic_fetch_add(p, v, __ATOMIC_RELAXED, __HIP_MEMORY_SCOPE_AGENT); }
DEVI unsigned xb_xcc_id() { return (unsigned)__builtin_amdgcn_s_getreg((3 << 11) | 20) & 0xFu; }
#define XB_SPIN(cond, bar) do { unsigned _sp = 0; while (cond) { __builtin_amdgcn_s_sleep(0); \
    if ((++_sp & 255u) == 0u) { if (xb_ld(&(bar)[XB_TMO])) break; if (_sp > XB_SPIN_CAP) { atomicAdd(&(bar)[XB_TMO], 1u); break; } } } } while (0)
struct XcdBarrier { unsigned* bar; unsigned x; volatile __attribute__((address_space(3))) unsigned* st; };
DEVI XcdBarrier xcd_barrier_post(unsigned* bar, volatile __attribute__((address_space(3))) unsigned* st) {
  XcdBarrier b; b.bar = bar; b.x = xb_xcc_id(); b.st = st;
  if (threadIdx.x == 0) (void)xb_add(&bar[XB_XCNT(b.x)], 1u);
  return b;
}
DEVI void xcd_barrier_complete(unsigned* bar, unsigned x, unsigned& nloc, unsigned& nx) {
  const unsigned G = gridDim.x * gridDim.y * gridDim.z;
  unsigned sum, cnt, mine, sp = 0u;
  for (;;) {
    sum = 0u; cnt = 0u; mine = 0u;
#pragma unroll
    for (unsigned j = 0; j < 16; ++j) { const unsigned c = xb_ld(&bar[XB_XCNT(j)]); sum += c; cnt += (c > 0u) ? 1u : 0u; mine = (j == x) ? c : mine; }
    if (sum == G) break;
    __builtin_amdgcn_s_sleep(1);
    if ((++sp & 255u) == 0u) { if (xb_ld(&bar[XB_TMO])) break; if (sp > XB_SPIN_CAP) { atomicAdd(&bar[XB_TMO], 1u); break; } }
  }
  nloc = mine > 0u ? mine : 1u; nx = cnt > 0u ? cnt : 1u;
}
DEVI void xcd_barrier(const XcdBarrier& b) {
  asm volatile("s_waitcnt vmcnt(0)" ::: "memory");
  __syncthreads();
  if (threadIdx.x == 0) {
    unsigned* bar = b.bar;
    __builtin_amdgcn_s_waitcnt(0);
    unsigned nloc = b.st[0], nx = b.st[1];
    if (nloc == 0u) { xcd_barrier_complete(bar, b.x, nloc, nx); b.st[0] = nloc; b.st[1] = nx; }
    const unsigned old = xb_add(&bar[XB_XSUB(b.x)], 1u);
    const unsigned gen = old / nloc;
    if (old + 1u == (gen + 1u) * nloc) {
      __builtin_amdgcn_fence(__ATOMIC_RELEASE, "agent");
      asm volatile("s_waitcnt vmcnt(0)" ::: "memory");
      const unsigned og = xb_add(&bar[XB_TOP], 1u);
      const unsigned tg = og / nx;
      if (og + 1u == (tg + 1u) * nx) xb_add(&bar[XB_TOPGEN], 1u);
      else XB_SPIN(xb_ld(&bar[XB_TOPGEN]) == tg, bar);
      __builtin_amdgcn_fence(__ATOMIC_ACQUIRE, "agent");
      xb_add(&bar[XB_XGEN(b.x)], 1u);
      asm volatile("s_waitcnt vmcnt(0)" ::: "memory");
    } else {
      XB_SPIN(xb_ld(&bar[XB_XGEN(b.x)]) == gen, bar);
      __builtin_amdgcn_fence(__ATOMIC_ACQUIRE, "agent");
      asm volatile("s_waitcnt vmcnt(0)" ::: "memory");
    }
  }
  __syncthreads();
}

DEVI void run_phase(const Params& pin, int ph, h16* smem, bool dummy = false) {
  Params p = pin;
  asm volatile("" : "+s"(p.ws));
  char* ws = p.ws;
  float* mod = (float*)(ws + OFF_MOD);
  h16* xres = (h16*)(ws + OFF_XRES);
  h16* xout = xres;
  h16* hbuf = (h16*)(ws + OFF_H);
  h16* cat = (h16*)(ws + OFF_CAT);
  h16* act = (h16*)(ws + OFF_BIG);
  switch (ph) {
    case 0: phase0(p, (float*)smem); break;
    case 1: norm_mod_phase(p.x, p.ctx, TA, p.norm1_g, mod, 0, 1, hbuf); break;
    case 2: {
      EpiG1 e{(h16*)(ws + OFF_Q0), (h16*)(ws + OFF_K0), (h16*)(ws + OFF_VT0), (h16*)(ws + OFF_VCT0), (h16*)(ws + OFF_UCT), (h16*)(ws + OFF_UCTC)};
      run_gemm(smem, hbuf, (const h16*)(ws + OFF_WT_IN_AB), TA, 5632, 2048, e);
    } break;
    case 3: {
#ifdef DFT_PROBE
      const bool do_dft = true, do_na = !dummy;
#else
      const bool do_dft = !dummy, do_na = true;
#endif
      if (do_dft) {
        EpiDft e{cat, 0.0013810679320049757f, 0, 1};
        run_gemm(smem, (const h16*)(ws + OFF_DFTA), (const h16*)(ws + OFF_UCT), 2304, 2048, 8192, e);
      }
      if (do_dft) {
        EpiDft e{cat, 0.005524271728019903f, 1, 0};
        run_gemm(smem, (const h16*)(ws + OFF_DFTAC), (const h16*)(ws + OFF_UCTC), 256, 2048, 512, e, (int)((lbid() + gridDim.x - (128 % gridDim.x)) % gridDim.x));
      }
      const int xcd = lbid() & 7;
      int* ctr = (int*)(ws + OFF_CTR) + xcd * 8;
      int* su = (int*)smem;
      const int tid = tidx();
      for (; do_na;) {
        __syncthreads();
        if (tid == 0) su[0] = atomicAdd(ctr, 1);
        __syncthreads();
        const int u = su[0];
        if (u >= 204) break;
        const int bu = u < 192 ? (xcd * 192 + u) : (1536 + xcd * 12 + (u - 192));
#ifdef NA_PROBE_VAR
        if (dummy) na_block_unit<NA_PROBE_VAR>(p, bu, smem + 64); else
#endif
        na_block_unit<0>(p, bu, smem + 64);
      }
    } break;
    case 4: {
      EpiRes<float> e{p.x, p.ctx, xout, mod + 2 * 2048};
      run_gemm(smem, cat, (const h16*)(ws + OFF_WT_OUT_AB), TA, 2048, 2048, e);
      if (!dummy && gridDim.x == 256 && lbid() >= 32) prep_ffn_gu(p, 0, (float*)smem, lbid() - 32, 224);
      else if (!dummy && gridDim.x != 256) prep_ffn_gu(p, 0, (float*)smem, lbid(), (int)gridDim.x);
    } break;
    case 5: norm_mod_phase(xres, xres + (size_t)TL * 2048, TA, p.norm2_g, mod, 3, 4, hbuf); break;
    case 6: {
      EpiGU e{act};
      run_gemm(smem, hbuf, (const h16*)(ws + OFF_WT_GU0), TA, 11264, 2048, e);
      if (!dummy && gridDim.x == 256 && lbid() >= 176) prep_ffn_dn(p, 0, (float*)smem, lbid() - 176, 80);
      else if (!dummy && gridDim.x != 256) prep_ffn_dn(p, 0, (float*)smem, lbid(), (int)gridDim.x);
    } break;
    case 7: {
      EpiRes<h16> e{xres, xres + (size_t)TL * 2048, xout, mod + 5 * 2048};
      if (gridDim.x == 256) {
        run_gemm(smem, act, (const h16*)(ws + OFF_WT_D0), TL, 2048, DFF, e);
        if (!dummy) {
          const int c = lbid(), sp = c >> 5;
          if (c < 128) {
            EpiPartial ep{(float*)cat + (size_t)sp * TC * 2048};
            run_gemm(smem, act + (size_t)TL * DFF + sp * 1408, (const h16*)(ws + OFF_WT_D0) + sp * 1408, TC, 2048, 1408, ep, c & 31, DFF);
          } else {
            prep_layer1(p, (float*)smem, c - 128, 128, false);
          }
        }
      } else {
        run_gemm(smem, act, (const h16*)(ws + OFF_WT_D0), TA, 2048, DFF, e);
        if (!dummy) prep_layer1(p, (float*)smem, lbid(), (int)gridDim.x, false);
      }
    } break;
    case 8:
      if (gridDim.x == 256) {
        norm_mod_phase(xres, xres + (size_t)TL * 2048, TL, p.norm1_g + 2048, mod + 5 * 12288, 0, 1, hbuf);
        ctx_norm_partial_phase(xres + (size_t)TL * 2048, p.norm1_g + 2048, mod + 5 * 12288, 0, 1, hbuf, (const float*)cat, 4, mod + 4 * 12288 + 5 * 2048);
      } else norm_mod_phase(xres, xres + (size_t)TL * 2048, TA, p.norm1_g + 2048, mod + 5 * 12288, 0, 1, hbuf);
      break;
    case 9: {
      EpiStore e{(h16*)(ws + OFF_P1), 2048};
      run_gemm(smem, hbuf, (const h16*)(ws + OFF_WT_IN_CD), TA, 2048, 2048, e);
      if (!dummy && gridDim.x == 256 && lbid() >= 32) prep_ffn(p, 1, (float*)smem, lbid() - 32, 224);
      else if (!dummy && gridDim.x != 256) prep_ffn(p, 1, (float*)smem, lbid(), (int)gridDim.x);
    } break;
    case 10: l1_prep_phase(p); break;
    case 11: {
      EpiQ1 eq{(h16*)(ws + OFF_Q1)};
      run_gemm(smem, (const h16*)(ws + OFF_CQN), (const h16*)(ws + OFF_WT_UQ), TL, 2304, 768, eq);
      EpiKV1 ek{(h16*)(ws + OFF_KN), (h16*)(ws + OFF_VT1)};
      run_gemm(smem, (const h16*)(ws + OFF_CKVN), (const h16*)(ws + OFF_WT_UKV), TA, 3072, 512, ek, (int)((lbid() + gridDim.x - 64) % gridDim.x));
    } break;
    case 12: {
      if (gridDim.x == 256) {
        const int xcd = lbid() & 7, slot = lbid() >> 3;
        for (int i = 0; i < 3; ++i) mla_unit<0>(p, (xcd * 6 + i * 2 + (slot >> 4)) * 16 + (slot & 15), smem);
      } else {
        for (int u = lbid(); u < 768; u += gridDim.x) mla_unit<0>(p, u, smem);
      }
    } break;
#ifdef MLA_PROBE_VAR
    case 112: {
      const int xcd = lbid() & 7, slot = lbid() >> 3;
      for (int i = 0; i < 3; ++i) mla_unit<MLA_PROBE_VAR>(p, (xcd * 6 + i * 2 + (slot >> 4)) * 16 + (slot & 15), smem);
    } break;
#endif
    case 13: {
      EpiRes<h16> e{xres, xres + (size_t)TL * 2048, xout, mod + 5 * 12288 + 2 * 2048};
      run_gemm(smem, cat, (const h16*)(ws + OFF_WT_OUT_CD), TL, 2048, 2048, e);
    } break;
    case 14: norm_mod_phase(xres, xres + (size_t)TL * 2048, TL, p.norm2_g + 2048, mod + 5 * 12288, 3, 4, hbuf); break;
    case 15: {
      EpiGU e{act};
      run_gemm(smem, hbuf, (const h16*)(ws + OFF_WT_GU1), TL, 11264, 2048, e);
    } break;
    case 16: {
      EpiRes<h16> e{xres, xres + (size_t)TL * 2048, xout, mod + 5 * 12288 + 5 * 2048};
      run_gemm(smem, act, (const h16*)(ws + OFF_WT_D1), TL, 2048, DFF, e);
    } break;
    case 17: final_norm_phase(xres, p.final_g, p.out); break;
    default: break;
  }
}

__global__ void __launch_bounds__(512, 2) mega_kernel(Params p, int ph_lo, int ph_hi) {
  extern __shared__ __attribute__((aligned(16))) unsigned char shm[];
  h16* smem = (h16*)shm;
  unsigned* barw = (unsigned*)(p.ws + OFF_BAR);
  if (threadIdx.x == 0) {
    const unsigned x = xb_xcc_id();
    const unsigned r = xb_add(&barw[XCD_BAR_WORDS + (x & 15u)], 1u);
    g_sh[0] = make_uint4(0u, 0u, 0u, 0u);
    g_sh[1] = make_uint4(blockIdx.x, r, x, 0u);
  }
  __syncthreads();
  const XcdBarrier xb = xcd_barrier_post(barw, (volatile __attribute__((address_space(3))) unsigned*)&g_sh[0]);
#ifdef ONLY_PHASE
  run_phase(p, ONLY_PHASE, smem);
#else
#pragma unroll
  for (int ph = 0; ph < NPHASE; ++ph) {
    if (ph >= ph_lo && ph < ph_hi) {
      run_phase(p, ph, smem);
      if ((REPEAT_MASK >> ph) & 1) {
        xcd_barrier(xb);
        if (ph == 3) { if (blockIdx.x == 0 && threadIdx.x < 8) ((int*)(p.ws + OFF_CTR))[threadIdx.x * 8] = 0; xcd_barrier(xb); }
#ifdef MLA_PROBE_VAR
        run_phase(p, ph == 12 ? 112 : ph, smem, true);
#else
        run_phase(p, ph, smem, true);
#endif
      }
      if (ph + 1 < ph_hi) { if (ph_hi > 1000) cg::this_grid().sync(); else xcd_barrier(xb); }
      if (ph == 0) {
        if (threadIdx.x == 0) {
          bool ok = (gridDim.x == 256);
#pragma unroll
          for (unsigned j = 0; j < 16; ++j) { const unsigned cnt = xb_ld(&barw[XB_XCNT(j)]); ok = ok && (cnt == (j < 8 ? 32u : 0u)); }
          const uint4 me = g_sh[1];
          if (ok && me.z < 8u && me.y < 32u) g_sh[1].x = me.y * 8u + me.z;
        }
        __syncthreads();
      }
    }
  }
#ifdef EXTRA_SYNCS
  for (int i = 0; i < EXTRA_SYNCS; ++i) xcd_barrier(xb);
#endif
#endif
}

extern "C" void kernel_launch(void* const* d_in, const int* in_sizes, int n_in, void* d_out, int out_size, void* d_ws,
                              size_t ws_size, hipStream_t stream) {
  if (ws_size < WS_NEEDED) {
    fprintf(stderr, "workspace too small: have %zu need %zu\n", ws_size, (size_t)WS_NEEDED);
    return;
  }
  static int grid_blocks = 0;
  if (!grid_blocks) {
    int dev = 0, cus = 0, per_cu = 0;
    (void)hipGetDevice(&dev);
    (void)hipDeviceGetAttribute(&cus, hipDeviceAttributeMultiprocessorCount, dev);
    (void)hipFuncSetAttribute((const void*)mega_kernel, hipFuncAttributeMaxDynamicSharedMemorySize, SMEM_BYTES);
    (void)hipOccupancyMaxActiveBlocksPerMultiprocessor(&per_cu, mega_kernel, NTHR, SMEM_BYTES);
    if (per_cu > 1) per_cu = 1;
    grid_blocks = cus * per_cu;
  }
  Params p{};
  const float** pf = (const float**)&p;
  for (int i = 0; i < 24; ++i) pf[i] = (const float*)d_in[i];
  p.out = (float*)d_out;
  p.ws = (char*)d_ws;
  int lo = 0, hi = NPHASE;
  (void)hipMemsetAsync((char*)d_ws + OFF_BAR, 0, BAR_BYTES, stream);
  void* args[] = {&p, &lo, &hi};
  hipError_t e = hipLaunchCooperativeKernel((void*)mega_kernel, dim3(grid_blocks), dim3(NTHR), args, SMEM_BYTES, stream);
  if (e != hipSuccess) fprintf(stderr, "cooperative launch failed: %s (grid %d)\n", hipGetErrorString(e), grid_blocks);
}
```

```cpp
#include <hip/hip_runtime.h>
#include <hip/hip_cooperative_groups.h>
#include <cstdio>
#include <cstdint>
namespace cg = cooperative_groups;

typedef _Float16 h16;
typedef _Float16 h16x8 __attribute__((ext_vector_type(8)));
typedef _Float16 h16x4 __attribute__((ext_vector_type(4)));
typedef float f32x16 __attribute__((ext_vector_type(16)));
typedef float f32x4 __attribute__((ext_vector_type(4)));

#define DEVI __device__ __forceinline__

#ifndef SINGLE_LAUNCH
#define SINGLE_LAUNCH 1
#endif
#ifndef REPEAT_MASK
#define REPEAT_MASK 0x0
#endif

constexpr int DM = 2048;
constexpr int TL = 16384;
constexpr int TC = 1024;
constexpr int TA = 17408;
constexpr int DFF = 5632;
constexpr int NPHASE = 18;

constexpr size_t SZ_WT_IN_AB = (size_t)5632 * 2048 * 2;
constexpr size_t SZ_WT_OUT = (size_t)2048 * 2048 * 2;
constexpr size_t SZ_WT_GU = (size_t)11264 * 2048 * 2;
constexpr size_t SZ_WT_D = (size_t)2048 * 5632 * 2;
constexpr size_t SZ_WT_IN_CD = (size_t)2048 * 2048 * 2;
constexpr size_t SZ_WT_UQ = (size_t)2304 * 768 * 2;
constexpr size_t SZ_WT_UKV = (size_t)3072 * 512 * 2;
constexpr size_t SZ_DFTA = (size_t)4096 * 8192 * 2;
constexpr size_t SZ_DFTAC = (size_t)256 * 512 * 2;
constexpr size_t SZ_MOD = (size_t)2 * 5 * 12288 * 4;
constexpr size_t SZ_XRES = (size_t)TA * 2048 * 4;
constexpr size_t SZ_H = (size_t)TA * 2048 * 2;
constexpr size_t SZ_CAT = (size_t)TA * 2048 * 2;
constexpr size_t SZ_BIG = (size_t)TA * 5632 * 2;

constexpr size_t OFF_WT_IN_AB = 0;
constexpr size_t OFF_WT_OUT_AB = OFF_WT_IN_AB + SZ_WT_IN_AB;
constexpr size_t OFF_WT_GU0 = OFF_WT_OUT_AB + SZ_WT_OUT;
constexpr size_t OFF_WT_GU1 = OFF_WT_GU0 + SZ_WT_GU;
constexpr size_t OFF_WT_D0 = OFF_WT_GU1 + SZ_WT_GU;
constexpr size_t OFF_WT_D1 = OFF_WT_D0 + SZ_WT_D;
constexpr size_t OFF_WT_IN_CD = OFF_WT_D1 + SZ_WT_D;
constexpr size_t OFF_WT_UQ = OFF_WT_IN_CD + SZ_WT_IN_CD;
constexpr size_t OFF_WT_UKV = OFF_WT_UQ + SZ_WT_UQ;
constexpr size_t OFF_WT_OUT_CD = OFF_WT_UKV + SZ_WT_UKV;
constexpr size_t OFF_DFTA = OFF_WT_OUT_CD + SZ_WT_OUT;
constexpr size_t OFF_DFTAC = OFF_DFTA + SZ_DFTA;
constexpr size_t OFF_MOD = OFF_DFTAC + SZ_DFTAC;
constexpr size_t OFF_XRES = OFF_MOD + SZ_MOD;
constexpr size_t OFF_H = OFF_XRES + SZ_XRES;
constexpr size_t OFF_CAT = OFF_H + SZ_H;
constexpr size_t OFF_BIG = OFF_CAT + SZ_CAT;
constexpr size_t OFF_CTR = OFF_BIG + SZ_BIG;
constexpr size_t OFF_BAR = OFF_CTR + 256;
constexpr size_t BAR_BYTES = 16384;
constexpr size_t WS_NEEDED = OFF_BAR + BAR_BYTES;

constexpr size_t OFF_Q0 = OFF_BIG;
constexpr size_t OFF_K0 = OFF_Q0 + (size_t)TA * 1536 * 2;
constexpr size_t OFF_VT0 = OFF_K0 + (size_t)TA * 1536 * 2;
constexpr size_t OFF_VCT0 = OFF_VT0 + (size_t)48 * 128 * 4096 * 2;
constexpr size_t OFF_UCT = OFF_VCT0 + (size_t)48 * 128 * 256 * 2;
constexpr size_t OFF_UCTC = OFF_UCT + (size_t)2048 * 8192 * 2;
static_assert(OFF_UCTC + (size_t)2048 * 512 * 2 <= OFF_BIG + SZ_BIG, "layer0 scratch overflow");
constexpr size_t OFF_P1 = OFF_BIG;
constexpr size_t OFF_CQN = OFF_P1 + (size_t)TA * 2048 * 2;
constexpr size_t OFF_CKVN = OFF_CQN + (size_t)TL * 768 * 2;
constexpr size_t OFF_KR = OFF_CKVN + (size_t)TA * 512 * 2;
constexpr size_t OFF_Q1 = OFF_KR + (size_t)4 * 4352 * 64 * 2;
static_assert(OFF_Q1 + (size_t)TL * 2304 * 2 <= OFF_BIG + SZ_BIG, "layer1 scratch overflow");
constexpr size_t OFF_KN = OFF_H;
constexpr size_t OFF_VT1 = OFF_DFTA;
static_assert((size_t)4 * 4352 * 1536 * 2 <= SZ_H, "kn alias");
static_assert((size_t)48 * 128 * 4352 * 2 <= SZ_DFTA, "vt1 alias");

struct Params {
  const float *x, *c, *ctx, *c_ctx, *w_mod, *b_mod, *norm1_g, *norm2_g, *w_in_ab, *w_four, *na_rpb, *w_out_ab;
  const float *w_in_cd, *w_pool, *pool_scale, *mla_gq, *mla_gkv, *w_uq, *w_ukv, *w_out_cd;
  const float *w_ffn_gate, *w_ffn_up, *w_ffn_down, *final_g;
  float* out;
  char* ws;
};

constexpr int NTHR = 512;
constexpr int SMEM_BYTES = 147456;

__shared__ uint4 g_sh[2];
__device__ __forceinline__ int lbid() { return (int)g_sh[1].x; }
DEVI f32x16 mfma32(h16x8 a, h16x8 b, f32x16 c) { return __builtin_amdgcn_mfma_f32_32x32x16_f16(a, b, c, 0, 0, 0); }
DEVI f32x4 mfma16(h16x8 a, h16x8 b, f32x4 c) { return __builtin_amdgcn_mfma_f32_16x16x32_f16(a, b, c, 0, 0, 0); }
DEVI int tidx() { int t = threadIdx.x; asm volatile("" : "+v"(t)); return t; }
DEVI float wave_sum(float v) {
#pragma unroll
  for (int o = 32; o >= 1; o >>= 1) v += __shfl_xor(v, o);
  return v;
}
DEVI float fexp2(float x) { return __builtin_amdgcn_exp2f(x); }
DEVI float cos_rev(float r) { return __builtin_amdgcn_cosf(r); }
DEVI float sin_rev(float r) { return __builtin_amdgcn_sinf(r); }
DEVI float silu_f(float v) { return v * __builtin_amdgcn_rcpf(1.0f + __builtin_amdgcn_exp2f(-1.4426950408889634f * v)); }
DEVI float4 ld4f(const float* p) { return *(const float4*)p; }
DEVI float4 ldnt4(const float* p) { const f32x4 v = __builtin_nontemporal_load((const f32x4*)p); return make_float4(v[0], v[1], v[2], v[3]); }
DEVI void stnt4(float* p, const float4& v) { f32x4 t; t[0] = v.x; t[1] = v.y; t[2] = v.z; t[3] = v.w; __builtin_nontemporal_store(t, (f32x4*)p); }
DEVI float4 ld4f(const h16* p) { const h16x4 v = *(const h16x4*)p; return make_float4((float)v[0], (float)v[1], (float)v[2], (float)v[3]); }
DEVI void store_h8(h16* dst, const f32x4& a, const f32x4& b, float sc = 1.0f) {
  h16x8 v;
#pragma unroll
  for (int j = 0; j < 4; ++j) { v[j] = (h16)(a[j] * sc); v[4 + j] = (h16)(b[j] * sc); }
  *(h16x8*)dst = v;
}
DEVI void store_h4(h16* dst, float a, float b, float c, float d) {
  h16x4 v;
  v[0] = (h16)a; v[1] = (h16)b; v[2] = (h16)c; v[3] = (h16)d;
  *(h16x4*)dst = v;
}

#define LAS __attribute__((address_space(3)))
namespace g8 {
constexpr int BM = 256, BK = 64, HALF = 128, HTB = HALF * BK * 2, NXCD = 8, WGM = 8;
DEVI int lds_byte(int r, int c) { const int st = (r >> 4) * 2 + (c >> 5), rr = r & 15, cc = c & 31, ob = rr * 64 + cc * 2; return st * 1024 + (ob ^ (((ob >> 9) & 1) << 5)); }
DEVI void stage_rc(int b, int& R, int& C) { const int st = b / 1024, sb = b % 1024, swz = sb ^ (((sb >> 9) & 1) << 5); R = (st >> 1) * 16 + swz / 64; C = (st & 1) * 32 + (swz % 64) / 2; }
DEVI int perm32(int rho) { const int n = rho >> 4, i = rho & 15; return 8 * (i >> 2) + 4 * n + (i & 3); }
struct Unit { int pm, pn; };
struct Gemm { const h16* A; const h16* Bt; int M, N, K, ld; };
struct StaticOrder {
  int nM, nN, nwg, G, c;
  DEVI void init(int M, int N, int G_, int c_) { nM = M / BM; nN = N / BM; nwg = nM * nN; G = G_; c = c_; }
  DEVI bool next(int i, Unit& u) const {
    if (c < 0) return false;
    const long L = (long)i * G + c; if (L >= nwg) return false;
    int wgid = (int)L; { const int q = nwg / NXCD, r = nwg % NXCD, xcd = wgid % NXCD, off = wgid / NXCD; wgid = (xcd < r ? xcd * (q + 1) : r * (q + 1) + (xcd - r) * q) + off; }
    const int nig = WGM * nN, gid = wgid / nig, fm = gid * WGM, gsz = (nM - fm) < WGM ? (nM - fm) : WGM;
    u.pm = fm + ((wgid % nig) % gsz); u.pn = (wgid % nig) / gsz; return true;
  }
};

template <class Epi>
DEVI void gemm_phase(LAS unsigned char* lds, const Gemm g, const StaticOrder& S, const Epi& E) {
  const int tid = tidx(), wid = __builtin_amdgcn_readfirstlane(tid >> 6), lane = tid & 63, wr = wid >> 2, wc = wid & 3, fr = lane & 15, fq = lane >> 4;
  const int K = g.K, nt = K / BK;
  unsigned voffA[2], voffB[2];
#pragma unroll
  for (int i = 0; i < 2; ++i) { int R, C; stage_rc(tid * 16 + i * 8192, R, C); const int Rb = Epi::PERM ? ((R & ~31) + perm32(R & 31)) : R;
    voffA[i] = (unsigned)(R * g.ld + C) * 2u; voffB[i] = (unsigned)(Rb * g.ld + C) * 2u; }
  const size_t kstep = (size_t)(BK * 2);
  const size_t hstep = (size_t)HALF * g.ld * 2;
  const size_t tstep = 2 * hstep;
  const unsigned ldsw = (unsigned)wid * 1024u;
  const int aoff = lds_byte(wr * 64 + fr, fq * 8), boff = lds_byte(wc * 32 + fr, fq * 8);
#define G8_SA(b, h) (((b) * 2 + (h)) * HTB)
#define G8_SB(b, h) ((4 + (b) * 2 + (h)) * HTB)
#define G8_STAGE(bufoff, gbase, voff) do { _Pragma("unroll") for (int _i = 0; _i < 2; ++_i) \
    __builtin_amdgcn_global_load_lds((const unsigned*)((const char*)(gbase) + (voff)[_i]), (LAS unsigned*)(lds + (bufoff) + ldsw + _i * 8192), 16, 0, 0); } while (0)
#define G8_LDA(dst, b, h) do { _Pragma("unroll") for (int m = 0; m < 4; ++m) _Pragma("unroll") for (int k = 0; k < 2; ++k) dst[m][k] = *(const LAS h16x8*)(lds + G8_SA(b, h) + aoff + m * 2048 + k * 1024); } while (0)
#define G8_LDB(dst, b, h) do { _Pragma("unroll") for (int n = 0; n < 2; ++n) _Pragma("unroll") for (int k = 0; k < 2; ++k) dst[n][k] = *(const LAS h16x8*)(lds + G8_SB(b, h) + boff + n * 2048 + k * 1024); } while (0)
#define G8_MMA(ai, bj, At, Bt) do { __builtin_amdgcn_s_setprio(1); _Pragma("unroll") for (int m = 0; m < 4; ++m) _Pragma("unroll") for (int n = 0; n < 2; ++n) _Pragma("unroll") for (int k = 0; k < 2; ++k) \
    acc[ai][bj][m][n] = __builtin_amdgcn_mfma_f32_16x16x32_f16(Bt[n][k], At[m][k], acc[ai][bj][m][n], 0, 0, 0); __builtin_amdgcn_s_setprio(0); } while (0)
#define G8_WAIT_V(n) asm volatile("s_waitcnt vmcnt(" #n ")" ::: "memory")
#define G8_WAIT_L(n) asm volatile("s_waitcnt lgkmcnt(" #n ")" ::: "memory")
#define G8_BAR __builtin_amdgcn_s_barrier()
#define G8_SCHED __builtin_amdgcn_sched_barrier(0)
  Unit cur, nxt; int ui = 0;
  if (!S.next(0, cur)) return;
  f32x4 acc[2][2][4][2];
#pragma unroll
  for (int a = 0; a < 2; ++a)
#pragma unroll
    for (int b = 0; b < 2; ++b)
#pragma unroll
      for (int m = 0; m < 4; ++m)
#pragma unroll
        for (int n = 0; n < 2; ++n) acc[a][b][m][n] = (f32x4){0.f, 0.f, 0.f, 0.f};
  h16x8 At[4][2], B0[2][2], B1[2][2];
  const char* cA = (const char*)g.A + (size_t)cur.pm * tstep; const char* cB = (const char*)g.Bt + (size_t)cur.pn * tstep;
  G8_STAGE(G8_SB(0, 0), cB, voffB); G8_STAGE(G8_SA(0, 0), cA, voffA); G8_STAGE(G8_SB(0, 1), cB + hstep, voffB); G8_STAGE(G8_SA(0, 1), cA + hstep, voffA);
  if (wr == 1) G8_BAR;
  G8_WAIT_V(4); G8_BAR;
  G8_STAGE(G8_SB(1, 0), cB + kstep, voffB); G8_STAGE(G8_SA(1, 0), cA + kstep, voffA); G8_STAGE(G8_SB(1, 1), cB + hstep + kstep, voffB);
  G8_WAIT_V(6); G8_BAR;
  for (;;) {
    const bool has_next = S.next(ui + 1, nxt);
    const char* nA = has_next ? (const char*)g.A + (size_t)nxt.pm * tstep : cA; const char* nB = has_next ? (const char*)g.Bt + (size_t)nxt.pn * tstep : cB;
    for (int t = 0; t < nt; t += 2) {
      const bool last = (t == nt - 2);
      const char* a1 = cA + (size_t)(t + 1) * kstep;
      const char* a2 = last ? nA : cA + (size_t)(t + 2) * kstep; const char* b2 = last ? nB : cB + (size_t)(t + 2) * kstep;
      const char* a3 = a2 + kstep; const char* b3 = b2 + kstep;
      G8_LDB(B0, 0, 0); G8_SCHED; G8_LDA(At, 0, 0); G8_STAGE(G8_SA(1, 1), a1 + hstep, voffA);
      G8_WAIT_L(8); G8_BAR; G8_WAIT_L(0); G8_MMA(0, 0, At, B0); G8_BAR; G8_SCHED;
      G8_LDB(B1, 0, 1); G8_STAGE(G8_SB(0, 0), b2, voffB);
      G8_BAR; G8_WAIT_L(0); G8_MMA(0, 1, At, B1); G8_BAR;
      G8_LDA(At, 0, 1); G8_STAGE(G8_SA(0, 0), a2, voffA);
      G8_BAR; G8_WAIT_L(0); G8_MMA(1, 0, At, B0); G8_BAR; G8_SCHED;
      G8_STAGE(G8_SB(0, 1), b2 + hstep, voffB);
      G8_WAIT_V(6); G8_BAR; G8_MMA(1, 1, At, B1); G8_BAR;
      G8_LDB(B0, 1, 0); G8_SCHED; G8_LDA(At, 1, 0); G8_STAGE(G8_SA(0, 1), a2 + hstep, voffA);
      G8_WAIT_L(8); G8_BAR; G8_WAIT_L(0); G8_MMA(0, 0, At, B0); G8_BAR; G8_SCHED;
      G8_LDB(B1, 1, 1); G8_STAGE(G8_SB(1, 0), b3, voffB);
      G8_BAR; G8_WAIT_L(0); G8_MMA(0, 1, At, B1); G8_BAR;
      G8_LDA(At, 1, 1); G8_STAGE(G8_SA(1, 0), a3, voffA);
      G8_BAR; G8_WAIT_L(0); G8_MMA(1, 0, At, B0); G8_BAR; G8_SCHED;
      G8_STAGE(G8_SB(1, 1), b3 + hstep, voffB);
      G8_WAIT_V(6); G8_BAR; G8_MMA(1, 1, At, B1); G8_BAR;
    }
    E(acc, cur, wr, wc, fr, fq);
    if (!has_next) break;
#pragma unroll
    for (int a = 0; a < 2; ++a)
#pragma unroll
      for (int b = 0; b < 2; ++b)
#pragma unroll
        for (int m = 0; m < 4; ++m)
#pragma unroll
          for (int n = 0; n < 2; ++n) acc[a][b][m][n] = (f32x4){0.f, 0.f, 0.f, 0.f};
    cur = nxt; cA = nA; cB = nB; ++ui;
  }
  G8_WAIT_V(0);
  if (wr == 0) G8_BAR;
  G8_BAR;
#undef G8_SA
#undef G8_SB
#undef G8_STAGE
#undef G8_LDA
#undef G8_LDB
#undef G8_MMA
}
}
using g8::Unit;

template <class Epi>
DEVI void run_gemm(h16* smem, const h16* A, const h16* Bt, int M, int N, int K, const Epi& e, int c_override = -2, int ld = 0) {
  g8::Gemm g{A, Bt, M, N, K, ld ? ld : K};
  g8::StaticOrder S;
  S.init(M, N, (int)gridDim.x, c_override == -2 ? lbid() : c_override);
  g8::gemm_phase((LAS unsigned char*)smem, g, S, e);
}

#define E8_FOR                                      \
  _Pragma("unroll") for (int ai = 0; ai < 2; ++ai)   \
  _Pragma("unroll") for (int m = 0; m < 4; ++m)      \
  _Pragma("unroll") for (int bj = 0; bj < 2; ++bj)   \
  _Pragma("unroll") for (int n = 0; n < 2; ++n)
#define E8_ROW (u.pm * 256 + ai * 128 + wr * 64 + m * 16 + fr)
#define E8_COL (u.pn * 256 + bj * 128 + wc * 32 + n * 16 + fq * 4)
#define E8_COLP (u.pn * 256 + bj * 128 + wc * 32 + fq * 8 + n * 4)
typedef const f32x4 (&AccRef)[2][2][4][2];

#define E8P_FOR                                     \
  _Pragma("unroll") for (int ai = 0; ai < 2; ++ai)   \
  _Pragma("unroll") for (int m = 0; m < 4; ++m)      \
  _Pragma("unroll") for (int bj = 0; bj < 2; ++bj)
#define E8P_COL (u.pn * 256 + bj * 128 + wc * 32 + fq * 8)
struct EpiG1 {
  static constexpr bool PERM = true, AFTER_DRAIN = false;
  h16 *q0, *k0, *vT, *vcT, *ucT, *ucTc;
  DEVI void operator()(AccRef acc, const Unit& u, int wr, int wc, int fr, int fq) const {
    const bool isctx = u.pm >= 64;
    E8P_FOR {
      const int row = E8_ROW, col = E8P_COL;
      const f32x4 va = acc[ai][bj][m][0], vb = acc[ai][bj][m][1];
      int b, n_;
      if (!isctx) { b = row >> 12; n_ = row & 4095; } else { b = (row - TL) >> 8; n_ = (row - TL) & 255; }
      if (u.pn < 4) {
        const int g = u.pn, part = bj, mm = col & 127;
        const size_t ld = isctx ? 512 : 8192;
        h16* d = isctx ? ucTc + (size_t)((b * 4 + g) * 128 + mm) * 512 + part * 256 + n_
                       : ucT + (size_t)((b * 4 + g) * 128 + mm) * 8192 + part * 4096 + n_;
#pragma unroll
        for (int j = 0; j < 4; ++j) { d[j * ld] = (h16)va[j]; d[(4 + j) * ld] = (h16)vb[j]; }
      } else if (u.pn < 10) {
        store_h8(q0 + (size_t)row * 1536 + (col - 1024), va, vb);
      } else if (u.pn < 16) {
        store_h8(k0 + (size_t)row * 1536 + (col - 2560), va, vb);
      } else {
        const int c3 = col - 4096, hh = c3 >> 7, dv = c3 & 127;
        const size_t ld = isctx ? 256 : 4096;
        h16* d = isctx ? vcT + (size_t)((b * 12 + hh) * 128 + dv) * 256 + n_
                       : vT + (size_t)((b * 12 + hh) * 128 + dv) * 4096 + n_;
#pragma unroll
        for (int j = 0; j < 4; ++j) { d[j * ld] = (h16)va[j]; d[(4 + j) * ld] = (h16)vb[j]; }
      }
    }
  }
};

struct EpiDft {
  static constexpr bool PERM = true, AFTER_DRAIN = false;
  h16* cat; float scale; int is_ctx; int mirror;
  DEVI void operator()(AccRef acc, const Unit& u, int wr, int wc, int fr, int fq) const {
    E8P_FOR {
      const int row = E8_ROW, col = E8P_COL;
      const f32x4 va = acc[ai][bj][m][0], vb = acc[ai][bj][m][1];
      const int b = col >> 9, g = (col >> 7) & 3, mm = col & 127;
      const size_t rbase = is_ctx ? (size_t)(TL + b * 256) : (size_t)b * 4096;
      if (!mirror || row <= 2048) store_h8(cat + (rbase + row) * 2048 + g * 128 + mm, va, vb, scale);
      if (mirror && row >= 1 && row <= 2047) {
        h16* mr = cat + (rbase + (4096 - row)) * 2048 + g * 128;
        mr[(128 - mm) & 127] = (h16)(va[0] * scale);
#pragma unroll
        for (int j = 1; j < 4; ++j) mr[128 - mm - j] = (h16)(va[j] * scale);
#pragma unroll
        for (int j = 0; j < 4; ++j) mr[124 - mm - j] = (h16)(vb[j] * scale);
      }
    }
  }
};

DEVI void ld8f(const float* p, float (&o)[8]) { const float4 a = *(const float4*)p, b = *(const float4*)(p + 4); o[0] = a.x; o[1] = a.y; o[2] = a.z; o[3] = a.w; o[4] = b.x; o[5] = b.y; o[6] = b.z; o[7] = b.w; }
DEVI void ld8f(const h16* p, float (&o)[8]) { const h16x8 v = *(const h16x8*)p;
#pragma unroll
  for (int i = 0; i < 8; ++i) o[i] = (float)v[i]; }
template <class TS>
struct EpiRes {
  static constexpr bool PERM = true, AFTER_DRAIN = false;
  const TS *src_lat, *src_ctx;
  h16* xres; const float* gate;
  DEVI void operator()(AccRef acc, const Unit& u, int wr, int wc, int fr, int fq) const {
    const int midx = (u.pm < 64) ? (u.pm >> 4) : 4;
    float gt[2][8];
#pragma unroll
    for (int bj = 0; bj < 2; ++bj) ld8f(gate + midx * 12288 + u.pn * 256 + bj * 128 + wc * 32 + fq * 8, gt[bj]);
#pragma unroll
    for (int ai = 0; ai < 2; ++ai)
#pragma unroll
      for (int m = 0; m < 4; ++m)
#pragma unroll
        for (int bj = 0; bj < 2; ++bj) {
          const int row = u.pm * 256 + ai * 128 + wr * 64 + m * 16 + fr;
          const int col = u.pn * 256 + bj * 128 + wc * 32 + fq * 8;
          const f32x4 v0 = acc[ai][bj][m][0], v1 = acc[ai][bj][m][1];
          float sv[8];
          ld8f(u.pm < 64 ? src_lat + (size_t)row * 2048 + col : src_ctx + (size_t)(row - TL) * 2048 + col, sv);
          h16x8 o;
#pragma unroll
          for (int j = 0; j < 4; ++j) { o[j] = (h16)(sv[j] + gt[bj][j] * v0[j]); o[4 + j] = (h16)(sv[4 + j] + gt[bj][4 + j] * v1[j]); }
          *(h16x8*)(xres + (size_t)row * 2048 + col) = o;
        }
  }
};

struct EpiPartial {
  static constexpr bool PERM = false, AFTER_DRAIN = false;
  float* part;
  DEVI void operator()(AccRef acc, const Unit& u, int wr, int wc, int fr, int fq) const {
    E8_FOR {
      const int row = E8_ROW, col = E8_COL;
      *(f32x4*)(part + (size_t)row * 2048 + col) = acc[ai][bj][m][n];
    }
  }
};

struct EpiGU {
  static constexpr bool PERM = true, AFTER_DRAIN = false;
  h16* act;
  DEVI void operator()(AccRef acc, const Unit& u, int wr, int wc, int fr, int fq) const {
#pragma unroll
    for (int ai = 0; ai < 2; ++ai)
#pragma unroll
      for (int m = 0; m < 4; ++m) {
        const int row = u.pm * 256 + ai * 128 + wr * 64 + m * 16 + fr;
        const int ocol = u.pn * 128 + wc * 32 + fq * 8;
        const f32x4 g0 = acc[ai][0][m][0], g1 = acc[ai][0][m][1], u0 = acc[ai][1][m][0], u1 = acc[ai][1][m][1];
        h16x8 o;
#pragma unroll
        for (int j = 0; j < 4; ++j) { o[j] = (h16)(silu_f(g0[j]) * u0[j]); o[4 + j] = (h16)(silu_f(g1[j]) * u1[j]); }
        *(h16x8*)(act + (size_t)row * DFF + ocol) = o;
      }
  }
};

struct EpiStore {
  static constexpr bool PERM = true, AFTER_DRAIN = false;
  h16* dst; int ldd;
  DEVI void operator()(AccRef acc, const Unit& u, int wr, int wc, int fr, int fq) const {
    E8P_FOR {
      const int row = E8_ROW, col = E8P_COL;
      store_h8(dst + (size_t)row * ldd + col, acc[ai][bj][m][0], acc[ai][bj][m][1]);
    }
  }
};

constexpr float LOG2E = 1.4426950408889634f;

struct EpiQ1 {
  static constexpr bool PERM = false, AFTER_DRAIN = false;
  h16* q1;
  DEVI void operator()(AccRef acc, const Unit& u, int wr, int wc, int fr, int fq) const {
    const float qs = 0.07216878364870322f * LOG2E;
#pragma unroll
    for (int bj = 0; bj < 2; ++bj) {
      const int cgb = u.pn * 256 + bj * 128 + wc * 32;
      const int w = cgb % 192;
      if (w < 128) {
#pragma unroll
        for (int ai = 0; ai < 2; ++ai)
#pragma unroll
          for (int m = 0; m < 4; ++m)
#pragma unroll
            for (int n = 0; n < 2; ++n) {
              const int row = u.pm * 256 + ai * 128 + wr * 64 + m * 16 + fr;
              const f32x4 v = acc[ai][bj][m][n];
              store_h4(q1 + (size_t)row * 2304 + cgb + n * 16 + fq * 4, v[0] * qs, v[1] * qs, v[2] * qs, v[3] * qs);
            }
      } else {
        const int half = (w - 128) >> 5;
        float inv[4];
#pragma unroll
        for (int j = 0; j < 4; ++j) inv[j] = fexp2(-(float)(fq * 4 + j) * (13.287712379549449f / 16.0f)) * 0.15915494309189535f;
#pragma unroll
        for (int ai = 0; ai < 2; ++ai)
#pragma unroll
          for (int m = 0; m < 4; ++m) {
            const int row = u.pm * 256 + ai * 128 + wr * 64 + m * 16 + fr;
            const int t = row & 4095;
            const float pos = (float)(half ? (t & 63) : (t >> 6));
            const f32x4 a = acc[ai][bj][m][0], bb = acc[ai][bj][m][1];
            float o1[4], o2[4];
#pragma unroll
            for (int j = 0; j < 4; ++j) {
              const float rev = pos * inv[j];
              const float cs = cos_rev(rev), sn = sin_rev(rev);
              o1[j] = (a[j] * cs - bb[j] * sn) * qs;
              o2[j] = (a[j] * sn + bb[j] * cs) * qs;
            }
            h16* d = q1 + (size_t)row * 2304 + cgb + fq * 4;
            store_h4(d, o1[0], o1[1], o1[2], o1[3]);
            store_h4(d + 16, o2[0], o2[1], o2[2], o2[3]);
          }
      }
    }
  }
};

struct EpiKV1 {
  static constexpr bool PERM = true, AFTER_DRAIN = false;
  h16 *kn, *vT1;
  DEVI void operator()(AccRef acc, const Unit& u, int wr, int wc, int fr, int fq) const {
    const int hh = u.pn;
    E8P_FOR {
      const int row = E8_ROW;
      const f32x4 va = acc[ai][bj][m][0], vb = acc[ai][bj][m][1];
      int b, key;
      if (row < TL) { b = row >> 12; key = 256 + (row & 4095); } else { b = (row - TL) >> 8; key = (row - TL) & 255; }
      const int w = wc * 32 + fq * 8;
      if (bj == 0) {
        store_h8(kn + ((size_t)b * 4352 + key) * 1536 + hh * 128 + w, va, vb);
      } else {
        h16* d = vT1 + (size_t)((b * 12 + hh) * 128 + w) * 4352 + key;
#pragma unroll
        for (int j = 0; j < 4; ++j) { d[(size_t)j * 4352] = (h16)va[j]; d[(size_t)(4 + j) * 4352] = (h16)vb[j]; }
      }
    }
  }
};

DEVI void mod_units(const Params& p, float* smemf) {
  float* mod = (float*)(p.ws + OFF_MOD);
  const int tid = tidx();
  float* ss = smemf;
  float* red = smemf + 5 * 2048;
  for (int i = tid; i < 5 * 2048; i += NTHR) {
    const int s = i >> 11, k = i & 2047;
    const float v = s < 4 ? p.c[s * 2048 + k] : p.c_ctx[k];
    ss[i] = silu_f(v);
  }
  __syncthreads();
  for (int u = blockIdx.x; u < 768; u += gridDim.x) {
    const int l = u / 384, n0 = (u % 384) * 32;
    const int cl = (tid & 7) * 4, kg = tid >> 3;
    const float* wp = p.w_mod + ((size_t)l * 2048 + kg * 32) * 12288 + n0 + cl;
    float4 a0 = {0, 0, 0, 0}, a1 = a0, a2 = a0, a3 = a0, a4 = a0;
#pragma unroll 8
    for (int kk = 0; kk < 32; ++kk) {
      const float4 w = ldnt4(wp + (size_t)kk * 12288);
      const int k = kg * 32 + kk;
      const float s0 = ss[k], s1 = ss[2048 + k], s2 = ss[4096 + k], s3 = ss[6144 + k], s4 = ss[8192 + k];
      a0.x += s0 * w.x; a0.y += s0 * w.y; a0.z += s0 * w.z; a0.w += s0 * w.w;
      a1.x += s1 * w.x; a1.y += s1 * w.y; a1.z += s1 * w.z; a1.w += s1 * w.w;
      a2.x += s2 * w.x; a2.y += s2 * w.y; a2.z += s2 * w.z; a2.w += s2 * w.w;
      a3.x += s3 * w.x; a3.y += s3 * w.y; a3.z += s3 * w.z; a3.w += s3 * w.w;
      a4.x += s4 * w.x; a4.y += s4 * w.y; a4.z += s4 * w.z; a4.w += s4 * w.w;
    }
    *(float4*)(red + (kg * 5 + 0) * 32 + cl) = a0;
    *(float4*)(red + (kg * 5 + 1) * 32 + cl) = a1;
    *(float4*)(red + (kg * 5 + 2) * 32 + cl) = a2;
    *(float4*)(red + (kg * 5 + 3) * 32 + cl) = a3;
    *(float4*)(red + (kg * 5 + 4) * 32 + cl) = a4;
    __syncthreads();
    if (tid < 160) {
      const int s = tid >> 5, cc = tid & 31;
      float sum = 0.f;
#pragma unroll 16
      for (int g = 0; g < 64; ++g) sum += red[(g * 5 + s) * 32 + cc];
      mod[(size_t)(l * 5 + s) * 12288 + n0 + cc] = sum + p.b_mod[l * 12288 + n0 + cc];
    }
    __syncthreads();
  }
}

DEVI int maprow(int mode, int n) {
  if (mode == 0) return n;
  if (mode == 1) return (n >> 7) * 256 + (n & 127);
  return (n >> 7) * 256 + 128 + (n & 127);
}
DEVI unsigned pack_h2(float lo, float hi) {
  typedef _Float16 h16x2 __attribute__((ext_vector_type(2)));
  h16x2 v; v[0] = (h16)lo; v[1] = (h16)hi;
  return __builtin_bit_cast(unsigned, v);
}
DEVI void transpose_job(const float* __restrict__ src, int ldsrc, int K, int N, int ncol0, h16* __restrict__ dst,
                        int ldd, int dcol0, int mode, float* tile_base, int worker, int nworkers) {
  const int tid = tidx();
  const int half = tid >> 8, tl = tid & 255;
  h16* tile = (h16*)tile_base + half * (64 * 68);
  const int nkt = K >> 6, nnt = N >> 6;
  const int ntiles = nkt * nnt;
  const int kp2 = (tl >> 4) * 2, lc4 = (tl & 15) * 4;
  float4 cur[4], nxt[4];
  int t = worker * 2 + half;
  const int tstride = nworkers * 2;
  if (t < ntiles) {
    const int kt = t / nnt, nt = t - kt * nnt;
    const float* sp = src + (size_t)(kt * 64 + kp2) * ldsrc + ncol0 + nt * 64 + lc4;
    cur[0] = ldnt4(sp); cur[1] = ldnt4(sp + ldsrc);
    cur[2] = ldnt4(sp + (size_t)32 * ldsrc); cur[3] = ldnt4(sp + (size_t)33 * ldsrc);
  }
  for (int t0 = worker * 2; t0 < ntiles; t0 += tstride, t += tstride) {
    const bool active = t < ntiles;
    const int tn = t + tstride;
    if (tn < ntiles) {
      const int kt = tn / nnt, nt = tn - kt * nnt;
      const float* sp = src + (size_t)(kt * 64 + kp2) * ldsrc + ncol0 + nt * 64 + lc4;
      nxt[0] = ldnt4(sp); nxt[1] = ldnt4(sp + ldsrc);
      nxt[2] = ldnt4(sp + (size_t)32 * ldsrc); nxt[3] = ldnt4(sp + (size_t)33 * ldsrc);
    }
    const int kt = t / nnt, nt = t - kt * nnt;
    const int k0 = kt * 64, n0 = nt * 64;
    if (active) {
      unsigned* tw = (unsigned*)tile;
#pragma unroll
      for (int i = 0; i < 2; ++i) {
        const int kd = (i * 32 + kp2) >> 1;
        const float4 a = cur[2 * i], bq = cur[2 * i + 1];
        tw[(lc4 + 0) * 34 + kd] = pack_h2(a.x, bq.x);
        tw[(lc4 + 1) * 34 + kd] = pack_h2(a.y, bq.y);
        tw[(lc4 + 2) * 34 + kd] = pack_h2(a.z, bq.z);
        tw[(lc4 + 3) * 34 + kd] = pack_h2(a.w, bq.w);
      }
    }
    __syncthreads();
    if (active) {
      const int n = tl >> 2, ks = (tl & 3) * 16;
      const uint2* rp = (const uint2*)(tile + n * 68 + ks);
      const uint2 r0 = rp[0], r1 = rp[1], r2 = rp[2], r3 = rp[3];
      h16* d = dst + (size_t)maprow(mode, n0 + n) * ldd + dcol0 + k0 + ks;
      *(uint4*)d = make_uint4(r0.x, r0.y, r1.x, r1.y);
      *(uint4*)(d + 8) = make_uint4(r2.x, r2.y, r3.x, r3.y);
    }
    __syncthreads();
#pragma unroll
    for (int i = 0; i < 4; ++i) cur[i] = nxt[i];
  }
}

DEVI void dft_gen(const Params& p) {
  h16* A = (h16*)(p.ws + OFF_DFTA);
  h16* Ac = (h16*)(p.ws + OFF_DFTAC);
  const size_t nthr = (size_t)gridDim.x * NTHR;
  const size_t gtid = (size_t)blockIdx.x * NTHR + tidx();
  if (gtid < 8) ((int*)(p.ws + OFF_CTR))[gtid * 8] = 0;
  for (size_t ch = gtid; ch < (size_t)2304 * 1024; ch += nthr) {
    const int k = (int)(ch >> 10), n8 = (int)(ch & 1023) * 8;
    h16x8 o;
#pragma unroll
    for (int e = 0; e < 8; ++e) {
      const int nn = n8 + e;
      const int n = nn & 4095;
      const float rev = (float)((k * n) & 4095) * (1.0f / 4096.0f);
      o[e] = (h16)((nn < 4096) ? cos_rev(rev) : -sin_rev(rev));
    }
    *(h16x8*)(A + (size_t)k * 8192 + n8) = o;
  }
  for (size_t ch = gtid; ch < (size_t)256 * 64; ch += nthr) {
    const int k = (int)(ch >> 6), n8 = (int)(ch & 63) * 8;
    h16x8 o;
#pragma unroll
    for (int e = 0; e < 8; ++e) {
      const int nn = n8 + e;
      const int n = nn & 255;
      const float rev = (float)((k * n) & 255) * (1.0f / 256.0f);
      o[e] = (h16)((nn < 256) ? cos_rev(rev) : -sin_rev(rev));
    }
    *(h16x8*)(Ac + (size_t)k * 512 + n8) = o;
  }
  h16* z = (h16*)(p.ws + OFF_WT_IN_CD) + (size_t)1856 * 2048;
  for (size_t ch = gtid; ch < (size_t)192 * 2048 / 8; ch += nthr) {
    uint4 zz = {0, 0, 0, 0};
    *(uint4*)(z + ch * 8) = zz;
  }
}

DEVI void fold_uc(const Params& p, float* smemf) {
  h16* wt = (h16*)(p.ws + OFF_WT_IN_AB);
  float* wl = smemf;
  float* ct = smemf + 128 * 64;
  float* st = ct + 128;
  const int tid = tidx();
  for (int u = blockIdx.x; u < 128; u += gridDim.x) {
    const int kb = u >> 2, g = u & 3, k0 = kb * 64;
    for (int i = tid; i < 64 * 32; i += NTHR) {
      const int kk = i >> 5, c4 = (i & 31) * 4;
      const float4 v = *(const float4*)(p.w_in_ab + (size_t)(k0 + kk) * 5120 + g * 128 + c4);
      wl[(c4 + 0) * 64 + kk] = v.x; wl[(c4 + 1) * 64 + kk] = v.y; wl[(c4 + 2) * 64 + kk] = v.z; wl[(c4 + 3) * 64 + kk] = v.w;
    }
    if (tid < 128) { ct[tid] = cos_rev((float)tid * (1.0f / 128.0f)); st[tid] = sin_rev((float)tid * (1.0f / 128.0f)); }
    __syncthreads();
    const int kh = tid >> 8, t2 = tid & 255;
    const int part = t2 >> 7, m = t2 & 127;
    const float* tab = part ? st : ct;
    float acc[32];
#pragma unroll
    for (int i = 0; i < 32; ++i) acc[i] = 0.f;
    for (int c = 0; c < 128; ++c) {
      const float tw = tab[(c * m) & 127];
#pragma unroll
      for (int k4 = 0; k4 < 8; ++k4) {
        const float4 w = *(const float4*)(wl + c * 64 + kh * 32 + k4 * 4);
        acc[k4 * 4 + 0] += w.x * tw; acc[k4 * 4 + 1] += w.y * tw; acc[k4 * 4 + 2] += w.z * tw; acc[k4 * 4 + 3] += w.w * tw;
      }
    }
    h16* d = wt + (size_t)(g * 256 + t2) * 2048 + k0 + kh * 32;
#pragma unroll
    for (int c8 = 0; c8 < 4; ++c8) {
      h16x8 o;
#pragma unroll
      for (int e = 0; e < 8; ++e) o[e] = (h16)acc[c8 * 8 + e];
      *(h16x8*)(d + c8 * 8) = o;
    }
    __syncthreads();
  }
}

DEVI void fold_out(const float* __restrict__ wg, const float* __restrict__ ps, const float* __restrict__ w_out,
                   h16* __restrict__ wt, float* smemf, int worker, int nworkers) {
  float* wl = smemf;
  float* wgl = smemf + 128 * 64;
  const int tid = tidx();
  for (int u = worker; u < 128; u += nworkers) {
    const int g = u >> 5, j0 = (u & 31) * 64;
    for (int i = tid; i < 128 * 16; i += NTHR) {
      const int d = i >> 4, c4 = (i & 15) * 4;
      float4 v = *(const float4*)(w_out + (size_t)(g * 128 + d) * 2048 + j0 + c4);
      const float sc = ps ? ps[g * 128 + d] : 1.0f;
      v.x *= sc; v.y *= sc; v.z *= sc; v.w *= sc;
      *(float4*)(wl + d * 64 + c4) = v;
    }
    for (int i = tid; i < 128 * 32; i += NTHR) {
      const int c = i >> 5, d4 = (i & 31) * 4;
      *(float4*)(wgl + c * 132 + d4) = *(const float4*)(wg + (size_t)(g * 128 + c) * 128 + d4);
    }
    __syncthreads();
    const int j = tid & 63;
    const int cg_ = __builtin_amdgcn_readfirstlane(tid >> 6);
    float acc[16];
#pragma unroll
    for (int i = 0; i < 16; ++i) acc[i] = 0.f;
    const float* wgp = wgl + (cg_ * 16) * 132;
    for (int d4 = 0; d4 < 32; ++d4) {
      const float w0 = wl[(d4 * 4 + 0) * 64 + j], w1 = wl[(d4 * 4 + 1) * 64 + j], w2 = wl[(d4 * 4 + 2) * 64 + j], w3 = wl[(d4 * 4 + 3) * 64 + j];
#pragma unroll
      for (int cc = 0; cc < 16; ++cc) {
        const float4 gq = *(const float4*)(wgp + cc * 132 + d4 * 4);
        acc[cc] += gq.x * w0 + gq.y * w1 + gq.z * w2 + gq.w * w3;
      }
    }
    h16* dst = wt + (size_t)(j0 + j) * 2048 + g * 128 + cg_ * 16;
#pragma unroll
    for (int c8 = 0; c8 < 2; ++c8) {
      h16x8 o;
#pragma unroll
      for (int e = 0; e < 8; ++e) o[e] = (h16)acc[c8 * 8 + e];
      *(h16x8*)(dst + c8 * 8) = o;
    }
    __syncthreads();
  }
}

DEVI void prep_out_ab(const Params& p, float* smemf, int w, int nw) {
  fold_out(p.w_four, nullptr, p.w_out_ab, (h16*)(p.ws + OFF_WT_OUT_AB), smemf, w, nw);
  transpose_job(p.w_out_ab + (size_t)512 * 2048, 2048, 1536, 2048, 0, (h16*)(p.ws + OFF_WT_OUT_AB), 2048, 512, 0, smemf, w, nw);
}
DEVI void phase0(const Params& p, float* smemf) {
  const int w = blockIdx.x, nw = gridDim.x;
  mod_units(p, smemf);
  dft_gen(p);
  fold_uc(p, smemf);
  transpose_job(p.w_in_ab, 5120, 2048, 4608, 512, (h16*)(p.ws + OFF_WT_IN_AB) + (size_t)1024 * 2048, 2048, 0, 0, smemf, w, nw);
  if (nw != 256) prep_out_ab(p, smemf, w, nw);
}
DEVI void prep_ffn_gu(const Params& p, int l, float* smemf, int w, int nw) {
  h16* gu = (h16*)(p.ws + (l ? OFF_WT_GU1 : OFF_WT_GU0));
  transpose_job(p.w_ffn_gate + (size_t)l * 2048 * DFF, DFF, 2048, DFF, 0, gu, 2048, 0, 1, smemf, w, nw);
  transpose_job(p.w_ffn_up + (size_t)l * 2048 * DFF, DFF, 2048, DFF, 0, gu, 2048, 0, 2, smemf, w, nw);
}
DEVI void prep_ffn_dn(const Params& p, int l, float* smemf, int w, int nw) {
  h16* dn = (h16*)(p.ws + (l ? OFF_WT_D1 : OFF_WT_D0));
  transpose_job(p.w_ffn_down + (size_t)l * DFF * 2048, 2048, DFF, 2048, 0, dn, DFF, 0, 0, smemf, w, nw);
}
DEVI void prep_ffn(const Params& p, int l, float* smemf, int w, int nw) {
  prep_ffn_gu(p, l, smemf, w, nw);
  prep_ffn_dn(p, l, smemf, w, nw);
}
DEVI void prep_layer1(const Params& p, float* smemf, int w, int nw, bool with_ffn = true) {
  fold_out(p.w_pool, p.pool_scale, p.w_out_cd, (h16*)(p.ws + OFF_WT_OUT_CD), smemf, w, nw);
  transpose_job(p.w_out_cd + (size_t)512 * 2048, 2048, 1536, 2048, 0, (h16*)(p.ws + OFF_WT_OUT_CD), 2048, 512, 0, smemf, w, nw);
  transpose_job(p.w_in_cd, 1856, 2048, 1856, 0, (h16*)(p.ws + OFF_WT_IN_CD), 2048, 0, 0, smemf, w, nw);
  transpose_job(p.w_uq, 2304, 768, 2304, 0, (h16*)(p.ws + OFF_WT_UQ), 768, 0, 0, smemf, w, nw);
  transpose_job(p.w_ukv, 3072, 512, 3072, 0, (h16*)(p.ws + OFF_WT_UKV), 512, 0, 0, smemf, w, nw);
  if (with_ffn) prep_ffn(p, 1, smemf, w, nw);
}

template <class TS>
DEVI void norm_mod_phase(const TS* src_lat, const TS* src_ctx, int nrows, const float* gvec, const float* modl,
                         int sh_idx, int sc_idx, h16* dst) {
  const int tid_ = tidx();
  const int lane = tid_ & 63, wid = tid_ >> 6;
  const int w = blockIdx.x * 8 + wid, nw = gridDim.x * 8;
  const int rbeg = (int)(((long)w * nrows) / nw), rend = (int)(((long)(w + 1) * nrows) / nw);
  if (rbeg >= rend) return;
  float4 fa[8], fb[8], v[8], vn[8];
  int cur_midx = -1;
  {
    const TS* s = rbeg < TL ? src_lat + (size_t)rbeg * 2048 : src_ctx + (size_t)(rbeg - TL) * 2048;
#pragma unroll
    for (int i = 0; i < 8; ++i) v[i] = ld4f(s + (i * 64 + lane) * 4);
  }
  for (int row = rbeg; row < rend; ++row) {
    if (row + 1 < rend) {
      const int r2 = row + 1;
      const TS* s = r2 < TL ? src_lat + (size_t)r2 * 2048 : src_ctx + (size_t)(r2 - TL) * 2048;
#pragma unroll
      for (int i = 0; i < 8; ++i) vn[i] = ld4f(s + (i * 64 + lane) * 4);
    }
    const int midx = row < TL ? (row >> 12) : 4;
    if (midx != cur_midx) {
      cur_midx = midx;
      const float* shp = modl + (size_t)midx * 12288 + sh_idx * 2048;
      const float* scp = modl + (size_t)midx * 12288 + sc_idx * 2048;
#pragma unroll
      for (int i = 0; i < 8; ++i) {
        const int col = (i * 64 + lane) * 4;
        const float4 g = *(const float4*)(gvec + col);
        const float4 sc = *(const float4*)(scp + col);
        fb[i] = *(const float4*)(shp + col);
        fa[i].x = g.x * (1.f + sc.x); fa[i].y = g.y * (1.f + sc.y); fa[i].z = g.z * (1.f + sc.z); fa[i].w = g.w * (1.f + sc.w);
      }
    }
    float ss = 0.f;
#pragma unroll
    for (int i = 0; i < 8; ++i) ss += v[i].x * v[i].x + v[i].y * v[i].y + v[i].z * v[i].z + v[i].w * v[i].w;
    ss = wave_sum(ss);
    const float rstd = rsqrtf(ss * (1.0f / 2048.0f) + 1e-6f);
#pragma unroll
    for (int i = 0; i < 8; ++i) {
      const int col = (i * 64 + lane) * 4;
      store_h4(dst + (size_t)row * 2048 + col, v[i].x * rstd * fa[i].x + fb[i].x, v[i].y * rstd * fa[i].y + fb[i].y,
               v[i].z * rstd * fa[i].z + fb[i].z, v[i].w * rstd * fa[i].w + fb[i].w);
    }
#pragma unroll
    for (int i = 0; i < 8; ++i) v[i] = vn[i];
  }
}

DEVI void ctx_norm_partial_phase(const h16* src_ctx, const float* gvec, const float* modl, int sh_idx, int sc_idx, h16* dst,
                                 const float* part, int nsplit, const float* pgate) {
  const int tid_ = tidx();
  const int lane = tid_ & 63, wid = tid_ >> 6;
  const int w = blockIdx.x * 8 + wid, nw = gridDim.x * 8;
  const float* shp = modl + (size_t)4 * 12288 + sh_idx * 2048;
  const float* scp = modl + (size_t)4 * 12288 + sc_idx * 2048;
  for (int r = w; r < TC; r += nw) {
    float4 v[8];
    float ss = 0.f;
#pragma unroll
    for (int i = 0; i < 8; ++i) {
      const int col = (i * 64 + lane) * 4;
      float4 acc = make_float4(0.f, 0.f, 0.f, 0.f);
      for (int sp = 0; sp < nsplit; ++sp) {
        const float4 q = *(const float4*)(part + ((size_t)sp * TC + r) * 2048 + col);
        acc.x += q.x; acc.y += q.y; acc.z += q.z; acc.w += q.w;
      }
      const float4 gq = *(const float4*)(pgate + col);
      const float4 x = ld4f(src_ctx + (size_t)r * 2048 + col);
      v[i].x = x.x + gq.x * acc.x; v[i].y = x.y + gq.y * acc.y; v[i].z = x.z + gq.z * acc.z; v[i].w = x.w + gq.w * acc.w;
      ss += v[i].x * v[i].x + v[i].y * v[i].y + v[i].z * v[i].z + v[i].w * v[i].w;
    }
    ss = wave_sum(ss);
    const float rstd = rsqrtf(ss * (1.0f / 2048.0f) + 1e-6f);
#pragma unroll
    for (int i = 0; i < 8; ++i) {
      const int col = (i * 64 + lane) * 4;
      const float4 g = *(const float4*)(gvec + col);
      const float4 sh = *(const float4*)(shp + col);
      const float4 sc = *(const float4*)(scp + col);
      store_h4(dst + (size_t)(TL + r) * 2048 + col, v[i].x * rstd * g.x * (1.f + sc.x) + sh.x, v[i].y * rstd * g.y * (1.f + sc.y) + sh.y,
               v[i].z * rstd * g.z * (1.f + sc.z) + sh.z, v[i].w * rstd * g.w * (1.f + sc.w) + sh.w);
    }
  }
}

DEVI void final_norm_phase(const h16* xres, const float* gvec, float* out) {
  const int tid_ = tidx();
  const int lane = tid_ & 63, wid = tid_ >> 6;
  const int w = blockIdx.x * 8 + wid, nw = gridDim.x * 8;
  const int rbeg = (int)(((long)w * TL) / nw), rend = (int)(((long)(w + 1) * TL) / nw);
  if (rbeg >= rend) return;
  float4 fa[8], v[8], vn[8];
#pragma unroll
  for (int i = 0; i < 8; ++i) {
    fa[i] = *(const float4*)(gvec + (i * 64 + lane) * 4);
    v[i] = ld4f(xres + (size_t)rbeg * 2048 + (i * 64 + lane) * 4);
  }
  for (int row = rbeg; row < rend; ++row) {
    if (row + 1 < rend) {
#pragma unroll
      for (int i = 0; i < 8; ++i) vn[i] = ld4f(xres + (size_t)(row + 1) * 2048 + (i * 64 + lane) * 4);
    }
    float ss = 0.f;
#pragma unroll
    for (int i = 0; i < 8; ++i) ss += v[i].x * v[i].x + v[i].y * v[i].y + v[i].z * v[i].z + v[i].w * v[i].w;
    ss = wave_sum(ss);
    const float rstd = rsqrtf(ss * (1.0f / 2048.0f) + 1e-6f);
#pragma unroll
    for (int i = 0; i < 8; ++i) {
      float4 o;
      o.x = v[i].x * rstd * fa[i].x; o.y = v[i].y * rstd * fa[i].y; o.z = v[i].z * rstd * fa[i].z; o.w = v[i].w * rstd * fa[i].w;
      stnt4(out + (size_t)row * 2048 + (i * 64 + lane) * 4, o);
    }
#pragma unroll
    for (int i = 0; i < 8; ++i) v[i] = vn[i];
  }
}

constexpr int NA_KS = 136;
constexpr int NA_VS = 136;
constexpr int NA_BUF = 128 * NA_KS + 128 * NA_VS;
template <int VAR>
DEVI void na_block_unit(const Params& p, int bu, h16* smem) {
  const h16* q0 = (const h16*)(p.ws + OFF_Q0);
  const h16* k0 = (const h16*)(p.ws + OFF_K0);
  const h16* vT = (const h16*)(p.ws + OFF_VT0);
  const h16* vcT = (const h16*)(p.ws + OFF_VCT0);
  h16* cat = VAR ? (h16*)p.out : (h16*)(p.ws + OFF_CAT);
  const int tid = tidx(), lane = tid & 63, wid = tid >> 6;
  const int q_ = lane & 15, g = lane >> 4;
  const bool is_ctx = bu >= 1536;
  int bh, rp = 0, half = 0;
  if (!is_ctx) { rp = bu & 31; bh = bu >> 5; } else { const int uu = bu - 1536; half = uu & 1; bh = uu >> 1; }
  const int hd = bh % 12, b = bh / 12;
  const int rw = 2 * rp + (wid >> 2), j = wid & 3;
  const size_t qrow = is_ctx ? (size_t)(TL + b * 256 + half * 128 + wid * 16 + q_) : (size_t)(b * 4096 + rw * 64 + j * 16 + q_);
  const int rs0 = min(max(2 * rp - 4, 0), 56), rs1 = min(max(2 * rp - 3, 0), 56);
  const int nrows = is_ctx ? 0 : (rs1 - rs0 + 8);
  const int nloc = (nrows + 1) >> 1;
  const int T = nloc + 2;
  const int rsw = min(max(rw - 4, 0), 56);
  const h16* qp = q0 + qrow * 1536 + hd * 128 + g * 8;
  h16x8 qf[4];
#pragma unroll
  for (int s = 0; s < 4; ++s) qf[s] = *(const h16x8*)(qp + s * 32);
  f32x4 o[8];
#pragma unroll
  for (int d = 0; d < 8; ++d) { o[d][0] = 0.f; o[d][1] = 0.f; o[d][2] = 0.f; o[d][3] = 0.f; }
  float m = -1e30f, lsum = 0.f;
  const int kstart = min(max(j * 16 - 8, 0), 32);
  const int qc = j * 16 + q_;
  const int cstart = min(max(qc - 8, 0), 48);
  const float scale = 0.08838834764831845f * LOG2E;
  float* rpb = (float*)(smem + 2 * NA_BUF);
  if (!is_ctx && tid < 465) rpb[tid] = p.na_rpb[hd * 465 + tid] * LOG2E;
  const int srow = tid >> 4, sch = tid & 15;
  const h16* kloc = k0 + (size_t)b * 4096 * 1536 + hd * 128 + (size_t)srow * 1536 + sch * 8;
  const h16* kctx = k0 + ((size_t)TL + b * 256) * 1536 + hd * 128 + (size_t)srow * 1536 + sch * 8;
  const h16* vloc = vT + ((size_t)(b * 12 + hd) * 128 + srow) * 4096 + sch * 8;
  const h16* vctx = vcT + ((size_t)(b * 12 + hd) * 128 + srow) * 256 + sch * 8;
  uint4 A0, A1, A2, A3, A4, A5, A6, A7;
#define NA_GLOAD(t, R0, R1, R2, R3, R4, R5, R6, R7)                                                    \
  {                                                                                                    \
    if ((t) < nloc) {                                                                                  \
      const int krow = rs0 + 2 * (t);                        \
      const h16* kb = kloc + (size_t)krow * 64 * 1536;                                                 \
      const h16* vb = vloc + krow * 64;                                                                \
      R0 = *(const uint4*)kb; R1 = *(const uint4*)(kb + 32 * 1536);                                    \
      R2 = *(const uint4*)(kb + 64 * 1536); R3 = *(const uint4*)(kb + 96 * 1536);                      \
      R4 = *(const uint4*)vb; R5 = *(const uint4*)(vb + (size_t)32 * 4096);                            \
      R6 = *(const uint4*)(vb + (size_t)64 * 4096); R7 = *(const uint4*)(vb + (size_t)96 * 4096);      \
    } else {                                                                                           \
      const int c = (t) - nloc;                                                                        \
      const h16* kb = kctx + (size_t)c * 128 * 1536;                                                   \
      const h16* vb = vctx + c * 128;                                                                  \
      R0 = *(const uint4*)kb; R1 = *(const uint4*)(kb + 32 * 1536);                                    \
      R2 = *(const uint4*)(kb + 64 * 1536); R3 = *(const uint4*)(kb + 96 * 1536);                      \
      R4 = *(const uint4*)vb; R5 = *(const uint4*)(vb + 32 * 256);                                     \
      R6 = *(const uint4*)(vb + 64 * 256); R7 = *(const uint4*)(vb + 96 * 256);                        \
    }                                                                                                  \
  }
#define NA_SSTORE(buf, R0, R1, R2, R3, R4, R5, R6, R7)                                                 \
  {                                                                                                    \
    h16* bk = smem + (buf) * NA_BUF;                                                                   \
    h16* bv = bk + 128 * NA_KS;                                                                        \
    *(uint4*)(bk + srow * NA_KS + sch * 8) = R0;                                                       \
    *(uint4*)(bk + (srow + 32) * NA_KS + sch * 8) = R1;                                                \
    *(uint4*)(bk + (srow + 64) * NA_KS + sch * 8) = R2;                                                \
    *(uint4*)(bk + (srow + 96) * NA_KS + sch * 8) = R3;                                                \
    *(uint4*)(bv + srow * NA_VS + sch * 8) = R4;                                                       \
    *(uint4*)(bv + (srow + 32) * NA_VS + sch * 8) = R5;                                                \
    *(uint4*)(bv + (srow + 64) * NA_VS + sch * 8) = R6;                                                \
    *(uint4*)(bv + (srow + 96) * NA_VS + sch * 8) = R7;                                                \
  }
  auto iter32 = [&](const h16* sKw, const h16* sVw, bool loc, int ridx) {
    f32x4 s0 = {0.f, 0.f, 0.f, 0.f}, s1 = {0.f, 0.f, 0.f, 0.f};
    const h16* kp = sKw + q_ * NA_KS + g * 8;
#pragma unroll
    for (int s = 0; s < 4; ++s) {
      const h16x8 ka = *(const h16x8*)(kp + s * 32);
      const h16x8 kb = *(const h16x8*)(kp + 16 * NA_KS + s * 32);
      s0 = mfma16(ka, qf[s], s0);
      s1 = mfma16(kb, qf[s], s1);
    }
    float sc[8];
#pragma unroll
    for (int i = 0; i < 4; ++i) { sc[i] = s0[i] * scale; sc[4 + i] = s1[i] * scale; }
    if (loc) {
#pragma unroll
      for (int i = 0; i < 8; ++i) {
        const int kcol = kstart + (i >> 2) * 16 + g * 4 + (i & 3);
        const bool valid = (kcol >= cstart) && (kcol < cstart + 16);
        const int cidx = min(max(kcol - qc + 15, 0), 30);
        const float bias = rpb[ridx * 31 + cidx];
        sc[i] = valid ? (sc[i] + bias) : -1e30f;
      }
    }
    float mx = sc[0];
#pragma unroll
    for (int i = 1; i < 8; ++i) mx = fmaxf(mx, sc[i]);
    mx = fmaxf(mx, __shfl_xor(mx, 16));
    mx = fmaxf(mx, __shfl_xor(mx, 32));
    const float mn = fmaxf(m, mx);
    const float alpha = fexp2(m - mn);
    m = mn;
    float ps = 0.f;
    h16x8 pf;
#pragma unroll
    for (int i = 0; i < 8; ++i) {
      const float pv = fexp2(sc[i] - mn);
      ps += pv;
      pf[i] = (h16)pv;
    }
    lsum = lsum * alpha + ps;
#pragma unroll
    for (int d = 0; d < 8; ++d) {
      o[d][0] *= alpha; o[d][1] *= alpha; o[d][2] *= alpha; o[d][3] *= alpha;
      const h16* vp = sVw + (d * 16 + q_) * NA_VS + g * 4;
      const h16x4 lo = *(const h16x4*)vp;
      const h16x4 hi = *(const h16x4*)(vp + 16);
      h16x8 vf;
      vf[0] = lo[0]; vf[1] = lo[1]; vf[2] = lo[2]; vf[3] = lo[3];
      vf[4] = hi[0]; vf[5] = hi[1]; vf[6] = hi[2]; vf[7] = hi[3];
      o[d] = mfma16(vf, pf, o[d]);
    }
  };
  auto iter64 = [&](const h16* sK0, const h16* sV0, const h16* sK1, const h16* sV1, bool loc, int ridx0, int ridx1) {
    f32x4 s00 = {0.f, 0.f, 0.f, 0.f}, s01 = s00, s10 = s00, s11 = s00;
    const h16* kp0 = sK0 + q_ * NA_KS + g * 8;
    const h16* kp1 = sK1 + q_ * NA_KS + g * 8;
#pragma unroll
    for (int s = 0; s < 4; ++s) {
      s00 = mfma16(*(const h16x8*)(kp0 + s * 32), qf[s], s00);
      s01 = mfma16(*(const h16x8*)(kp0 + 16 * NA_KS + s * 32), qf[s], s01);
      s10 = mfma16(*(const h16x8*)(kp1 + s * 32), qf[s], s10);
      s11 = mfma16(*(const h16x8*)(kp1 + 16 * NA_KS + s * 32), qf[s], s11);
    }
    float sc[16];
#pragma unroll
    for (int i = 0; i < 4; ++i) { sc[i] = s00[i] * scale; sc[4 + i] = s01[i] * scale; sc[8 + i] = s10[i] * scale; sc[12 + i] = s11[i] * scale; }
    if (loc) {
#pragma unroll
      for (int i = 0; i < 8; ++i) {
        const int kcol = kstart + (i >> 2) * 16 + g * 4 + (i & 3);
        const bool valid = (kcol >= cstart) && (kcol < cstart + 16);
        const int cidx = min(max(kcol - qc + 15, 0), 30);
        sc[i] = valid ? (sc[i] + rpb[ridx0 * 31 + cidx]) : -1e30f;
        sc[8 + i] = valid ? (sc[8 + i] + rpb[ridx1 * 31 + cidx]) : -1e30f;
      }
    }
    float mx = sc[0];
#pragma unroll
    for (int i = 1; i < 16; ++i) mx = fmaxf(mx, sc[i]);
    mx = fmaxf(mx, __shfl_xor(mx, 16));
    mx = fmaxf(mx, __shfl_xor(mx, 32));
    const float mn = fmaxf(m, mx);
    const float alpha = fexp2(m - mn);
    m = mn;
    float ps = 0.f;
    h16x8 pf0, pf1;
#pragma unroll
    for (int i = 0; i < 8; ++i) {
      const float pa = fexp2(sc[i] - mn), pb = fexp2(sc[8 + i] - mn);
      ps += pa + pb;
      pf0[i] = (h16)pa; pf1[i] = (h16)pb;
    }
    lsum = lsum * alpha + ps;
#pragma unroll
    for (int d = 0; d < 8; ++d) {
      o[d][0] *= alpha; o[d][1] *= alpha; o[d][2] *= alpha; o[d][3] *= alpha;
      const h16* vp0 = sV0 + (d * 16 + q_) * NA_VS + g * 4;
      const h16* vp1 = sV1 + (d * 16 + q_) * NA_VS + g * 4;
      const h16x4 lo0 = *(const h16x4*)vp0, hi0 = *(const h16x4*)(vp0 + 16);
      const h16x4 lo1 = *(const h16x4*)vp1, hi1 = *(const h16x4*)(vp1 + 16);
      h16x8 vf0, vf1;
      vf0[0] = lo0[0]; vf0[1] = lo0[1]; vf0[2] = lo0[2]; vf0[3] = lo0[3]; vf0[4] = hi0[0]; vf0[5] = hi0[1]; vf0[6] = hi0[2]; vf0[7] = hi0[3];
      vf1[0] = lo1[0]; vf1[1] = lo1[1]; vf1[2] = lo1[2]; vf1[3] = lo1[3]; vf1[4] = hi1[0]; vf1[5] = hi1[1]; vf1[6] = hi1[2]; vf1[7] = hi1[3];
      o[d] = mfma16(vf0, pf0, o[d]);
      o[d] = mfma16(vf1, pf1, o[d]);
    }
  };
  auto compute = [&](int t) {
    const h16* sK = smem + (t & 1) * NA_BUF;
    const h16* sV = sK + 128 * NA_KS;
    if (t < nloc) {
      const int kr0 = rs0 + 2 * t, kr1 = kr0 + 1;
      const bool m0 = (kr0 >= rsw) && (kr0 < rsw + 8);
      const bool m1 = (kr1 >= rsw) && (kr1 < rsw + 8);
      if (m0 && m1) iter64(sK + kstart * NA_KS, sV + kstart, sK + (64 + kstart) * NA_KS, sV + 64 + kstart, true, kr0 - rw + 7, kr1 - rw + 7);
      else if (m0) iter32(sK + kstart * NA_KS, sV + kstart, true, kr0 - rw + 7);
      else if (m1) iter32(sK + (64 + kstart) * NA_KS, sV + 64 + kstart, true, kr1 - rw + 7);
    } else {
      iter64(sK, sV, sK + 32 * NA_KS, sV + 32, false, 0, 0);
      iter64(sK + 64 * NA_KS, sV + 64, sK + 96 * NA_KS, sV + 96, false, 0, 0);
    }
  };
  NA_GLOAD(0, A0, A1, A2, A3, A4, A5, A6, A7);
  NA_SSTORE(0, A0, A1, A2, A3, A4, A5, A6, A7);
  NA_GLOAD(1, A0, A1, A2, A3, A4, A5, A6, A7);
  __syncthreads();
  for (int t = 0; t < T; ++t) {
    if (VAR != 1) compute(t);
    if (t + 1 < T && VAR != 2) NA_SSTORE((t + 1) & 1, A0, A1, A2, A3, A4, A5, A6, A7);
    if (t + 2 < T && VAR != 2) NA_GLOAD(t + 2, A0, A1, A2, A3, A4, A5, A6, A7);
    __syncthreads();
  }
  lsum += __shfl_xor(lsum, 16);
  lsum += __shfl_xor(lsum, 32);
  const float rl = 1.0f / lsum;
  h16* op = cat + qrow * 2048 + 512 + hd * 128 + g * 4;
#pragma unroll
  for (int d = 0; d < 8; ++d) store_h4(op + d * 16, o[d][0] * rl, o[d][1] * rl, o[d][2] * rl, o[d][3] * rl);
#undef NA_GLOAD
#undef NA_SSTORE
}

constexpr int MLA_KS = 200;
constexpr int MLA_VS = 72;
constexpr int MLA_BUF = 64 * MLA_KS + 128 * MLA_VS;
template <int VAR>
DEVI void mla_unit(const Params& p, int unit, h16* smem) {
  const h16* q1 = (const h16*)(p.ws + OFF_Q1);
  const h16* kn = (const h16*)(p.ws + OFF_KN);
  const h16* kr = (const h16*)(p.ws + OFF_KR);
  const h16* vT1 = (const h16*)(p.ws + OFF_VT1);
  h16* cat = VAR ? (h16*)p.out : (h16*)(p.ws + OFF_CAT);
  const int tid = tidx(), lane = tid & 63, wid = tid >> 6;
  const int qblk = unit & 15, bh = unit >> 4, hd = bh % 12, b = bh / 12;
  const int q_ = lane & 31, hh = lane >> 5;
  const size_t qrow = (size_t)b * 4096 + qblk * 256 + wid * 32 + q_;
  const h16* qp = q1 + qrow * 2304 + hd * 192 + hh * 8;
  h16x8 qf[12];
#pragma unroll
  for (int s = 0; s < 12; ++s) qf[s] = *(const h16x8*)(qp + s * 16);
  const int skey = tid >> 3, sc0 = tid & 7;
  const h16* gk = kn + ((size_t)b * 4352 + skey) * 1536 + hd * 128 + sc0 * 8;
  const h16* gr = kr + ((size_t)b * 4352 + skey) * 64 + sc0 * 8;
  const h16* gv = vT1 + ((size_t)(b * 12 + hd) * 128 + skey) * 4352 + sc0 * 8;
  uint4 rk0, rk1, rk2, rv0, rv1;
#define MLA_GLOAD(KT)                                             \
  {                                                               \
    const size_t key0 = (size_t)(KT) * 64;                        \
    rk0 = *(const uint4*)(gk + key0 * 1536);                      \
    rk1 = *(const uint4*)(gk + key0 * 1536 + 64);                 \
    rk2 = *(const uint4*)(gr + key0 * 64);                        \
    rv0 = *(const uint4*)(gv + key0);                             \
    rv1 = *(const uint4*)(gv + (size_t)64 * 4352 + key0);         \
  }
#define MLA_SSTORE(BUF)                                           \
  {                                                               \
    h16* bk = smem + (BUF) * MLA_BUF;                             \
    h16* bv = bk + 64 * MLA_KS;                                   \
    *(uint4*)(bk + skey * MLA_KS + sc0 * 8) = rk0;                \
    *(uint4*)(bk + skey * MLA_KS + 64 + sc0 * 8) = rk1;           \
    *(uint4*)(bk + skey * MLA_KS + 128 + sc0 * 8) = rk2;          \
    h16* d0 = bv + skey * MLA_VS + (sc0 >> 1) * 16 + (sc0 & 1) * 4;  \
    *(uint2*)d0 = make_uint2(rv0.x, rv0.y);                       \
    *(uint2*)(d0 + 8) = make_uint2(rv0.z, rv0.w);                 \
    h16* d1 = d0 + 64 * MLA_VS;                                   \
    *(uint2*)d1 = make_uint2(rv1.x, rv1.y);                       \
    *(uint2*)(d1 + 8) = make_uint2(rv1.z, rv1.w);                 \
  }
  f32x16 o[4];
#pragma unroll
  for (int d = 0; d < 4; ++d)
#pragma unroll
    for (int i = 0; i < 16; ++i) o[d][i] = 0.f;
  float m = -1e30f, lsum = 0.f;
  f32x16 sc, sn;
#define MLA_SUBSTEP(HAVE_NEXT, KNEXT, VCUR)                                                       \
  {                                                                                               \
    _Pragma("unroll") for (int i = 0; i < 16; ++i) sn[i] = 0.f;                                   \
    if (HAVE_NEXT) {                                                                              \
      const h16* kp = (KNEXT) + q_ * MLA_KS + hh * 8;                                             \
      _Pragma("unroll") for (int st = 0; st < 12; ++st) sn = mfma32(*(const h16x8*)(kp + st * 16), qf[st], sn); \
    }                                                                                             \
    float mx = sc[0];                                                                             \
    _Pragma("unroll") for (int i = 1; i < 16; ++i) mx = fmaxf(mx, sc[i]);                         \
    mx = fmaxf(mx, __shfl_xor(mx, 32));                                                           \
    const float mn = fmaxf(m, mx);                                                                \
    const float alpha = fexp2(m - mn);                                                            \
    m = mn;                                                                                       \
    float ps = 0.f;                                                                               \
    h16x8 pf0, pf1;                                                                               \
    _Pragma("unroll") for (int i = 0; i < 8; ++i) {                                               \
      const float pa = (VAR == 2) ? (sc[i] - mn) : fexp2(sc[i] - mn), pb = (VAR == 2) ? (sc[8 + i] - mn) : fexp2(sc[8 + i] - mn); \
      ps += pa + pb;                                                                              \
      pf0[i] = (h16)pa; pf1[i] = (h16)pb;                                                         \
    }                                                                                             \
    lsum = lsum * alpha + ps;                                                                     \
    __builtin_amdgcn_sched_group_barrier(0x100, 4, 0);                                            \
    _Pragma("unroll") for (int i = 0; i < 12; ++i) {                                              \
      __builtin_amdgcn_sched_group_barrier(0x008, 1, 0);                                          \
      __builtin_amdgcn_sched_group_barrier(0x002, 7, 0);                                          \
      __builtin_amdgcn_sched_group_barrier(0x100, 1, 0);                                          \
    }                                                                                             \
    if (__builtin_amdgcn_ballot_w64(alpha != 1.0f) != 0) {                                        \
      _Pragma("unroll") for (int d = 0; d < 4; ++d)                                               \
        _Pragma("unroll") for (int i = 0; i < 16; ++i) o[d][i] *= alpha;                          \
    }                                                                                             \
    _Pragma("unroll") for (int s2 = 0; s2 < 2; ++s2) {                                            \
      _Pragma("unroll") for (int d = 0; d < 4; ++d) {                                             \
        const h16x8 vf = *(const h16x8*)((VCUR) + (d * 32 + q_) * MLA_VS + s2 * 16 + hh * 8);     \
        if (VAR != 3) o[d] = mfma32(vf, s2 ? pf1 : pf0, o[d]); else o[d][0] += (float)vf[0] * (float)pf0[0]; \
      }                                                                                           \
    }                                                                                             \
    sc = sn;                                                                                      \
  }
  constexpr int NT = 4352 / 64;
  MLA_GLOAD(0);
  MLA_SSTORE(0);
  MLA_GLOAD(1);
  MLA_SSTORE(1);
  __syncthreads();
  {
#pragma unroll
    for (int i = 0; i < 16; ++i) sc[i] = 0.f;
    const h16* kp = smem + q_ * MLA_KS + hh * 8;
#pragma unroll
    for (int st = 0; st < 12; ++st) sc = mfma32(*(const h16x8*)(kp + st * 16), qf[st], sc);
  }
  int bc = 0;
  for (int kt = 0; kt < NT; ++kt) {
    const int bn = (bc == 2) ? 0 : bc + 1;
    const int bw = (bn == 2) ? 0 : bn + 1;
    const bool pre = kt + 2 < NT;
    if (pre && VAR != 1) MLA_GLOAD(kt + 2);
    const h16* sK = smem + bc * MLA_BUF;
    const h16* sV = sK + 64 * MLA_KS;
    const h16* sKn = smem + bn * MLA_BUF;
    MLA_SUBSTEP(true, sK + 32 * MLA_KS, sV);
    MLA_SUBSTEP(kt + 1 < NT, sKn, sV + 32);
    if (pre && VAR != 1) MLA_SSTORE(bw);
    __syncthreads();
    bc = bn;
  }
  lsum += __shfl_xor(lsum, 32);
  const float rl = 1.0f / lsum;
  h16* op = cat + qrow * 2048 + 512 + hd * 128 + hh * 4;
#pragma unroll
  for (int d = 0; d < 4; ++d)
#pragma unroll
    for (int i4 = 0; i4 < 4; ++i4)
      store_h4(op + d * 32 + i4 * 8, o[d][i4 * 4 + 0] * rl, o[d][i4 * 4 + 1] * rl, o[d][i4 * 4 + 2] * rl, o[d][i4 * 4 + 3] * rl);
#undef MLA_GLOAD
#undef MLA_SSTORE
#undef MLA_SUBSTEP
}

DEVI void l1_prep_phase(const Params& p) {
  const h16* p1 = (const h16*)(p.ws + OFF_P1);
  h16* cqn = (h16*)(p.ws + OFF_CQN);
  h16* ckvn = (h16*)(p.ws + OFF_CKVN);
  h16* kr = (h16*)(p.ws + OFF_KR);
  h16* cat = (h16*)(p.ws + OFF_CAT);
  const int tid_ = tidx(); const int lane = tid_ & 63, wid = tid_ >> 6;
  for (int row = blockIdx.x * 8 + wid; row < TA; row += gridDim.x * 8) {
    const h16* pr = p1 + (size_t)row * 2048;
    const bool lat = row < TL;
    {
      const h16x8 v = *(const h16x8*)(pr + 1280 + lane * 8);
      float f[8], ss = 0.f;
#pragma unroll
      for (int e = 0; e < 8; ++e) { f[e] = (float)v[e]; ss += f[e] * f[e]; }
      ss = wave_sum(ss);
      const float rstd = rsqrtf(ss * (1.0f / 512.0f) + 1e-6f);
      h16x8 o;
#pragma unroll
      for (int e = 0; e < 8; ++e) o[e] = (h16)(f[e] * rstd * p.mla_gkv[lane * 8 + e]);
      *(h16x8*)(ckvn + (size_t)row * 512 + lane * 8) = o;
    }
    {
      const float xv = (float)pr[1792 + lane];
      const float xo = __shfl_xor(xv, 16);
      float outv = xv;
      int b, key;
      if (lat) {
        const int t = row & 4095;
        b = row >> 12; key = 256 + t;
        const int fi = lane & 15;
        const int pos = (lane < 32) ? (t >> 6) : (t & 63);
        const float inv = fexp2(-(float)fi * (13.287712379549449f / 16.0f));
        const float rev = (float)pos * inv * 0.15915494309189535f;
        const float cs = cos_rev(rev), sn = sin_rev(rev);
        outv = (lane & 16) ? (xo * sn + xv * cs) : (xv * cs - xo * sn);
      } else {
        b = (row - TL) >> 8; key = (row - TL) & 255;
      }
      kr[((size_t)b * 4352 + key) * 64 + lane] = (h16)outv;
    }
    if (lat) {
      {
        float f[12], ss = 0.f;
#pragma unroll
        for (int i = 0; i < 3; ++i) {
          const h16x4 v = *(const h16x4*)(pr + 512 + (i * 64 + lane) * 4);
#pragma unroll
          for (int e = 0; e < 4; ++e) { f[i * 4 + e] = (float)v[e]; ss += f[i * 4 + e] * f[i * 4 + e]; }
        }
        ss = wave_sum(ss);
        const float rstd = rsqrtf(ss * (1.0f / 768.0f) + 1e-6f);
#pragma unroll
        for (int i = 0; i < 3; ++i) {
          const int col = (i * 64 + lane) * 4;
          store_h4(cqn + (size_t)row * 768 + col, f[i * 4 + 0] * rstd * p.mla_gq[col + 0], f[i * 4 + 1] * rstd * p.mla_gq[col + 1],
                   f[i * 4 + 2] * rstd * p.mla_gq[col + 2], f[i * 4 + 3] * rstd * p.mla_gq[col + 3]);
        }
      }
      {
        const int t = row & 4095;
        const int grp = lane >> 4;
        const int hw = 1 << grp;
        const int lo = max(t - hw, 0), hi = min(t + hw, 4096);
        float acc[8];
#pragma unroll
        for (int e = 0; e < 8; ++e) acc[e] = 0.f;
        const h16* base = p1 + (size_t)(row - t) * 2048 + lane * 8;
        for (int tt = lo; tt < hi; ++tt) {
          const h16x8 v = *(const h16x8*)(base + (size_t)tt * 2048);
#pragma unroll
          for (int e = 0; e < 8; ++e) acc[e] += (float)v[e];
        }
        const h16x8 self = *(const h16x8*)(pr + lane * 8);
        const float rc = 1.0f / (float)(hi - lo);
        h16x8 o;
#pragma unroll
        for (int e = 0; e < 8; ++e) o[e] = (h16)(acc[e] * rc - (float)self[e]);
        *(h16x8*)(cat + (size_t)row * 2048 + lane * 8) = o;
      }
    }
  }
}

#define XB_TMO      128
#define XB_XCNT(j)  (256  + 64 * (j))
#define XB_XSUB(j)  (1280 + 64 * (j))
#define XB_XGEN(j)  (2304 + 64 * (j))
#define XB_TOP      3328
#define XB_TOPGEN   3392
#define XCD_BAR_WORDS 3456
#define XB_SPIN_CAP (1u << 20)
DEVI unsigned xb_ld(unsigned* p) { return __hip_atomic_load(p, __ATOMIC_RELAXED, __HIP_MEMORY_SCOPE_AGENT); }
DEVI unsigned xb_add(unsigned* p, unsigned v) { return __hip_atomic_fetch_add(p, v, __ATOMIC_RELAXED, __HIP_MEMORY_SCOPE_AGENT); }
DEVI unsigned xb_xcc_id() { return (unsigned)__builtin_amdgcn_s_getreg((3 << 11) | 20) & 0xFu; }
#define XB_SPIN(cond, bar) do { unsigned _sp = 0; while (cond) { __builtin_amdgcn_s_sleep(0); \
    if ((++_sp & 255u) == 0u) { if (xb_ld(&(bar)[XB_TMO])) break; if (_sp > XB_SPIN_CAP) { atomicAdd(&(bar)[XB_TMO], 1u); break; } } } } while (0)
struct XcdBarrier { unsigned* bar; unsigned x; volatile __attribute__((address_space(3))) unsigned* st; };
DEVI XcdBarrier xcd_barrier_post(unsigned* bar, volatile __attribute__((address_space(3))) unsigned* st) {
  XcdBarrier b; b.bar = bar; b.x = xb_xcc_id(); b.st = st;
  if (threadIdx.x == 0) (void)xb_add(&bar[XB_XCNT(b.x)], 1u);
  return b;
}
DEVI void xcd_barrier_complete(unsigned* bar, unsigned x, unsigned& nloc, unsigned& nx) {
  const unsigned G = gridDim.x * gridDim.y * gridDim.z;
  unsigned sum, cnt, mine, sp = 0u;
  for (;;) {
    sum = 0u; cnt = 0u; mine = 0u;
#pragma unroll
    for (unsigned j = 0; j < 16; ++j) { const unsigned c = xb_ld(&bar[XB_XCNT(j)]); sum += c; cnt += (c > 0u) ? 1u : 0u; mine = (j == x) ? c : mine; }
    if (sum == G) break;
    __builtin_amdgcn_s_sleep(1);
    if ((++sp & 255u) == 0u) { if (xb_ld(&bar[XB_TMO])) break; if (sp > XB_SPIN_CAP) { atomicAdd(&bar[XB_TMO], 1u); break; } }
  }
  nloc = mine > 0u ? mine : 1u; nx = cnt > 0u ? cnt : 1u;
}
DEVI void xcd_barrier(const XcdBarrier& b) {
  asm volatile("s_waitcnt vmcnt(0)" ::: "memory");
  __syncthreads();
  if (threadIdx.x == 0) {
    unsigned* bar = b.bar;
    __builtin_amdgcn_s_waitcnt(0);
    unsigned nloc = b.st[0], nx = b.st[1];
    if (nloc == 0u) { xcd_barrier_complete(bar, b.x, nloc, nx); b.st[0] = nloc; b.st[1] = nx; }
    const unsigned old = xb_add(&bar[XB_XSUB(b.x)], 1u);
    const unsigned gen = old / nloc;
    if (old + 1u == (gen + 1u) * nloc) {
      __builtin_amdgcn_fence(__ATOMIC_RELEASE, "agent");
      asm volatile("s_waitcnt vmcnt(0)" ::: "memory");
      const unsigned og = xb_add(&bar[XB_TOP], 1u);
      const unsigned tg = og / nx;
      if (og + 1u == (tg + 1u) * nx) xb_add(&bar[XB_TOPGEN], 1u);
      else XB_SPIN(xb_ld(&bar[XB_TOPGEN]) == tg, bar);
      __builtin_amdgcn_fence(__ATOMIC_ACQUIRE, "agent");
      xb_add(&bar[XB_XGEN(b.x)], 1u);
      asm volatile("s_waitcnt vmcnt(0)" ::: "memory");
    } else {
      XB_SPIN(xb_ld(&bar[XB_XGEN(b.x)]) == gen, bar);
      __builtin_amdgcn_fence(__ATOMIC_ACQUIRE, "agent");
      asm volatile("s_waitcnt vmcnt(0)" ::: "memory");
    }
  }
  __syncthreads();
}

DEVI void run_phase(const Params& pin, int ph, h16* smem, bool dummy = false) {
  Params p = pin;
  asm volatile("" : "+s"(p.ws));
  char* ws = p.ws;
  float* mod = (float*)(ws + OFF_MOD);
  h16* xres = (h16*)(ws + OFF_XRES);
  h16* xout = xres;
  h16* hbuf = (h16*)(ws + OFF_H);
  h16* cat = (h16*)(ws + OFF_CAT);
  h16* act = (h16*)(ws + OFF_BIG);
  switch (ph) {
    case 0: phase0(p, (float*)smem); break;
    case 1: norm_mod_phase(p.x, p.ctx, TA, p.norm1_g, mod, 0, 1, hbuf); break;
    case 2: {
      EpiG1 e{(h16*)(ws + OFF_Q0), (h16*)(ws + OFF_K0), (h16*)(ws + OFF_VT0), (h16*)(ws + OFF_VCT0), (h16*)(ws + OFF_UCT), (h16*)(ws + OFF_UCTC)};
      run_gemm(smem, hbuf, (const h16*)(ws + OFF_WT_IN_AB), TA, 5632, 2048, e);
      if (!dummy && gridDim.x == 256 && lbid() >= 216) prep_out_ab(p, (float*)smem, lbid() - 216, 40);
    } break;
    case 3: {
#ifdef DFT_PROBE
      const bool do_dft = true, do_na = !dummy;
#else
      const bool do_dft = !dummy, do_na = true;
#endif
      if (do_dft) {
        EpiDft e{cat, 0.0013810679320049757f, 0, 1};
        run_gemm(smem, (const h16*)(ws + OFF_DFTA), (const h16*)(ws + OFF_UCT), 2304, 2048, 8192, e);
      }
      if (do_dft) {
        EpiDft e{cat, 0.005524271728019903f, 1, 0};
        run_gemm(smem, (const h16*)(ws + OFF_DFTAC), (const h16*)(ws + OFF_UCTC), 256, 2048, 512, e, (int)((lbid() + gridDim.x - (128 % gridDim.x)) % gridDim.x));
      }
      const int xcd = lbid() & 7;
      int* ctr = (int*)(ws + OFF_CTR) + xcd * 8;
      int* su = (int*)smem;
      const int tid = tidx();
      for (; do_na;) {
        __syncthreads();
        if (tid == 0) su[0] = atomicAdd(ctr, 1);
        __syncthreads();
        const int u = su[0];
        if (u >= 204) break;
        const int bu = u < 192 ? (xcd * 192 + u) : (1536 + xcd * 12 + (u - 192));
#ifdef NA_PROBE_VAR
        if (dummy) na_block_unit<NA_PROBE_VAR>(p, bu, smem + 64); else
#endif
        na_block_unit<0>(p, bu, smem + 64);
      }
    } break;
    case 4: {
      EpiRes<float> e{p.x, p.ctx, xout, mod + 2 * 2048};
      run_gemm(smem, cat, (const h16*)(ws + OFF_WT_OUT_AB), TA, 2048, 2048, e);
      if (!dummy && gridDim.x == 256 && lbid() >= 32) prep_ffn_gu(p, 0, (float*)smem, lbid() - 32, 224);
      else if (!dummy && gridDim.x != 256) prep_ffn_gu(p, 0, (float*)smem, lbid(), (int)gridDim.x);
    } break;
    case 5: norm_mod_phase(xres, xres + (size_t)TL * 2048, TA, p.norm2_g, mod, 3, 4, hbuf); break;
    case 6: {
      EpiGU e{act};
      run_gemm(smem, hbuf, (const h16*)(ws + OFF_WT_GU0), TA, 11264, 2048, e);
      if (!dummy && gridDim.x == 256 && lbid() >= 176) prep_ffn_dn(p, 0, (float*)smem, lbid() - 176, 80);
      else if (!dummy && gridDim.x != 256) prep_ffn_dn(p, 0, (float*)smem, lbid(), (int)gridDim.x);
    } break;
    case 7: {
      EpiRes<h16> e{xres, xres + (size_t)TL * 2048, xout, mod + 5 * 2048};
      if (gridDim.x == 256) {
        run_gemm(smem, act, (const h16*)(ws + OFF_WT_D0), TL, 2048, DFF, e);
        if (!dummy) {
          const int c = lbid(), sp = c >> 5;
          if (c < 128) {
            EpiPartial ep{(float*)cat + (size_t)sp * TC * 2048};
            run_gemm(smem, act + (size_t)TL * DFF + sp * 1408, (const h16*)(ws + OFF_WT_D0) + sp * 1408, TC, 2048, 1408, ep, c & 31, DFF);
          } else {
            prep_layer1(p, (float*)smem, c - 128, 128, false);
          }
        }
      } else {
        run_gemm(smem, act, (const h16*)(ws + OFF_WT_D0), TA, 2048, DFF, e);
        if (!dummy) prep_layer1(p, (float*)smem, lbid(), (int)gridDim.x, false);
      }
    } break;
    case 8:
      if (gridDim.x == 256) {
        norm_mod_phase(xres, xres + (size_t)TL * 2048, TL, p.norm1_g + 2048, mod + 5 * 12288, 0, 1, hbuf);
        ctx_norm_partial_phase(xres + (size_t)TL * 2048, p.norm1_g + 2048, mod + 5 * 12288, 0, 1, hbuf, (const float*)cat, 4, mod + 4 * 12288 + 5 * 2048);
      } else norm_mod_phase(xres, xres + (size_t)TL * 2048, TA, p.norm1_g + 2048, mod + 5 * 12288, 0, 1, hbuf);
      break;
    case 9: {
      EpiStore e{(h16*)(ws + OFF_P1), 2048};
      run_gemm(smem, hbuf, (const h16*)(ws + OFF_WT_IN_CD), TA, 2048, 2048, e);
      if (!dummy && gridDim.x == 256 && lbid() >= 32) prep_ffn(p, 1, (float*)smem, lbid() - 32, 224);
      else if (!dummy && gridDim.x != 256) prep_ffn(p, 1, (float*)smem, lbid(), (int)gridDim.x);
    } break;
    case 10: l1_prep_phase(p); break;
    case 11: {
      EpiQ1 eq{(h16*)(ws + OFF_Q1)};
      run_gemm(smem, (const h16*)(ws + OFF_CQN), (const h16*)(ws + OFF_WT_UQ), TL, 2304, 768, eq);
      EpiKV1 ek{(h16*)(ws + OFF_KN), (h16*)(ws + OFF_VT1)};
      run_gemm(smem, (const h16*)(ws + OFF_CKVN), (const h16*)(ws + OFF_WT_UKV), TA, 3072, 512, ek, (int)((lbid() + gridDim.x - 64) % gridDim.x));
    } break;
    case 12: {
      if (gridDim.x == 256) {
        const int xcd = lbid() & 7, slot = lbid() >> 3;
        for (int i = 0; i < 3; ++i) mla_unit<0>(p, (xcd * 6 + i * 2 + (slot >> 4)) * 16 + (slot & 15), smem);
      } else {
        for (int u = lbid(); u < 768; u += gridDim.x) mla_unit<0>(p, u, smem);
      }
    } break;
#ifdef MLA_PROBE_VAR
    case 112: {
      const int xcd = lbid() & 7, slot = lbid() >> 3;
      for (int i = 0; i < 3; ++i) mla_unit<MLA_PROBE_VAR>(p, (xcd * 6 + i * 2 + (slot >> 4)) * 16 + (slot & 15), smem);
    } break;
#endif
    case 13: {
      EpiRes<h16> e{xres, xres + (size_t)TL * 2048, xout, mod + 5 * 12288 + 2 * 2048};
      run_gemm(smem, cat, (const h16*)(ws + OFF_WT_OUT_CD), TL, 2048, 2048, e);
    } break;
    case 14: norm_mod_phase(xres, xres + (size_t)TL * 2048, TL, p.norm2_g + 2048, mod + 5 * 12288, 3, 4, hbuf); break;
    case 15: {
      EpiGU e{act};
      run_gemm(smem, hbuf, (const h16*)(ws + OFF_WT_GU1), TL, 11264, 2048, e);
    } break;
    case 16: {
      EpiRes<h16> e{xres, xres + (size_t)TL * 2048, xout, mod + 5 * 12288 + 5 * 2048};
      run_gemm(smem, act, (const h16*)(ws + OFF_WT_D1), TL, 2048, DFF, e);
    } break;
    case 17: final_norm_phase(xres, p.final_g, p.out); break;
    default: break;
  }
}

__global__ void __launch_bounds__(512, 2) mega_kernel(Params p, int ph_lo, int ph_hi) {
  extern __shared__ __attribute__((aligned(16))) unsigned char shm[];
  h16* smem = (h16*)shm;
  unsigned* barw = (unsigned*)(p.ws + OFF_BAR);
  if (threadIdx.x == 0) {
    const unsigned x = xb_xcc_id();
    const unsigned r = xb_add(&barw[XCD_BAR_WORDS + (x & 15u)], 1u);
    g_sh[0] = make_uint4(0u, 0u, 0u, 0u);
    g_sh[1] = make_uint4(blockIdx.x, r, x, 0u);
  }
  __syncthreads();
  const XcdBarrier xb = xcd_barrier_post(barw, (volatile __attribute__((address_space(3))) unsigned*)&g_sh[0]);
#ifdef ONLY_PHASE
  run_phase(p, ONLY_PHASE, smem);
#else
#pragma unroll
  for (int ph = 0; ph < NPHASE; ++ph) {
    if (ph >= ph_lo && ph < ph_hi) {
      run_phase(p, ph, smem);
      if ((REPEAT_MASK >> ph) & 1) {
        xcd_barrier(xb);
        if (ph == 3) { if (blockIdx.x == 0 && threadIdx.x < 8) ((int*)(p.ws + OFF_CTR))[threadIdx.x * 8] = 0; xcd_barrier(xb); }
#ifdef MLA_PROBE_VAR
        run_phase(p, ph == 12 ? 112 : ph, smem, true);
#else
        run_phase(p, ph, smem, true);
#endif
      }
      if (ph + 1 < ph_hi) { if (ph_hi > 1000) cg::this_grid().sync(); else xcd_barrier(xb); }
      if (ph == 0) {
        if (threadIdx.x == 0) {
          bool ok = (gridDim.x == 256);
#pragma unroll
          for (unsigned j = 0; j < 16; ++j) { const unsigned cnt = xb_ld(&barw[XB_XCNT(j)]); ok = ok && (cnt == (j < 8 ? 32u : 0u)); }
          const uint4 me = g_sh[1];
          if (ok && me.z < 8u && me.y < 32u) g_sh[1].x = me.y * 8u + me.z;
        }
        __syncthreads();
      }
    }
  }
#ifdef EXTRA_SYNCS
  for (int i = 0; i < EXTRA_SYNCS; ++i) xcd_barrier(xb);
#endif
#endif
}

extern "C" void kernel_launch(void* const* d_in, const int* in_sizes, int n_in, void* d_out, int out_size, void* d_ws,
                              size_t ws_size, hipStream_t stream) {
  if (ws_size < WS_NEEDED) {
    fprintf(stderr, "workspace too small: have %zu need %zu\n", ws_size, (size_t)WS_NEEDED);
    return;
  }
  static int grid_blocks = 0;
  if (!grid_blocks) {
    int dev = 0, cus = 0, per_cu = 0;
    (void)hipGetDevice(&dev);
    (void)hipDeviceGetAttribute(&cus, hipDeviceAttributeMultiprocessorCount, dev);
    (void)hipFuncSetAttribute((const void*)mega_kernel, hipFuncAttributeMaxDynamicSharedMemorySize, SMEM_BYTES);
    (void)hipOccupancyMaxActiveBlocksPerMultiprocessor(&per_cu, mega_kernel, NTHR, SMEM_BYTES);
    if (per_cu > 1) per_cu = 1;
    grid_blocks = cus * per_cu;
  }
  Params p{};
  const float** pf = (const float**)&p;
  for (int i = 0; i < 24; ++i) pf[i] = (const float*)d_in[i];
  p.out = (float*)d_out;
  p.ws = (char*)d_ws;
  int lo = 0, hi = NPHASE;
  (void)hipMemsetAsync((char*)d_ws + OFF_BAR, 0, BAR_BYTES, stream);
  void* args[] = {&p, &lo, &hi};
  hipError_t e = hipLaunchCooperativeKernel((void*)mega_kernel, dim3(grid_blocks), dim3(NTHR), args, SMEM_BYTES, stream);
  if (e != hipSuccess) fprintf(stderr, "cooperative launch failed: %s (grid %d)\n", hipGetErrorString(e), grid_blocks);
}
```

```cpp
#include <hip/hip_runtime.h>
#include <hip/hip_cooperative_groups.h>
#include <cstdio>
#include <cstdint>
namespace cg = cooperative_groups;

typedef _Float16 h16;
typedef _Float16 h16x8 __attribute__((ext_vector_type(8)));
typedef _Float16 h16x4 __attribute__((ext_vector_type(4)));
typedef float f32x16 __attribute__((ext_vector_type(16)));
typedef float f32x4 __attribute__((ext_vector_type(4)));

#define DEVI __device__ __forceinline__

#ifndef SINGLE_LAUNCH
#define SINGLE_LAUNCH 1
#endif
#ifndef REPEAT_MASK
#define REPEAT_MASK 0x0
#endif

constexpr int DM = 2048;
constexpr int TL = 16384;
constexpr int TC = 1024;
constexpr int TA = 17408;
constexpr int DFF = 5632;
constexpr int NPHASE = 18;

constexpr size_t SZ_WT_IN_AB = (size_t)5632 * 2048 * 2;
constexpr size_t SZ_WT_OUT = (size_t)2048 * 2048 * 2;
constexpr size_t SZ_WT_GU = (size_t)11264 * 2048 * 2;
constexpr size_t SZ_WT_D = (size_t)2048 * 5632 * 2;
constexpr size_t SZ_WT_IN_CD = (size_t)2048 * 2048 * 2;
constexpr size_t SZ_WT_UQ = (size_t)2304 * 768 * 2;
constexpr size_t SZ_WT_UKV = (size_t)3072 * 512 * 2;
constexpr size_t SZ_DFTA = (size_t)4096 * 8192 * 2;
constexpr size_t SZ_DFTAC = (size_t)256 * 512 * 2;
constexpr size_t SZ_MOD = (size_t)2 * 5 * 12288 * 4;
constexpr size_t SZ_XRES = (size_t)TA * 2048 * 4;
constexpr size_t SZ_H = (size_t)TA * 2048 * 2;
constexpr size_t SZ_CAT = (size_t)TA * 2048 * 2;
constexpr size_t SZ_BIG = (size_t)TA * 5632 * 2;

constexpr size_t OFF_WT_IN_AB = 0;
constexpr size_t OFF_WT_OUT_AB = OFF_WT_IN_AB + SZ_WT_IN_AB;
constexpr size_t OFF_WT_GU0 = OFF_WT_OUT_AB + SZ_WT_OUT;
constexpr size_t OFF_WT_GU1 = OFF_WT_GU0 + SZ_WT_GU;
constexpr size_t OFF_WT_D0 = OFF_WT_GU1 + SZ_WT_GU;
constexpr size_t OFF_WT_D1 = OFF_WT_D0 + SZ_WT_D;
constexpr size_t OFF_WT_IN_CD = OFF_WT_D1 + SZ_WT_D;
constexpr size_t OFF_WT_UQ = OFF_WT_IN_CD + SZ_WT_IN_CD;
constexpr size_t OFF_WT_UKV = OFF_WT_UQ + SZ_WT_UQ;
constexpr size_t OFF_WT_OUT_CD = OFF_WT_UKV + SZ_WT_UKV;
constexpr size_t OFF_DFTA = OFF_WT_OUT_CD + SZ_WT_OUT;
constexpr size_t OFF_DFTAC = OFF_DFTA + SZ_DFTA;
constexpr size_t OFF_MOD = OFF_DFTAC + SZ_DFTAC;
constexpr size_t OFF_XRES = OFF_MOD + SZ_MOD;
constexpr size_t OFF_H = OFF_XRES + SZ_XRES;
constexpr size_t OFF_CAT = OFF_H + SZ_H;
constexpr size_t OFF_BIG = OFF_CAT + SZ_CAT;
constexpr size_t OFF_CTR = OFF_BIG + SZ_BIG;
constexpr size_t OFF_BAR = OFF_CTR + 256;
constexpr size_t BAR_BYTES = 16384;
constexpr size_t WS_NEEDED = OFF_BAR + BAR_BYTES;

constexpr size_t OFF_Q0 = OFF_BIG;
constexpr size_t OFF_K0 = OFF_Q0 + (size_t)TA * 1536 * 2;
constexpr size_t OFF_VT0 = OFF_K0 + (size_t)TA * 1536 * 2;
constexpr size_t OFF_VCT0 = OFF_VT0 + (size_t)48 * 128 * 4096 * 2;
constexpr size_t OFF_UCT = OFF_VCT0 + (size_t)48 * 128 * 256 * 2;
constexpr size_t OFF_UCTC = OFF_UCT + (size_t)2048 * 8192 * 2;
static_assert(OFF_UCTC + (size_t)2048 * 512 * 2 <= OFF_BIG + SZ_BIG, "layer0 scratch overflow");
constexpr size_t OFF_P1 = OFF_BIG;
constexpr size_t OFF_CQN = OFF_P1 + (size_t)TA * 2048 * 2;
constexpr size_t OFF_CKVN = OFF_CQN + (size_t)TL * 768 * 2;
constexpr size_t OFF_KR = OFF_CKVN + (size_t)TA * 512 * 2;
constexpr size_t OFF_Q1 = OFF_KR + (size_t)4 * 4352 * 64 * 2;
static_assert(OFF_Q1 + (size_t)TL * 2304 * 2 <= OFF_BIG + SZ_BIG, "layer1 scratch overflow");
constexpr size_t OFF_KN = OFF_H;
constexpr size_t OFF_VT1 = OFF_DFTA;
static_assert((size_t)4 * 4352 * 1536 * 2 <= SZ_H, "kn alias");
static_assert((size_t)48 * 128 * 4352 * 2 <= SZ_DFTA, "vt1 alias");

struct Params {
  const float *x, *c, *ctx, *c_ctx, *w_mod, *b_mod, *norm1_g, *norm2_g, *w_in_ab, *w_four, *na_rpb, *w_out_ab;
  const float *w_in_cd, *w_pool, *pool_scale, *mla_gq, *mla_gkv, *w_uq, *w_ukv, *w_out_cd;
  const float *w_ffn_gate, *w_ffn_up, *w_ffn_down, *final_g;
  float* out;
  char* ws;
};

constexpr int NTHR = 512;
constexpr int SMEM_BYTES = 147456;

__shared__ uint4 g_sh[2];
__device__ __forceinline__ int lbid() { return (int)g_sh[1].x; }
DEVI f32x16 mfma32(h16x8 a, h16x8 b, f32x16 c) { return __builtin_amdgcn_mfma_f32_32x32x16_f16(a, b, c, 0, 0, 0); }
DEVI f32x4 mfma16(h16x8 a, h16x8 b, f32x4 c) { return __builtin_amdgcn_mfma_f32_16x16x32_f16(a, b, c, 0, 0, 0); }
DEVI int tidx() { int t = threadIdx.x; asm volatile("" : "+v"(t)); return t; }
DEVI float wave_sum(float v) {
#pragma unroll
  for (int o = 32; o >= 1; o >>= 1) v += __shfl_xor(v, o);
  return v;
}
DEVI float fexp2(float x) { return __builtin_amdgcn_exp2f(x); }
DEVI float cos_rev(float r) { return __builtin_amdgcn_cosf(r); }
DEVI float sin_rev(float r) { return __builtin_amdgcn_sinf(r); }
DEVI float silu_f(float v) { return v * __builtin_amdgcn_rcpf(1.0f + __builtin_amdgcn_exp2f(-1.4426950408889634f * v)); }
DEVI float4 ld4f(const float* p) { return *(const float4*)p; }
DEVI float4 ldnt4(const float* p) { const f32x4 v = __builtin_nontemporal_load((const f32x4*)p); return make_float4(v[0], v[1], v[2], v[3]); }
DEVI void stnt4(float* p, const float4& v) { f32x4 t; t[0] = v.x; t[1] = v.y; t[2] = v.z; t[3] = v.w; __builtin_nontemporal_store(t, (f32x4*)p); }
DEVI float4 ld4f(const h16* p) { const h16x4 v = *(const h16x4*)p; return make_float4((float)v[0], (float)v[1], (float)v[2], (float)v[3]); }
DEVI void store_h8(h16* dst, const f32x4& a, const f32x4& b, float sc = 1.0f) {
  h16x8 v;
#pragma unroll
  for (int j = 0; j < 4; ++j) { v[j] = (h16)(a[j] * sc); v[4 + j] = (h16)(b[j] * sc); }
  *(h16x8*)dst = v;
}
DEVI void store_h4(h16* dst, float a, float b, float c, float d) {
  h16x4 v;
  v[0] = (h16)a; v[1] = (h16)b; v[2] = (h16)c; v[3] = (h16)d;
  *(h16x4*)dst = v;
}

#define LAS __attribute__((address_space(3)))
namespace g8 {
constexpr int BM = 256, BK = 64, HALF = 128, HTB = HALF * BK * 2, NXCD = 8, WGM = 8;
DEVI int lds_byte(int r, int c) { const int st = (r >> 4) * 2 + (c >> 5), rr = r & 15, cc = c & 31, ob = rr * 64 + cc * 2; return st * 1024 + (ob ^ (((ob >> 9) & 1) << 5)); }
DEVI void stage_rc(int b, int& R, int& C) { const int st = b / 1024, sb = b % 1024, swz = sb ^ (((sb >> 9) & 1) << 5); R = (st >> 1) * 16 + swz / 64; C = (st & 1) * 32 + (swz % 64) / 2; }
DEVI int perm32(int rho) { const int n = rho >> 4, i = rho & 15; return 8 * (i >> 2) + 4 * n + (i & 3); }
struct Unit { int pm, pn; };
struct Gemm { const h16* A; const h16* Bt; int M, N, K, ld; };
struct StaticOrder {
  int nM, nN, nwg, G, c;
  DEVI void init(int M, int N, int G_, int c_) { nM = M / BM; nN = N / BM; nwg = nM * nN; G = G_; c = c_; }
  DEVI bool next(int i, Unit& u) const {
    if (c < 0) return false;
    const long L = (long)i * G + c; if (L >= nwg) return false;
    int wgid = (int)L; { const int q = nwg / NXCD, r = nwg % NXCD, xcd = wgid % NXCD, off = wgid / NXCD; wgid = (xcd < r ? xcd * (q + 1) : r * (q + 1) + (xcd - r) * q) + off; }
    const int nig = WGM * nN, gid = wgid / nig, fm = gid * WGM, gsz = (nM - fm) < WGM ? (nM - fm) : WGM;
    u.pm = fm + ((wgid % nig) % gsz); u.pn = (wgid % nig) / gsz; return true;
  }
};

template <class Epi>
DEVI void gemm_phase(LAS unsigned char* lds, const Gemm g, const StaticOrder& S, const Epi& E) {
  const int tid = tidx(), wid = __builtin_amdgcn_readfirstlane(tid >> 6), lane = tid & 63, wr = wid >> 2, wc = wid & 3, fr = lane & 15, fq = lane >> 4;
  const int K = g.K, nt = K / BK;
  unsigned voffA[2], voffB[2];
#pragma unroll
  for (int i = 0; i < 2; ++i) { int R, C; stage_rc(tid * 16 + i * 8192, R, C); const int Rb = Epi::PERM ? ((R & ~31) + perm32(R & 31)) : R;
    voffA[i] = (unsigned)(R * g.ld + C) * 2u; voffB[i] = (unsigned)(Rb * g.ld + C) * 2u; }
  const size_t kstep = (size_t)(BK * 2);
  const size_t hstep = (size_t)HALF * g.ld * 2;
  const size_t tstep = 2 * hstep;
  const unsigned ldsw = (unsigned)wid * 1024u;
  const int aoff = lds_byte(wr * 64 + fr, fq * 8), boff = lds_byte(wc * 32 + fr, fq * 8);
#define G8_SA(b, h) (((b) * 2 + (h)) * HTB)
#define G8_SB(b, h) ((4 + (b) * 2 + (h)) * HTB)
#define G8_STAGE(bufoff, gbase, voff) do { _Pragma("unroll") for (int _i = 0; _i < 2; ++_i) \
    __builtin_amdgcn_global_load_lds((const unsigned*)((const char*)(gbase) + (voff)[_i]), (LAS unsigned*)(lds + (bufoff) + ldsw + _i * 8192), 16, 0, 0); } while (0)
#define G8_LDA(dst, b, h) do { _Pragma("unroll") for (int m = 0; m < 4; ++m) _Pragma("unroll") for (int k = 0; k < 2; ++k) dst[m][k] = *(const LAS h16x8*)(lds + G8_SA(b, h) + aoff + m * 2048 + k * 1024); } while (0)
#define G8_LDB(dst, b, h) do { _Pragma("unroll") for (int n = 0; n < 2; ++n) _Pragma("unroll") for (int k = 0; k < 2; ++k) dst[n][k] = *(const LAS h16x8*)(lds + G8_SB(b, h) + boff + n * 2048 + k * 1024); } while (0)
#define G8_MMA(ai, bj, At, Bt) do { __builtin_amdgcn_s_setprio(1); _Pragma("unroll") for (int m = 0; m < 4; ++m) _Pragma("unroll") for (int n = 0; n < 2; ++n) _Pragma("unroll") for (int k = 0; k < 2; ++k) \
    acc[ai][bj][m][n] = __builtin_amdgcn_mfma_f32_16x16x32_f16(Bt[n][k], At[m][k], acc[ai][bj][m][n], 0, 0, 0); __builtin_amdgcn_s_setprio(0); } while (0)
#define G8_WAIT_V(n) asm volatile("s_waitcnt vmcnt(" #n ")" ::: "memory")
#define G8_WAIT_L(n) asm volatile("s_waitcnt lgkmcnt(" #n ")" ::: "memory")
#define G8_BAR __builtin_amdgcn_s_barrier()
#define G8_SCHED __builtin_amdgcn_sched_barrier(0)
  Unit cur, nxt; int ui = 0;
  if (!S.next(0, cur)) return;
  f32x4 acc[2][2][4][2];
#pragma unroll
  for (int a = 0; a < 2; ++a)
#pragma unroll
    for (int b = 0; b < 2; ++b)
#pragma unroll
      for (int m = 0; m < 4; ++m)
#pragma unroll
        for (int n = 0; n < 2; ++n) acc[a][b][m][n] = (f32x4){0.f, 0.f, 0.f, 0.f};
  h16x8 At[4][2], B0[2][2], B1[2][2];
  const char* cA = (const char*)g.A + (size_t)cur.pm * tstep; const char* cB = (const char*)g.Bt + (size_t)cur.pn * tstep;
  G8_STAGE(G8_SB(0, 0), cB, voffB); G8_STAGE(G8_SA(0, 0), cA, voffA); G8_STAGE(G8_SB(0, 1), cB + hstep, voffB); G8_STAGE(G8_SA(0, 1), cA + hstep, voffA);
  if (wr == 1) G8_BAR;
  G8_WAIT_V(4); G8_BAR;
  G8_STAGE(G8_SB(1, 0), cB + kstep, voffB); G8_STAGE(G8_SA(1, 0), cA + kstep, voffA); G8_STAGE(G8_SB(1, 1), cB + hstep + kstep, voffB);
  G8_WAIT_V(6); G8_BAR;
  for (;;) {
    const bool has_next = S.next(ui + 1, nxt);
    const char* nA = has_next ? (const char*)g.A + (size_t)nxt.pm * tstep : cA; const char* nB = has_next ? (const char*)g.Bt + (size_t)nxt.pn * tstep : cB;
    for (int t = 0; t < nt; t += 2) {
      const bool last = (t == nt - 2);
      const char* a1 = cA + (size_t)(t + 1) * kstep;
      const char* a2 = last ? nA : cA + (size_t)(t + 2) * kstep; const char* b2 = last ? nB : cB + (size_t)(t + 2) * kstep;
      const char* a3 = a2 + kstep; const char* b3 = b2 + kstep;
      G8_LDB(B0, 0, 0); G8_SCHED; G8_LDA(At, 0, 0); G8_STAGE(G8_SA(1, 1), a1 + hstep, voffA);
      G8_WAIT_L(8); G8_BAR; G8_WAIT_L(0); G8_MMA(0, 0, At, B0); G8_BAR; G8_SCHED;
      G8_LDB(B1, 0, 1); G8_STAGE(G8_SB(0, 0), b2, voffB);
      G8_BAR; G8_WAIT_L(0); G8_MMA(0, 1, At, B1); G8_BAR;
      G8_LDA(At, 0, 1); G8_STAGE(G8_SA(0, 0), a2, voffA);
      G8_BAR; G8_WAIT_L(0); G8_MMA(1, 0, At, B0); G8_BAR; G8_SCHED;
      G8_STAGE(G8_SB(0, 1), b2 + hstep, voffB);
      G8_WAIT_V(6); G8_BAR; G8_MMA(1, 1, At, B1); G8_BAR;
      G8_LDB(B0, 1, 0); G8_SCHED; G8_LDA(At, 1, 0); G8_STAGE(G8_SA(0, 1), a2 + hstep, voffA);
      G8_WAIT_L(8); G8_BAR; G8_WAIT_L(0); G8_MMA(0, 0, At, B0); G8_BAR; G8_SCHED;
      G8_LDB(B1, 1, 1); G8_STAGE(G8_SB(1, 0), b3, voffB);
      G8_BAR; G8_WAIT_L(0); G8_MMA(0, 1, At, B1); G8_BAR;
      G8_LDA(At, 1, 1); G8_STAGE(G8_SA(1, 0), a3, voffA);
      G8_BAR; G8_WAIT_L(0); G8_MMA(1, 0, At, B0); G8_BAR; G8_SCHED;
      G8_STAGE(G8_SB(1, 1), b3 + hstep, voffB);
      G8_WAIT_V(6); G8_BAR; G8_MMA(1, 1, At, B1); G8_BAR;
    }
    E(acc, cur, wr, wc, fr, fq);
    if (!has_next) break;
#pragma unroll
    for (int a = 0; a < 2; ++a)
#pragma unroll
      for (int b = 0; b < 2; ++b)
#pragma unroll
        for (int m = 0; m < 4; ++m)
#pragma unroll
          for (int n = 0; n < 2; ++n) acc[a][b][m][n] = (f32x4){0.f, 0.f, 0.f, 0.f};
    cur = nxt; cA = nA; cB = nB; ++ui;
  }
  G8_WAIT_V(0);
  if (wr == 0) G8_BAR;
  G8_BAR;
#undef G8_SA
#undef G8_SB
#undef G8_STAGE
#undef G8_LDA
#undef G8_LDB
#undef G8_MMA
}
}
using g8::Unit;

template <class Epi>
DEVI void run_gemm(h16* smem, const h16* A, const h16* Bt, int M, int N, int K, const Epi& e, int c_override = -2, int ld = 0) {
  g8::Gemm g{A, Bt, M, N, K, ld ? ld : K};
  g8::StaticOrder S;
  S.init(M, N, (int)gridDim.x, c_override == -2 ? lbid() : c_override);
  g8::gemm_phase((LAS unsigned char*)smem, g, S, e);
}

#define E8_FOR                                      \
  _Pragma("unroll") for (int ai = 0; ai < 2; ++ai)   \
  _Pragma("unroll") for (int m = 0; m < 4; ++m)      \
  _Pragma("unroll") for (int bj = 0; bj < 2; ++bj)   \
  _Pragma("unroll") for (int n = 0; n < 2; ++n)
#define E8_ROW (u.pm * 256 + ai * 128 + wr * 64 + m * 16 + fr)
#define E8_COL (u.pn * 256 + bj * 128 + wc * 32 + n * 16 + fq * 4)
#define E8_COLP (u.pn * 256 + bj * 128 + wc * 32 + fq * 8 + n * 4)
typedef const f32x4 (&AccRef)[2][2][4][2];

#define E8P_FOR                                     \
  _Pragma("unroll") for (int ai = 0; ai < 2; ++ai)   \
  _Pragma("unroll") for (int m = 0; m < 4; ++m)      \
  _Pragma("unroll") for (int bj = 0; bj < 2; ++bj)
#define E8P_COL (u.pn * 256 + bj * 128 + wc * 32 + fq * 8)
struct EpiG1 {
  static constexpr bool PERM = true, AFTER_DRAIN = false;
  h16 *q0, *k0, *vT, *vcT, *ucT, *ucTc;
  DEVI void operator()(AccRef acc, const Unit& u, int wr, int wc, int fr, int fq) const {
    const bool isctx = u.pm >= 64;
    E8P_FOR {
      const int row = E8_ROW, col = E8P_COL;
      const f32x4 va = acc[ai][bj][m][0], vb = acc[ai][bj][m][1];
      int b, n_;
      if (!isctx) { b = row >> 12; n_ = row & 4095; } else { b = (row - TL) >> 8; n_ = (row - TL) & 255; }
      if (u.pn < 4) {
        const int g = u.pn, part = bj, mm = col & 127;
        const size_t ld = isctx ? 512 : 8192;
        h16* d = isctx ? ucTc + (size_t)((b * 4 + g) * 128 + mm) * 512 + part * 256 + n_
                       : ucT + (size_t)((b * 4 + g) * 128 + mm) * 8192 + part * 4096 + n_;
#pragma unroll
        for (int j = 0; j < 4; ++j) { d[j * ld] = (h16)va[j]; d[(4 + j) * ld] = (h16)vb[j]; }
      } else if (u.pn < 10) {
        store_h8(q0 + (size_t)row * 1536 + (col - 1024), va, vb);
      } else if (u.pn < 16) {
        store_h8(k0 + (size_t)row * 1536 + (col - 2560), va, vb);
      } else {
        const int c3 = col - 4096, hh = c3 >> 7, dv = c3 & 127;
        const size_t ld = isctx ? 256 : 4096;
        h16* d = isctx ? vcT + (size_t)((b * 12 + hh) * 128 + dv) * 256 + n_
                       : vT + (size_t)((b * 12 + hh) * 128 + dv) * 4096 + n_;
#pragma unroll
        for (int j = 0; j < 4; ++j) { d[j * ld] = (h16)va[j]; d[(4 + j) * ld] = (h16)vb[j]; }
      }
    }
  }
};

struct EpiDft {
  static constexpr bool PERM = true, AFTER_DRAIN = false;
  h16* cat; float scale; int is_ctx; int mirror;
  DEVI void operator()(AccRef acc, const Unit& u, int wr, int wc, int fr, int fq) const {
    E8P_FOR {
      const int row = E8_ROW, col = E8P_COL;
      const f32x4 va = acc[ai][bj][m][0], vb = acc[ai][bj][m][1];
      const int b = col >> 9, g = (col >> 7) & 3, mm = col & 127;
      const size_t rbase = is_ctx ? (size_t)(TL + b * 256) : (size_t)b * 4096;
      if (!mirror || row <= 2048) store_h8(cat + (rbase + row) * 2048 + g * 128 + mm, va, vb, scale);
      if (mirror && row >= 1 && row <= 2047) {
        h16* mr = cat + (rbase + (4096 - row)) * 2048 + g * 128;
        mr[(128 - mm) & 127] = (h16)(va[0] * scale);
#pragma unroll
        for (int j = 1; j < 4; ++j) mr[128 - mm - j] = (h16)(va[j] * scale);
#pragma unroll
        for (int j = 0; j < 4; ++j) mr[124 - mm - j] = (h16)(vb[j] * scale);
      }
    }
  }
};

DEVI void ld8f(const float* p, float (&o)[8]) { const float4 a = *(const float4*)p, b = *(const float4*)(p + 4); o[0] = a.x; o[1] = a.y; o[2] = a.z; o[3] = a.w; o[4] = b.x; o[5] = b.y; o[6] = b.z; o[7] = b.w; }
DEVI void ld8f(const h16* p, float (&o)[8]) { const h16x8 v = *(const h16x8*)p;
#pragma unroll
  for (int i = 0; i < 8; ++i) o[i] = (float)v[i]; }
template <class TS>
struct EpiRes {
  static constexpr bool PERM = true, AFTER_DRAIN = false;
  const TS *src_lat, *src_ctx;
  h16* xres; const float* gate;
  DEVI void operator()(AccRef acc, const Unit& u, int wr, int wc, int fr, int fq) const {
    const int midx = (u.pm < 64) ? (u.pm >> 4) : 4;
    float gt[2][8];
#pragma unroll
    for (int bj = 0; bj < 2; ++bj) ld8f(gate + midx * 12288 + u.pn * 256 + bj * 128 + wc * 32 + fq * 8, gt[bj]);
#pragma unroll
    for (int ai = 0; ai < 2; ++ai)
#pragma unroll
      for (int m = 0; m < 4; ++m)
#pragma unroll
        for (int bj = 0; bj < 2; ++bj) {
          const int row = u.pm * 256 + ai * 128 + wr * 64 + m * 16 + fr;
          const int col = u.pn * 256 + bj * 128 + wc * 32 + fq * 8;
          const f32x4 v0 = acc[ai][bj][m][0], v1 = acc[ai][bj][m][1];
          float sv[8];
          ld8f(u.pm < 64 ? src_lat + (size_t)row * 2048 + col : src_ctx + (size_t)(row - TL) * 2048 + col, sv);
          h16x8 o;
#pragma unroll
          for (int j = 0; j < 4; ++j) { o[j] = (h16)(sv[j] + gt[bj][j] * v0[j]); o[4 + j] = (h16)(sv[4 + j] + gt[bj][4 + j] * v1[j]); }
          *(h16x8*)(xres + (size_t)row * 2048 + col) = o;
        }
  }
};

struct EpiPartial {
  static constexpr bool PERM = false, AFTER_DRAIN = false;
  float* part;
  DEVI void operator()(AccRef acc, const Unit& u, int wr, int wc, int fr, int fq) const {
    E8_FOR {
      const int row = E8_ROW, col = E8_COL;
      *(f32x4*)(part + (size_t)row * 2048 + col) = acc[ai][bj][m][n];
    }
  }
};

struct EpiGU {
  static constexpr bool PERM = true, AFTER_DRAIN = false;
  h16* act;
  DEVI void operator()(AccRef acc, const Unit& u, int wr, int wc, int fr, int fq) const {
#pragma unroll
    for (int ai = 0; ai < 2; ++ai)
#pragma unroll
      for (int m = 0; m < 4; ++m) {
        const int row = u.pm * 256 + ai * 128 + wr * 64 + m * 16 + fr;
        const int ocol = u.pn * 128 + wc * 32 + fq * 8;
        const f32x4 g0 = acc[ai][0][m][0], g1 = acc[ai][0][m][1], u0 = acc[ai][1][m][0], u1 = acc[ai][1][m][1];
        h16x8 o;
#pragma unroll
        for (int j = 0; j < 4; ++j) { o[j] = (h16)(silu_f(g0[j]) * u0[j]); o[4 + j] = (h16)(silu_f(g1[j]) * u1[j]); }
        *(h16x8*)(act + (size_t)row * DFF + ocol) = o;
      }
  }
};

struct EpiStore {
  static constexpr bool PERM = true, AFTER_DRAIN = false;
  h16* dst; int ldd;
  DEVI void operator()(AccRef acc, const Unit& u, int wr, int wc, int fr, int fq) const {
    E8P_FOR {
      const int row = E8_ROW, col = E8P_COL;
      store_h8(dst + (size_t)row * ldd + col, acc[ai][bj][m][0], acc[ai][bj][m][1]);
    }
  }
};

constexpr float LOG2E = 1.4426950408889634f;

struct EpiQ1 {
  static constexpr bool PERM = false, AFTER_DRAIN = false;
  h16* q1;
  DEVI void operator()(AccRef acc, const Unit& u, int wr, int wc, int fr, int fq) const {
    const float qs = 0.07216878364870322f * LOG2E;
#pragma unroll
    for (int bj = 0; bj < 2; ++bj) {
      const int cgb = u.pn * 256 + bj * 128 + wc * 32;
      const int w = cgb % 192;
      if (w < 128) {
#pragma unroll
        for (int ai = 0; ai < 2; ++ai)
#pragma unroll
          for (int m = 0; m < 4; ++m)
#pragma unroll
            for (int n = 0; n < 2; ++n) {
              const int row = u.pm * 256 + ai * 128 + wr * 64 + m * 16 + fr;
              const f32x4 v = acc[ai][bj][m][n];
              store_h4(q1 + (size_t)row * 2304 + cgb + n * 16 + fq * 4, v[0] * qs, v[1] * qs, v[2] * qs, v[3] * qs);
            }
      } else {
        const int half = (w - 128) >> 5;
        float inv[4];
#pragma unroll
        for (int j = 0; j < 4; ++j) inv[j] = fexp2(-(float)(fq * 4 + j) * (13.287712379549449f / 16.0f)) * 0.15915494309189535f;
#pragma unroll
        for (int ai = 0; ai < 2; ++ai)
#pragma unroll
          for (int m = 0; m < 4; ++m) {
            const int row = u.pm * 256 + ai * 128 + wr * 64 + m * 16 + fr;
            const int t = row & 4095;
            const float pos = (float)(half ? (t & 63) : (t >> 6));
            const f32x4 a = acc[ai][bj][m][0], bb = acc[ai][bj][m][1];
            float o1[4], o2[4];
#pragma unroll
            for (int j = 0; j < 4; ++j) {
              const float rev = pos * inv[j];
              const float cs = cos_rev(rev), sn = sin_rev(rev);
              o1[j] = (a[j] * cs - bb[j] * sn) * qs;
              o2[j] = (a[j] * sn + bb[j] * cs) * qs;
            }
            h16* d = q1 + (size_t)row * 2304 + cgb + fq * 4;
            store_h4(d, o1[0], o1[1], o1[2], o1[3]);
            store_h4(d + 16, o2[0], o2[1], o2[2], o2[3]);
          }
      }
    }
  }
};

struct EpiKV1 {
  static constexpr bool PERM = true, AFTER_DRAIN = false;
  h16 *kn, *vT1;
  DEVI void operator()(AccRef acc, const Unit& u, int wr, int wc, int fr, int fq) const {
    const int hh = u.pn;
    E8P_FOR {
      const int row = E8_ROW;
      const f32x4 va = acc[ai][bj][m][0], vb = acc[ai][bj][m][1];
      int b, key;
      if (row < TL) { b = row >> 12; key = 256 + (row & 4095); } else { b = (row - TL) >> 8; key = (row - TL) & 255; }
      const int w = wc * 32 + fq * 8;
      if (bj == 0) {
        store_h8(kn + ((size_t)b * 4352 + key) * 1536 + hh * 128 + w, va, vb);
      } else {
        h16* d = vT1 + (size_t)((b * 12 + hh) * 128 + w) * 4352 + key;
#pragma unroll
        for (int j = 0; j < 4; ++j) { d[(size_t)j * 4352] = (h16)va[j]; d[(size_t)(4 + j) * 4352] = (h16)vb[j]; }
      }
    }
  }
};

DEVI void mod_units(const Params& p, float* smemf) {
  float* mod = (float*)(p.ws + OFF_MOD);
  const int tid = tidx();
  float* ss = smemf;
  float* red = smemf + 5 * 2048;
  for (int i = tid; i < 5 * 2048; i += NTHR) {
    const int s = i >> 11, k = i & 2047;
    const float v = s < 4 ? p.c[s * 2048 + k] : p.c_ctx[k];
    ss[i] = silu_f(v);
  }
  __syncthreads();
  for (int u = blockIdx.x; u < 768; u += gridDim.x) {
    const int l = u / 384, n0 = (u % 384) * 32;
    const int cl = (tid & 7) * 4, kg = tid >> 3;
    const float* wp = p.w_mod + ((size_t)l * 2048 + kg * 32) * 12288 + n0 + cl;
    float4 a0 = {0, 0, 0, 0}, a1 = a0, a2 = a0, a3 = a0, a4 = a0;
#pragma unroll 8
    for (int kk = 0; kk < 32; ++kk) {
      const float4 w = ldnt4(wp + (size_t)kk * 12288);
      const int k = kg * 32 + kk;
      const float s0 = ss[k], s1 = ss[2048 + k], s2 = ss[4096 + k], s3 = ss[6144 + k], s4 = ss[8192 + k];
      a0.x += s0 * w.x; a0.y += s0 * w.y; a0.z += s0 * w.z; a0.w += s0 * w.w;
      a1.x += s1 * w.x; a1.y += s1 * w.y; a1.z += s1 * w.z; a1.w += s1 * w.w;
      a2.x += s2 * w.x; a2.y += s2 * w.y; a2.z += s2 * w.z; a2.w += s2 * w.w;
      a3.x += s3 * w.x; a3.y += s3 * w.y; a3.z += s3 * w.z; a3.w += s3 * w.w;
      a4.x += s4 * w.x; a4.y += s4 * w.y; a4.z += s4 * w.z; a4.w += s4 * w.w;
    }
    *(float4*)(red + (kg * 5 + 0) * 32 + cl) = a0;
    *(float4*)(red + (kg * 5 + 1) * 32 + cl) = a1;
    *(float4*)(red + (kg * 5 + 2) * 32 + cl) = a2;
    *(float4*)(red + (kg * 5 + 3) * 32 + cl) = a3;
    *(float4*)(red + (kg * 5 + 4) * 32 + cl) = a4;
    __syncthreads();
    if (tid < 160) {
      const int s = tid >> 5, cc = tid & 31;
      float sum = 0.f;
#pragma unroll 16
      for (int g = 0; g < 64; ++g) sum += red[(g * 5 + s) * 32 + cc];
      mod[(size_t)(l * 5 + s) * 12288 + n0 + cc] = sum + p.b_mod[l * 12288 + n0 + cc];
    }
    __syncthreads();
  }
}

DEVI int maprow(int mode, int n) {
  if (mode == 0) return n;
  if (mode == 1) return (n >> 7) * 256 + (n & 127);
  return (n >> 7) * 256 + 128 + (n & 127);
}
DEVI unsigned pack_h2(float lo, float hi) {
  typedef _Float16 h16x2 __attribute__((ext_vector_type(2)));
  h16x2 v; v[0] = (h16)lo; v[1] = (h16)hi;
  return __builtin_bit_cast(unsigned, v);
}
DEVI void transpose_job(const float* __restrict__ src, int ldsrc, int K, int N, int ncol0, h16* __restrict__ dst,
                        int ldd, int dcol0, int mode, float* tile_base, int worker, int nworkers) {
  const int tid = tidx();
  const int half = tid >> 8, tl = tid & 255;
  h16* tile = (h16*)tile_base + half * (64 * 68);
  const int nkt = K >> 6, nnt = N >> 6;
  const int ntiles = nkt * nnt;
  const int kp2 = (tl >> 4) * 2, lc4 = (tl & 15) * 4;
  float4 cur[4], nxt[4];
  int t = worker * 2 + half;
  const int tstride = nworkers * 2;
  if (t < ntiles) {
    const int kt = t / nnt, nt = t - kt * nnt;
    const float* sp = src + (size_t)(kt * 64 + kp2) * ldsrc + ncol0 + nt * 64 + lc4;
    cur[0] = ldnt4(sp); cur[1] = ldnt4(sp + ldsrc);
    cur[2] = ldnt4(sp + (size_t)32 * ldsrc); cur[3] = ldnt4(sp + (size_t)33 * ldsrc);
  }
  for (int t0 = worker * 2; t0 < ntiles; t0 += tstride, t += tstride) {
    const bool active = t < ntiles;
    const int tn = t + tstride;
    if (tn < ntiles) {
      const int kt = tn / nnt, nt = tn - kt * nnt;
      const float* sp = src + (size_t)(kt * 64 + kp2) * ldsrc + ncol0 + nt * 64 + lc4;
      nxt[0] = ldnt4(sp); nxt[1] = ldnt4(sp + ldsrc);
      nxt[2] = ldnt4(sp + (size_t)32 * ldsrc); nxt[3] = ldnt4(sp + (size_t)33 * ldsrc);
    }
    const int kt = t / nnt, nt = t - kt * nnt;
    const int k0 = kt * 64, n0 = nt * 64;
    if (active) {
      unsigned* tw = (unsigned*)tile;
#pragma unroll
      for (int i = 0; i < 2; ++i) {
        const int kd = (i * 32 + kp2) >> 1;
        const float4 a = cur[2 * i], bq = cur[2 * i + 1];
        tw[(lc4 + 0) * 34 + kd] = pack_h2(a.x, bq.x);
        tw[(lc4 + 1) * 34 + kd] = pack_h2(a.y, bq.y);
        tw[(lc4 + 2) * 34 + kd] = pack_h2(a.z, bq.z);
        tw[(lc4 + 3) * 34 + kd] = pack_h2(a.w, bq.w);
      }
    }
    __syncthreads();
    if (active) {
      const int n = tl >> 2, ks = (tl & 3) * 16;
      const uint2* rp = (const uint2*)(tile + n * 68 + ks);
      const uint2 r0 = rp[0], r1 = rp[1], r2 = rp[2], r3 = rp[3];
      h16* d = dst + (size_t)maprow(mode, n0 + n) * ldd + dcol0 + k0 + ks;
      *(uint4*)d = make_uint4(r0.x, r0.y, r1.x, r1.y);
      *(uint4*)(d + 8) = make_uint4(r2.x, r2.y, r3.x, r3.y);
    }
    __syncthreads();
#pragma unroll
    for (int i = 0; i < 4; ++i) cur[i] = nxt[i];
  }
}

DEVI void dft_gen(const Params& p) {
  h16* A = (h16*)(p.ws + OFF_DFTA);
  h16* Ac = (h16*)(p.ws + OFF_DFTAC);
  const size_t nthr = (size_t)gridDim.x * NTHR;
  const size_t gtid = (size_t)blockIdx.x * NTHR + tidx();
  if (gtid < 8) ((int*)(p.ws + OFF_CTR))[gtid * 8] = 0;
  for (size_t ch = gtid; ch < (size_t)2304 * 1024; ch += nthr) {
    const int k = (int)(ch >> 10), n8 = (int)(ch & 1023) * 8;
    h16x8 o;
#pragma unroll
    for (int e = 0; e < 8; ++e) {
      const int nn = n8 + e;
      const int n = nn & 4095;
      const float rev = (float)((k * n) & 4095) * (1.0f / 4096.0f);
      o[e] = (h16)((nn < 4096) ? cos_rev(rev) : -sin_rev(rev));
    }
    *(h16x8*)(A + (size_t)k * 8192 + n8) = o;
  }
  for (size_t ch = gtid; ch < (size_t)256 * 64; ch += nthr) {
    const int k = (int)(ch >> 6), n8 = (int)(ch & 63) * 8;
    h16x8 o;
#pragma unroll
    for (int e = 0; e < 8; ++e) {
      const int nn = n8 + e;
      const int n = nn & 255;
      const float rev = (float)((k * n) & 255) * (1.0f / 256.0f);
      o[e] = (h16)((nn < 256) ? cos_rev(rev) : -sin_rev(rev));
    }
    *(h16x8*)(Ac + (size_t)k * 512 + n8) = o;
  }
  h16* z = (h16*)(p.ws + OFF_WT_IN_CD) + (size_t)1856 * 2048;
  for (size_t ch = gtid; ch < (size_t)192 * 2048 / 8; ch += nthr) {
    uint4 zz = {0, 0, 0, 0};
    *(uint4*)(z + ch * 8) = zz;
  }
}

DEVI void fold_uc(const Params& p, float* smemf) {
  h16* wt = (h16*)(p.ws + OFF_WT_IN_AB);
  float* wl = smemf;
  float* ct = smemf + 128 * 64;
  float* st = ct + 128;
  const int tid = tidx();
  for (int u = blockIdx.x; u < 128; u += gridDim.x) {
    const int kb = u >> 2, g = u & 3, k0 = kb * 64;
    for (int i = tid; i < 64 * 32; i += NTHR) {
      const int kk = i >> 5, c4 = (i & 31) * 4;
      const float4 v = *(const float4*)(p.w_in_ab + (size_t)(k0 + kk) * 5120 + g * 128 + c4);
      wl[(c4 + 0) * 64 + kk] = v.x; wl[(c4 + 1) * 64 + kk] = v.y; wl[(c4 + 2) * 64 + kk] = v.z; wl[(c4 + 3) * 64 + kk] = v.w;
    }
    if (tid < 128) { ct[tid] = cos_rev((float)tid * (1.0f / 128.0f)); st[tid] = sin_rev((float)tid * (1.0f / 128.0f)); }
    __syncthreads();
    const int kh = tid >> 8, t2 = tid & 255;
    const int part = t2 >> 7, m = t2 & 127;
    const float* tab = part ? st : ct;
    float acc[32];
#pragma unroll
    for (int i = 0; i < 32; ++i) acc[i] = 0.f;
    for (int c = 0; c < 128; ++c) {
      const float tw = tab[(c * m) & 127];
#pragma unroll
      for (int k4 = 0; k4 < 8; ++k4) {
        const float4 w = *(const float4*)(wl + c * 64 + kh * 32 + k4 * 4);
        acc[k4 * 4 + 0] += w.x * tw; acc[k4 * 4 + 1] += w.y * tw; acc[k4 * 4 + 2] += w.z * tw; acc[k4 * 4 + 3] += w.w * tw;
      }
    }
    h16* d = wt + (size_t)(g * 256 + t2) * 2048 + k0 + kh * 32;
#pragma unroll
    for (int c8 = 0; c8 < 4; ++c8) {
      h16x8 o;
#pragma unroll
      for (int e = 0; e < 8; ++e) o[e] = (h16)acc[c8 * 8 + e];
      *(h16x8*)(d + c8 * 8) = o;
    }
    __syncthreads();
  }
}

DEVI void fold_out(const float* __restrict__ wg, const float* __restrict__ ps, const float* __restrict__ w_out,
                   h16* __restrict__ wt, float* smemf, int worker, int nworkers) {
  float* wl = smemf;
  float* wgl = smemf + 128 * 64;
  const int tid = tidx();
  for (int u = worker; u < 128; u += nworkers) {
    const int g = u >> 5, j0 = (u & 31) * 64;
    for (int i = tid; i < 128 * 16; i += NTHR) {
      const int d = i >> 4, c4 = (i & 15) * 4;
      float4 v = *(const float4*)(w_out + (size_t)(g * 128 + d) * 2048 + j0 + c4);
      const float sc = ps ? ps[g * 128 + d] : 1.0f;
      v.x *= sc; v.y *= sc; v.z *= sc; v.w *= sc;
      *(float4*)(wl + d * 64 + c4) = v;
    }
    for (int i = tid; i < 128 * 32; i += NTHR) {
      const int c = i >> 5, d4 = (i & 31) * 4;
      *(float4*)(wgl + c * 132 + d4) = *(const float4*)(wg + (size_t)(g * 128 + c) * 128 + d4);
    }
    __syncthreads();
    const int j = tid & 63;
    const int cg_ = __builtin_amdgcn_readfirstlane(tid >> 6);
    float acc[16];
#pragma unroll
    for (int i = 0; i < 16; ++i) acc[i] = 0.f;
    const float* wgp = wgl + (cg_ * 16) * 132;
    for (int d4 = 0; d4 < 32; ++d4) {
      const float w0 = wl[(d4 * 4 + 0) * 64 + j], w1 = wl[(d4 * 4 + 1) * 64 + j], w2 = wl[(d4 * 4 + 2) * 64 + j], w3 = wl[(d4 * 4 + 3) * 64 + j];
#pragma unroll
      for (int cc = 0; cc < 16; ++cc) {
        const float4 gq = *(const float4*)(wgp + cc * 132 + d4 * 4);
        acc[cc] += gq.x * w0 + gq.y * w1 + gq.z * w2 + gq.w * w3;
      }
    }
    h16* dst = wt + (size_t)(j0 + j) * 2048 + g * 128 + cg_ * 16;
#pragma unroll
    for (int c8 = 0; c8 < 2; ++c8) {
      h16x8 o;
#pragma unroll
      for (int e = 0; e < 8; ++e) o[e] = (h16)acc[c8 * 8 + e];
      *(h16x8*)(dst + c8 * 8) = o;
    }
    __syncthreads();
  }
}

DEVI void phase0(const Params& p, float* smemf) {
  const int w = blockIdx.x, nw = gridDim.x;
  mod_units(p, smemf);
  dft_gen(p);
  fold_uc(p, smemf);
  fold_out(p.w_four, nullptr, p.w_out_ab, (h16*)(p.ws + OFF_WT_OUT_AB), smemf, w, nw);
  transpose_job(p.w_in_ab, 5120, 2048, 4608, 512, (h16*)(p.ws + OFF_WT_IN_AB) + (size_t)1024 * 2048, 2048, 0, 0, smemf, w, nw);
  transpose_job(p.w_out_ab + (size_t)512 * 2048, 2048, 1536, 2048, 0, (h16*)(p.ws + OFF_WT_OUT_AB), 2048, 512, 0, smemf, w, nw);
}
DEVI void prep_ffn_gu(const Params& p, int l, float* smemf, int w, int nw) {
  h16* gu = (h16*)(p.ws + (l ? OFF_WT_GU1 : OFF_WT_GU0));
  transpose_job(p.w_ffn_gate + (size_t)l * 2048 * DFF, DFF, 2048, DFF, 0, gu, 2048, 0, 1, smemf, w, nw);
  transpose_job(p.w_ffn_up + (size_t)l * 2048 * DFF, DFF, 2048, DFF, 0, gu, 2048, 0, 2, smemf, w, nw);
}
DEVI void prep_ffn_dn(const Params& p, int l, float* smemf, int w, int nw) {
  h16* dn = (h16*)(p.ws + (l ? OFF_WT_D1 : OFF_WT_D0));
  transpose_job(p.w_ffn_down + (size_t)l * DFF * 2048, 2048, DFF, 2048, 0, dn, DFF, 0, 0, smemf, w, nw);
}
DEVI void prep_ffn(const Params& p, int l, float* smemf, int w, int nw) {
  prep_ffn_gu(p, l, smemf, w, nw);
  prep_ffn_dn(p, l, smemf, w, nw);
}
DEVI void prep_layer1(const Params& p, float* smemf, int w, int nw, bool with_ffn = true) {
  fold_out(p.w_pool, p.pool_scale, p.w_out_cd, (h16*)(p.ws + OFF_WT_OUT_CD), smemf, w, nw);
  transpose_job(p.w_out_cd + (size_t)512 * 2048, 2048, 1536, 2048, 0, (h16*)(p.ws + OFF_WT_OUT_CD), 2048, 512, 0, smemf, w, nw);
  transpose_job(p.w_in_cd, 1856, 2048, 1856, 0, (h16*)(p.ws + OFF_WT_IN_CD), 2048, 0, 0, smemf, w, nw);
  transpose_job(p.w_uq, 2304, 768, 2304, 0, (h16*)(p.ws + OFF_WT_UQ), 768, 0, 0, smemf, w, nw);
  transpose_job(p.w_ukv, 3072, 512, 3072, 0, (h16*)(p.ws + OFF_WT_UKV), 512, 0, 0, smemf, w, nw);
  if (with_ffn) prep_ffn(p, 1, smemf, w, nw);
}

template <class TS>
DEVI void norm_mod_phase(const TS* src_lat, const TS* src_ctx, int nrows, const float* gvec, const float* modl,
                         int sh_idx, int sc_idx, h16* dst) {
  const int tid_ = tidx();
  const int lane = tid_ & 63, wid = tid_ >> 6;
  const int w = blockIdx.x * 8 + wid, nw = gridDim.x * 8;
  const int rbeg = (int)(((long)w * nrows) / nw), rend = (int)(((long)(w + 1) * nrows) / nw);
  if (rbeg >= rend) return;
  float4 fa[8], fb[8], v[8], vn[8];
  int cur_midx = -1;
  {
    const TS* s = rbeg < TL ? src_lat + (size_t)rbeg * 2048 : src_ctx + (size_t)(rbeg - TL) * 2048;
#pragma unroll
    for (int i = 0; i < 8; ++i) v[i] = ld4f(s + (i * 64 + lane) * 4);
  }
  for (int row = rbeg; row < rend; ++row) {
    if (row + 1 < rend) {
      const int r2 = row + 1;
      const TS* s = r2 < TL ? src_lat + (size_t)r2 * 2048 : src_ctx + (size_t)(r2 - TL) * 2048;
#pragma unroll
      for (int i = 0; i < 8; ++i) vn[i] = ld4f(s + (i * 64 + lane) * 4);
    }
    const int midx = row < TL ? (row >> 12) : 4;
    if (midx != cur_midx) {
      cur_midx = midx;
      const float* shp = modl + (size_t)midx * 12288 + sh_idx * 2048;
      const float* scp = modl + (size_t)midx * 12288 + sc_idx * 2048;
#pragma unroll
      for (int i = 0; i < 8; ++i) {
        const int col = (i * 64 + lane) * 4;
        const float4 g = *(const float4*)(gvec + col);
        const float4 sc = *(const float4*)(scp + col);
        fb[i] = *(const float4*)(shp + col);
        fa[i].x = g.x * (1.f + sc.x); fa[i].y = g.y * (1.f + sc.y); fa[i].z = g.z * (1.f + sc.z); fa[i].w = g.w * (1.f + sc.w);
      }
    }
    float ss = 0.f;
#pragma unroll
    for (int i = 0; i < 8; ++i) ss += v[i].x * v[i].x + v[i].y * v[i].y + v[i].z * v[i].z + v[i].w * v[i].w;
    ss = wave_sum(ss);
    const float rstd = rsqrtf(ss * (1.0f / 2048.0f) + 1e-6f);
#pragma unroll
    for (int i = 0; i < 8; ++i) {
      const int col = (i * 64 + lane) * 4;
      store_h4(dst + (size_t)row * 2048 + col, v[i].x * rstd * fa[i].x + fb[i].x, v[i].y * rstd * fa[i].y + fb[i].y,
               v[i].z * rstd * fa[i].z + fb[i].z, v[i].w * rstd * fa[i].w + fb[i].w);
    }
#pragma unroll
    for (int i = 0; i < 8; ++i) v[i] = vn[i];
  }
}

DEVI void ctx_norm_partial_phase(const h16* src_ctx, const float* gvec, const float* modl, int sh_idx, int sc_idx, h16* dst,
                                 const float* part, int nsplit, const float* pgate) {
  const int tid_ = tidx();
  const int lane = tid_ & 63, wid = tid_ >> 6;
  const int w = blockIdx.x * 8 + wid, nw = gridDim.x * 8;
  const float* shp = modl + (size_t)4 * 12288 + sh_idx * 2048;
  const float* scp = modl + (size_t)4 * 12288 + sc_idx * 2048;
  for (int r = w; r < TC; r += nw) {
    float4 v[8];
    float ss = 0.f;
#pragma unroll
    for (int i = 0; i < 8; ++i) {
      const int col = (i * 64 + lane) * 4;
      float4 acc = make_float4(0.f, 0.f, 0.f, 0.f);
      for (int sp = 0; sp < nsplit; ++sp) {
        const float4 q = *(const float4*)(part + ((size_t)sp * TC + r) * 2048 + col);
        acc.x += q.x; acc.y += q.y; acc.z += q.z; acc.w += q.w;
      }
      const float4 gq = *(const float4*)(pgate + col);
      const float4 x = ld4f(src_ctx + (size_t)r * 2048 + col);
      v[i].x = x.x + gq.x * acc.x; v[i].y = x.y + gq.y * acc.y; v[i].z = x.z + gq.z * acc.z; v[i].w = x.w + gq.w * acc.w;
      ss += v[i].x * v[i].x + v[i].y * v[i].y + v[i].z * v[i].z + v[i].w * v[i].w;
    }
    ss = wave_sum(ss);
    const float rstd = rsqrtf(ss * (1.0f / 2048.0f) + 1e-6f);
#pragma unroll
    for (int i = 0; i < 8; ++i) {
      const int col = (i * 64 + lane) * 4;
      const float4 g = *(const float4*)(gvec + col);
      const float4 sh = *(const float4*)(shp + col);
      const float4 sc = *(const float4*)(scp + col);
      store_h4(dst + (size_t)(TL + r) * 2048 + col, v[i].x * rstd * g.x * (1.f + sc.x) + sh.x, v[i].y * rstd * g.y * (1.f + sc.y) + sh.y,
               v[i].z * rstd * g.z * (1.f + sc.z) + sh.z, v[i].w * rstd * g.w * (1.f + sc.w) + sh.w);
    }
  }
}

DEVI void final_norm_phase(const h16* xres, const float* gvec, float* out) {
  const int tid_ = tidx();
  const int lane = tid_ & 63, wid = tid_ >> 6;
  const int w = blockIdx.x * 8 + wid, nw = gridDim.x * 8;
  const int rbeg = (int)(((long)w * TL) / nw), rend = (int)(((long)(w + 1) * TL) / nw);
  if (rbeg >= rend) return;
  float4 fa[8], v[8], vn[8];
#pragma unroll
  for (int i = 0; i < 8; ++i) {
    fa[i] = *(const float4*)(gvec + (i * 64 + lane) * 4);
    v[i] = ld4f(xres + (size_t)rbeg * 2048 + (i * 64 + lane) * 4);
  }
  for (int row = rbeg; row < rend; ++row) {
    if (row + 1 < rend) {
#pragma unroll
      for (int i = 0; i < 8; ++i) vn[i] = ld4f(xres + (size_t)(row + 1) * 2048 + (i * 64 + lane) * 4);
    }
    float ss = 0.f;
#pragma unroll
    for (int i = 0; i < 8; ++i) ss += v[i].x * v[i].x + v[i].y * v[i].y + v[i].z * v[i].z + v[i].w * v[i].w;
    ss = wave_sum(ss);
    const float rstd = rsqrtf(ss * (1.0f / 2048.0f) + 1e-6f);
#pragma unroll
    for (int i = 0; i < 8; ++i) {
      float4 o;
      o.x = v[i].x * rstd * fa[i].x; o.y = v[i].y * rstd * fa[i].y; o.z = v[i].z * rstd * fa[i].z; o.w = v[i].w * rstd * fa[i].w;
      stnt4(out + (size_t)row * 2048 + (i * 64 + lane) * 4, o);
    }
#pragma unroll
    for (int i = 0; i < 8; ++i) v[i] = vn[i];
  }
}

constexpr int NA_KS = 136;
constexpr int NA_VS = 136;
constexpr int NA_BUF = 128 * NA_KS + 128 * NA_VS;
template <int VAR>
DEVI void na_block_unit(const Params& p, int bu, h16* smem) {
  const h16* q0 = (const h16*)(p.ws + OFF_Q0);
  const h16* k0 = (const h16*)(p.ws + OFF_K0);
  const h16* vT = (const h16*)(p.ws + OFF_VT0);
  const h16* vcT = (const h16*)(p.ws + OFF_VCT0);
  h16* cat = VAR ? (h16*)p.out : (h16*)(p.ws + OFF_CAT);
  const int tid = tidx(), lane = tid & 63, wid = tid >> 6;
  const int q_ = lane & 15, g = lane >> 4;
  const bool is_ctx = bu >= 1536;
  int bh, rp = 0, half = 0;
  if (!is_ctx) { rp = bu & 31; bh = bu >> 5; } else { const int uu = bu - 1536; half = uu & 1; bh = uu >> 1; }
  const int hd = bh % 12, b = bh / 12;
  const int rw = 2 * rp + (wid >> 2), j = wid & 3;
  const size_t qrow = is_ctx ? (size_t)(TL + b * 256 + half * 128 + wid * 16 + q_) : (size_t)(b * 4096 + rw * 64 + j * 16 + q_);
  const int rs0 = min(max(2 * rp - 4, 0), 56), rs1 = min(max(2 * rp - 3, 0), 56);
  const int nrows = is_ctx ? 0 : (rs1 - rs0 + 8);
  const int nloc = (nrows + 1) >> 1;
  const int T = nloc + 2;
  const int rsw = min(max(rw - 4, 0), 56);
  const h16* qp = q0 + qrow * 1536 + hd * 128 + g * 8;
  h16x8 qf[4];
#pragma unroll
  for (int s = 0; s < 4; ++s) qf[s] = *(const h16x8*)(qp + s * 32);
  f32x4 o[8];
#pragma unroll
  for (int d = 0; d < 8; ++d) { o[d][0] = 0.f; o[d][1] = 0.f; o[d][2] = 0.f; o[d][3] = 0.f; }
  float m = -1e30f, lsum = 0.f;
  const int kstart = min(max(j * 16 - 8, 0), 32);
  const int qc = j * 16 + q_;
  const int cstart = min(max(qc - 8, 0), 48);
  const float scale = 0.08838834764831845f * LOG2E;
  float* rpb = (float*)(smem + 2 * NA_BUF);
  if (!is_ctx && tid < 465) rpb[tid] = p.na_rpb[hd * 465 + tid] * LOG2E;
  const int srow = tid >> 4, sch = tid & 15;
  const h16* kloc = k0 + (size_t)b * 4096 * 1536 + hd * 128 + (size_t)srow * 1536 + sch * 8;
  const h16* kctx = k0 + ((size_t)TL + b * 256) * 1536 + hd * 128 + (size_t)srow * 1536 + sch * 8;
  const h16* vloc = vT + ((size_t)(b * 12 + hd) * 128 + srow) * 4096 + sch * 8;
  const h16* vctx = vcT + ((size_t)(b * 12 + hd) * 128 + srow) * 256 + sch * 8;
  uint4 A0, A1, A2, A3, A4, A5, A6, A7;
#define NA_GLOAD(t, R0, R1, R2, R3, R4, R5, R6, R7)                                                    \
  {                                                                                                    \
    if ((t) < nloc) {                                                                                  \
      const int krow = rs0 + 2 * (t);                        \
      const h16* kb = kloc + (size_t)krow * 64 * 1536;                                                 \
      const h16* vb = vloc + krow * 64;                                                                \
      R0 = *(const uint4*)kb; R1 = *(const uint4*)(kb + 32 * 1536);                                    \
      R2 = *(const uint4*)(kb + 64 * 1536); R3 = *(const uint4*)(kb + 96 * 1536);                      \
      R4 = *(const uint4*)vb; R5 = *(const uint4*)(vb + (size_t)32 * 4096);                            \
      R6 = *(const uint4*)(vb + (size_t)64 * 4096); R7 = *(const uint4*)(vb + (size_t)96 * 4096);      \
    } else {                                                                                           \
      const int c = (t) - nloc;                                                                        \
      const h16* kb = kctx + (size_t)c * 128 * 1536;                                                   \
      const h16* vb = vctx + c * 128;                                                                  \
      R0 = *(const uint4*)kb; R1 = *(const uint4*)(kb + 32 * 1536);                                    \
      R2 = *(const uint4*)(kb + 64 * 1536); R3 = *(const uint4*)(kb + 96 * 1536);                      \
      R4 = *(const uint4*)vb; R5 = *(const uint4*)(vb + 32 * 256);                                     \
      R6 = *(const uint4*)(vb + 64 * 256); R7 = *(const uint4*)(vb + 96 * 256);                        \
    }                                                                                                  \
  }
#define NA_SSTORE(buf, R0, R1, R2, R3, R4, R5, R6, R7)                                                 \
  {                                                                                                    \
    h16* bk = smem + (buf) * NA_BUF;                                                                   \
    h16* bv = bk + 128 * NA_KS;                                                                        \
    *(uint4*)(bk + srow * NA_KS + sch * 8) = R0;                                                       \
    *(uint4*)(bk + (srow + 32) * NA_KS + sch * 8) = R1;                                                \
    *(uint4*)(bk + (srow + 64) * NA_KS + sch * 8) = R2;                                                \
    *(uint4*)(bk + (srow + 96) * NA_KS + sch * 8) = R3;                                                \
    *(uint4*)(bv + srow * NA_VS + sch * 8) = R4;                                                       \
    *(uint4*)(bv + (srow + 32) * NA_VS + sch * 8) = R5;                                                \
    *(uint4*)(bv + (srow + 64) * NA_VS + sch * 8) = R6;                                                \
    *(uint4*)(bv + (srow + 96) * NA_VS + sch * 8) = R7;                                                \
  }
  auto iter32 = [&](const h16* sKw, const h16* sVw, bool loc, int ridx) {
    f32x4 s0 = {0.f, 0.f, 0.f, 0.f}, s1 = {0.f, 0.f, 0.f, 0.f};
    const h16* kp = sKw + q_ * NA_KS + g * 8;
#pragma unroll
    for (int s = 0; s < 4; ++s) {
      const h16x8 ka = *(const h16x8*)(kp + s * 32);
      const h16x8 kb = *(const h16x8*)(kp + 16 * NA_KS + s * 32);
      s0 = mfma16(ka, qf[s], s0);
      s1 = mfma16(kb, qf[s], s1);
    }
    float sc[8];
#pragma unroll
    for (int i = 0; i < 4; ++i) { sc[i] = s0[i] * scale; sc[4 + i] = s1[i] * scale; }
    if (loc) {
#pragma unroll
      for (int i = 0; i < 8; ++i) {
        const int kcol = kstart + (i >> 2) * 16 + g * 4 + (i & 3);
        const bool valid = (kcol >= cstart) && (kcol < cstart + 16);
        const int cidx = min(max(kcol - qc + 15, 0), 30);
        const float bias = rpb[ridx * 31 + cidx];
        sc[i] = valid ? (sc[i] + bias) : -1e30f;
      }
    }
    float mx = sc[0];
#pragma unroll
    for (int i = 1; i < 8; ++i) mx = fmaxf(mx, sc[i]);
    mx = fmaxf(mx, __shfl_xor(mx, 16));
    mx = fmaxf(mx, __shfl_xor(mx, 32));
    const float mn = fmaxf(m, mx);
    const float alpha = fexp2(m - mn);
    m = mn;
    float ps = 0.f;
    h16x8 pf;
#pragma unroll
    for (int i = 0; i < 8; ++i) {
      const float pv = fexp2(sc[i] - mn);
      ps += pv;
      pf[i] = (h16)pv;
    }
    lsum = lsum * alpha + ps;
#pragma unroll
    for (int d = 0; d < 8; ++d) {
      o[d][0] *= alpha; o[d][1] *= alpha; o[d][2] *= alpha; o[d][3] *= alpha;
      const h16* vp = sVw + (d * 16 + q_) * NA_VS + g * 4;
      const h16x4 lo = *(const h16x4*)vp;
      const h16x4 hi = *(const h16x4*)(vp + 16);
      h16x8 vf;
      vf[0] = lo[0]; vf[1] = lo[1]; vf[2] = lo[2]; vf[3] = lo[3];
      vf[4] = hi[0]; vf[5] = hi[1]; vf[6] = hi[2]; vf[7] = hi[3];
      o[d] = mfma16(vf, pf, o[d]);
    }
  };
  auto iter64 = [&](const h16* sK0, const h16* sV0, const h16* sK1, const h16* sV1, bool loc, int ridx0, int ridx1) {
    f32x4 s00 = {0.f, 0.f, 0.f, 0.f}, s01 = s00, s10 = s00, s11 = s00;
    const h16* kp0 = sK0 + q_ * NA_KS + g * 8;
    const h16* kp1 = sK1 + q_ * NA_KS + g * 8;
#pragma unroll
    for (int s = 0; s < 4; ++s) {
      s00 = mfma16(*(const h16x8*)(kp0 + s * 32), qf[s], s00);
      s01 = mfma16(*(const h16x8*)(kp0 + 16 * NA_KS + s * 32), qf[s], s01);
      s10 = mfma16(*(const h16x8*)(kp1 + s * 32), qf[s], s10);
      s11 = mfma16(*(const h16x8*)(kp1 + 16 * NA_KS + s * 32), qf[s], s11);
    }
    float sc[16];
#pragma unroll
    for (int i = 0; i < 4; ++i) { sc[i] = s00[i] * scale; sc[4 + i] = s01[i] * scale; sc[8 + i] = s10[i] * scale; sc[12 + i] = s11[i] * scale; }
    if (loc) {
#pragma unroll
      for (int i = 0; i < 8; ++i) {
        const int kcol = kstart + (i >> 2) * 16 + g * 4 + (i & 3);
        const bool valid = (kcol >= cstart) && (kcol < cstart + 16);
        const int cidx = min(max(kcol - qc + 15, 0), 30);
        sc[i] = valid ? (sc[i] + rpb[ridx0 * 31 + cidx]) : -1e30f;
        sc[8 + i] = valid ? (sc[8 + i] + rpb[ridx1 * 31 + cidx]) : -1e30f;
      }
    }
    float mx = sc[0];
#pragma unroll
    for (int i = 1; i < 16; ++i) mx = fmaxf(mx, sc[i]);
    mx = fmaxf(mx, __shfl_xor(mx, 16));
    mx = fmaxf(mx, __shfl_xor(mx, 32));
    const float mn = fmaxf(m, mx);
    const float alpha = fexp2(m - mn);
    m = mn;
    float ps = 0.f;
    h16x8 pf0, pf1;
#pragma unroll
    for (int i = 0; i < 8; ++i) {
      const float pa = fexp2(sc[i] - mn), pb = fexp2(sc[8 + i] - mn);
      ps += pa + pb;
      pf0[i] = (h16)pa; pf1[i] = (h16)pb;
    }
    lsum = lsum * alpha + ps;
#pragma unroll
    for (int d = 0; d < 8; ++d) {
      o[d][0] *= alpha; o[d][1] *= alpha; o[d][2] *= alpha; o[d][3] *= alpha;
      const h16* vp0 = sV0 + (d * 16 + q_) * NA_VS + g * 4;
      const h16* vp1 = sV1 + (d * 16 + q_) * NA_VS + g * 4;
      const h16x4 lo0 = *(const h16x4*)vp0, hi0 = *(const h16x4*)(vp0 + 16);
      const h16x4 lo1 = *(const h16x4*)vp1, hi1 = *(const h16x4*)(vp1 + 16);
      h16x8 vf0, vf1;
      vf0[0] = lo0[0]; vf0[1] = lo0[1]; vf0[2] = lo0[2]; vf0[3] = lo0[3]; vf0[4] = hi0[0]; vf0[5] = hi0[1]; vf0[6] = hi0[2]; vf0[7] = hi0[3];
      vf1[0] = lo1[0]; vf1[1] = lo1[1]; vf1[2] = lo1[2]; vf1[3] = lo1[3]; vf1[4] = hi1[0]; vf1[5] = hi1[1]; vf1[6] = hi1[2]; vf1[7] = hi1[3];
      o[d] = mfma16(vf0, pf0, o[d]);
      o[d] = mfma16(vf1, pf1, o[d]);
    }
  };
  auto compute = [&](int t) {
    const h16* sK = smem + (t & 1) * NA_BUF;
    const h16* sV = sK + 128 * NA_KS;
    if (t < nloc) {
      const int kr0 = rs0 + 2 * t, kr1 = kr0 + 1;
      const bool m0 = (kr0 >= rsw) && (kr0 < rsw + 8);
      const bool m1 = (kr1 >= rsw) && (kr1 < rsw + 8);
      if (m0 && m1) iter64(sK + kstart * NA_KS, sV + kstart, sK + (64 + kstart) * NA_KS, sV + 64 + kstart, true, kr0 - rw + 7, kr1 - rw + 7);
      else if (m0) iter32(sK + kstart * NA_KS, sV + kstart, true, kr0 - rw + 7);
      else if (m1) iter32(sK + (64 + kstart) * NA_KS, sV + 64 + kstart, true, kr1 - rw + 7);
    } else {
      iter64(sK, sV, sK + 32 * NA_KS, sV + 32, false, 0, 0);
      iter64(sK + 64 * NA_KS, sV + 64, sK + 96 * NA_KS, sV + 96, false, 0, 0);
    }
  };
  NA_GLOAD(0, A0, A1, A2, A3, A4, A5, A6, A7);
  NA_SSTORE(0, A0, A1, A2, A3, A4, A5, A6, A7);
  NA_GLOAD(1, A0, A1, A2, A3, A4, A5, A6, A7);
  __syncthreads();
  for (int t = 0; t < T; ++t) {
    if (VAR != 1) compute(t);
    if (t + 1 < T && VAR != 2) NA_SSTORE((t + 1) & 1, A0, A1, A2, A3, A4, A5, A6, A7);
    if (t + 2 < T && VAR != 2) NA_GLOAD(t + 2, A0, A1, A2, A3, A4, A5, A6, A7);
    __syncthreads();
  }
  lsum += __shfl_xor(lsum, 16);
  lsum += __shfl_xor(lsum, 32);
  const float rl = 1.0f / lsum;
  h16* op = cat + qrow * 2048 + 512 + hd * 128 + g * 4;
#pragma unroll
  for (int d = 0; d < 8; ++d) store_h4(op + d * 16, o[d][0] * rl, o[d][1] * rl, o[d][2] * rl, o[d][3] * rl);
#undef NA_GLOAD
#undef NA_SSTORE
}

constexpr int MLA_KS = 200;
constexpr int MLA_VS = 72;
constexpr int MLA_BUF = 64 * MLA_KS + 128 * MLA_VS;
template <int VAR>
DEVI void mla_unit(const Params& p, int unit, h16* smem) {
  const h16* q1 = (const h16*)(p.ws + OFF_Q1);
  const h16* kn = (const h16*)(p.ws + OFF_KN);
  const h16* kr = (const h16*)(p.ws + OFF_KR);
  const h16* vT1 = (const h16*)(p.ws + OFF_VT1);
  h16* cat = VAR ? (h16*)p.out : (h16*)(p.ws + OFF_CAT);
  const int tid = tidx(), lane = tid & 63, wid = tid >> 6;
  const int qblk = unit & 15, bh = unit >> 4, hd = bh % 12, b = bh / 12;
  const int q_ = lane & 31, hh = lane >> 5;
  const size_t qrow = (size_t)b * 4096 + qblk * 256 + wid * 32 + q_;
  const h16* qp = q1 + qrow * 2304 + hd * 192 + hh * 8;
  h16x8 qf[12];
#pragma unroll
  for (int s = 0; s < 12; ++s) qf[s] = *(const h16x8*)(qp + s * 16);
  const int skey = tid >> 3, sc0 = tid & 7;
  const h16* gk = kn + ((size_t)b * 4352 + skey) * 1536 + hd * 128 + sc0 * 8;
  const h16* gr = kr + ((size_t)b * 4352 + skey) * 64 + sc0 * 8;
  const h16* gv = vT1 + ((size_t)(b * 12 + hd) * 128 + skey) * 4352 + sc0 * 8;
  uint4 rk0, rk1, rk2, rv0, rv1;
#define MLA_GLOAD(KT)                                             \
  {                                                               \
    const size_t key0 = (size_t)(KT) * 64;                        \
    rk0 = *(const uint4*)(gk + key0 * 1536);                      \
    rk1 = *(const uint4*)(gk + key0 * 1536 + 64);                 \
    rk2 = *(const uint4*)(gr + key0 * 64);                        \
    rv0 = *(const uint4*)(gv + key0);                             \
    rv1 = *(const uint4*)(gv + (size_t)64 * 4352 + key0);         \
  }
#define MLA_SSTORE(BUF)                                           \
  {                                                               \
    h16* bk = smem + (BUF) * MLA_BUF;                             \
    h16* bv = bk + 64 * MLA_KS;                                   \
    *(uint4*)(bk + skey * MLA_KS + sc0 * 8) = rk0;                \
    *(uint4*)(bk + skey * MLA_KS + 64 + sc0 * 8) = rk1;           \
    *(uint4*)(bk + skey * MLA_KS + 128 + sc0 * 8) = rk2;          \
    h16* d0 = bv + skey * MLA_VS + (sc0 >> 1) * 16 + (sc0 & 1) * 4;  \
    *(uint2*)d0 = make_uint2(rv0.x, rv0.y);                       \
    *(uint2*)(d0 + 8) = make_uint2(rv0.z, rv0.w);                 \
    h16* d1 = d0 + 64 * MLA_VS;                                   \
    *(uint2*)d1 = make_uint2(rv1.x, rv1.y);                       \
    *(uint2*)(d1 + 8) = make_uint2(rv1.z, rv1.w);                 \
  }
  f32x16 o[4];
#pragma unroll
  for (int d = 0; d < 4; ++d)
#pragma unroll
    for (int i = 0; i < 16; ++i) o[d][i] = 0.f;
  float m = -1e30f, lsum = 0.f;
  f32x16 sc, sn;
#define MLA_SUBSTEP(HAVE_NEXT, KNEXT, VCUR)                                                       \
  {                                                                                               \
    _Pragma("unroll") for (int i = 0; i < 16; ++i) sn[i] = 0.f;                                   \
    if (HAVE_NEXT) {                                                                              \
      const h16* kp = (KNEXT) + q_ * MLA_KS + hh * 8;                                             \
      _Pragma("unroll") for (int st = 0; st < 12; ++st) sn = mfma32(*(const h16x8*)(kp + st * 16), qf[st], sn); \
    }                                                                                             \
    float mx = sc[0];                                                                             \
    _Pragma("unroll") for (int i = 1; i < 16; ++i) mx = fmaxf(mx, sc[i]);                         \
    mx = fmaxf(mx, __shfl_xor(mx, 32));                                                           \
    const float mn = (mx > m + 8.0f) ? mx : m;     \
    const float alpha = fexp2(m - mn);                                                            \
    m = mn;                                                                                       \
    float ps = 0.f;                                                                               \
    h16x8 pf0, pf1;                                                                               \
    _Pragma("unroll") for (int i = 0; i < 8; ++i) {                                               \
      const float pa = (VAR == 2) ? (sc[i] - mn) : fexp2(sc[i] - mn), pb = (VAR == 2) ? (sc[8 + i] - mn) : fexp2(sc[8 + i] - mn); \
      ps += pa + pb;                                                                              \
      pf0[i] = (h16)pa; pf1[i] = (h16)pb;                                                         \
    }                                                                                             \
    lsum = lsum * alpha + ps;                                                                     \
    __builtin_amdgcn_sched_group_barrier(0x100, 4, 0);                                            \
    _Pragma("unroll") for (int i = 0; i < 12; ++i) {                                              \
      __builtin_amdgcn_sched_group_barrier(0x008, 1, 0);                                          \
      __builtin_amdgcn_sched_group_barrier(0x002, 7, 0);                                          \
      __builtin_amdgcn_sched_group_barrier(0x100, 1, 0);                                          \
    }                                                                                             \
    if (__builtin_amdgcn_ballot_w64(alpha != 1.0f) != 0) {                                        \
      _Pragma("unroll") for (int d = 0; d < 4; ++d)                                               \
        _Pragma("unroll") for (int i = 0; i < 16; ++i) o[d][i] *= alpha;                          \
    }                                                                                             \
    _Pragma("unroll") for (int s2 = 0; s2 < 2; ++s2) {                                            \
      _Pragma("unroll") for (int d = 0; d < 4; ++d) {                                             \
        const h16x8 vf = *(const h16x8*)((VCUR) + (d * 32 + q_) * MLA_VS + s2 * 16 + hh * 8);     \
        if (VAR != 3) o[d] = mfma32(vf, s2 ? pf1 : pf0, o[d]); else o[d][0] += (float)vf[0] * (float)pf0[0]; \
      }                                                                                           \
    }                                                                                             \
    sc = sn;                                                                                      \
  }
  constexpr int NT = 4352 / 64;
  MLA_GLOAD(0);
  MLA_SSTORE(0);
  MLA_GLOAD(1);
  MLA_SSTORE(1);
  __syncthreads();
  {
#pragma unroll
    for (int i = 0; i < 16; ++i) sc[i] = 0.f;
    const h16* kp = smem + q_ * MLA_KS + hh * 8;
#pragma unroll
    for (int st = 0; st < 12; ++st) sc = mfma32(*(const h16x8*)(kp + st * 16), qf[st], sc);
  }
  int bc = 0;
  for (int kt = 0; kt < NT; ++kt) {
    const int bn = (bc == 2) ? 0 : bc + 1;
    const int bw = (bn == 2) ? 0 : bn + 1;
    const bool pre = kt + 2 < NT;
    if (pre && VAR != 1) MLA_GLOAD(kt + 2);
    const h16* sK = smem + bc * MLA_BUF;
    const h16* sV = sK + 64 * MLA_KS;
    const h16* sKn = smem + bn * MLA_BUF;
    MLA_SUBSTEP(true, sK + 32 * MLA_KS, sV);
    MLA_SUBSTEP(kt + 1 < NT, sKn, sV + 32);
    if (pre && VAR != 1) MLA_SSTORE(bw);
    __syncthreads();
    bc = bn;
  }
  lsum += __shfl_xor(lsum, 32);
  const float rl = 1.0f / lsum;
  h16* op = cat + qrow * 2048 + 512 + hd * 128 + hh * 4;
#pragma unroll
  for (int d = 0; d < 4; ++d)
#pragma unroll
    for (int i4 = 0; i4 < 4; ++i4)
      store_h4(op + d * 32 + i4 * 8, o[d][i4 * 4 + 0] * rl, o[d][i4 * 4 + 1] * rl, o[d][i4 * 4 + 2] * rl, o[d][i4 * 4 + 3] * rl);
#undef MLA_GLOAD
#undef MLA_SSTORE
#undef MLA_SUBSTEP
}

DEVI void l1_prep_phase(const Params& p) {
  const h16* p1 = (const h16*)(p.ws + OFF_P1);
  h16* cqn = (h16*)(p.ws + OFF_CQN);
  h16* ckvn = (h16*)(p.ws + OFF_CKVN);
  h16* kr = (h16*)(p.ws + OFF_KR);
  h16* cat = (h16*)(p.ws + OFF_CAT);
  const int tid_ = tidx(); const int lane = tid_ & 63, wid = tid_ >> 6;
  for (int row = blockIdx.x * 8 + wid; row < TA; row += gridDim.x * 8) {
    const h16* pr = p1 + (size_t)row * 2048;
    const bool lat = row < TL;
    {
      const h16x8 v = *(const h16x8*)(pr + 1280 + lane * 8);
      float f[8], ss = 0.f;
#pragma unroll
      for (int e = 0; e < 8; ++e) { f[e] = (float)v[e]; ss += f[e] * f[e]; }
      ss = wave_sum(ss);
      const float rstd = rsqrtf(ss * (1.0f / 512.0f) + 1e-6f);
      h16x8 o;
#pragma unroll
      for (int e = 0; e < 8; ++e) o[e] = (h16)(f[e] * rstd * p.mla_gkv[lane * 8 + e]);
      *(h16x8*)(ckvn + (size_t)row * 512 + lane * 8) = o;
    }
    {
      const float xv = (float)pr[1792 + lane];
      const float xo = __shfl_xor(xv, 16);
      float outv = xv;
      int b, key;
      if (lat) {
        const int t = row & 4095;
        b = row >> 12; key = 256 + t;
        const int fi = lane & 15;
        const int pos = (lane < 32) ? (t >> 6) : (t & 63);
        const float inv = fexp2(-(float)fi * (13.287712379549449f / 16.0f));
        const float rev = (float)pos * inv * 0.15915494309189535f;
        const float cs = cos_rev(rev), sn = sin_rev(rev);
        outv = (lane & 16) ? (xo * sn + xv * cs) : (xv * cs - xo * sn);
      } else {
        b = (row - TL) >> 8; key = (row - TL) & 255;
      }
      kr[((size_t)b * 4352 + key) * 64 + lane] = (h16)outv;
    }
    if (lat) {
      {
        float f[12], ss = 0.f;
#pragma unroll
        for (int i = 0; i < 3; ++i) {
          const h16x4 v = *(const h16x4*)(pr + 512 + (i * 64 + lane) * 4);
#pragma unroll
          for (int e = 0; e < 4; ++e) { f[i * 4 + e] = (float)v[e]; ss += f[i * 4 + e] * f[i * 4 + e]; }
        }
        ss = wave_sum(ss);
        const float rstd = rsqrtf(ss * (1.0f / 768.0f) + 1e-6f);
#pragma unroll
        for (int i = 0; i < 3; ++i) {
          const int col = (i * 64 + lane) * 4;
          store_h4(cqn + (size_t)row * 768 + col, f[i * 4 + 0] * rstd * p.mla_gq[col + 0], f[i * 4 + 1] * rstd * p.mla_gq[col + 1],
                   f[i * 4 + 2] * rstd * p.mla_gq[col + 2], f[i * 4 + 3] * rstd * p.mla_gq[col + 3]);
        }
      }
      {
        const int t = row & 4095;
        const int grp = lane >> 4;
        const int hw = 1 << grp;
        const int lo = max(t - hw, 0), hi = min(t + hw, 4096);
        float acc[8];
#pragma unroll
        for (int e = 0; e < 8; ++e) acc[e] = 0.f;
        const h16* base = p1 + (size_t)(row - t) * 2048 + lane * 8;
        for (int tt = lo; tt < hi; ++tt) {
          const h16x8 v = *(const h16x8*)(base + (size_t)tt * 2048);
#pragma unroll
          for (int e = 0; e < 8; ++e) acc[e] += (float)v[e];
        }
        const h16x8 self = *(const h16x8*)(pr + lane * 8);
        const float rc = 1.0f / (float)(hi - lo);
        h16x8 o;
#pragma unroll
        for (int e = 0; e < 8; ++e) o[e] = (h16)(acc[e] * rc - (float)self[e]);
        *(h16x8*)(cat + (size_t)row * 2048 + lane * 8) = o;
      }
    }
  }
}

#define XB_TMO      128
#define XB_XCNT(j)  (256  + 64 * (j))
#define XB_XSUB(j)  (1280 + 64 * (j))
#define XB_XGEN(j)  (2304 + 64 * (j))
#define XB_TOP      3328
#define XB_TOPGEN   3392
#define XCD_BAR_WORDS 3456
#define XB_SPIN_CAP (1u << 20)
DEVI unsigned xb_ld(unsigned* p) { return __hip_atomic_load(p, __ATOMIC_RELAXED, __HIP_MEMORY_SCOPE_AGENT); }
DEVI unsigned xb_add(unsigned* p, unsigned v) { return __hip_atomic_fetch_add(p, v, __ATOMIC_RELAXED, __HIP_MEMORY_SCOPE_AGENT); }
DEVI unsigned xb_xcc_id() { return (unsigned)__builtin_amdgcn_s_getreg((3 << 11) | 20) & 0xFu; }
#define XB_SPIN(cond, bar) do { unsigned _sp = 0; while (cond) { __builtin_amdgcn_s_sleep(0); \
    if ((++_sp & 255u) == 0u) { if (xb_ld(&(bar)[XB_TMO])) break; if (_sp > XB_SPIN_CAP) { atomicAdd(&(bar)[XB_TMO], 1u); break; } } } } while (0)
struct XcdBarrier { unsigned* bar; unsigned x; volatile __attribute__((address_space(3))) unsigned* st; };
DEVI XcdBarrier xcd_barrier_post(unsigned* bar, volatile __attribute__((address_space(3))) unsigned* st) {
  XcdBarrier b; b.bar = bar; b.x = xb_xcc_id(); b.st = st;
  if (threadIdx.x == 0) (void)xb_add(&bar[XB_XCNT(b.x)], 1u);
  return b;
}
DEVI void xcd_barrier_complete(unsigned* bar, unsigned x, unsigned& nloc, unsigned& nx) {
  const unsigned G = gridDim.x * gridDim.y * gridDim.z;
  unsigned sum, cnt, mine, sp = 0u;
  for (;;) {
    sum = 0u; cnt = 0u; mine = 0u;
#pragma unroll
    for (unsigned j = 0; j < 16; ++j) { const unsigned c = xb_ld(&bar[XB_XCNT(j)]); sum += c; cnt += (c > 0u) ? 1u : 0u; mine = (j == x) ? c : mine; }
    if (sum == G) break;
    __builtin_amdgcn_s_sleep(1);
    if ((++sp & 255u) == 0u) { if (xb_ld(&bar[XB_TMO])) break; if (sp > XB_SPIN_CAP) { atomicAdd(&bar[XB_TMO], 1u); break; } }
  }
  nloc = mine > 0u ? mine : 1u; nx = cnt > 0u ? cnt : 1u;
}
DEVI void xcd_barrier(const XcdBarrier& b) {
  asm volatile("s_waitcnt vmcnt(0)" ::: "memory");
  __syncthreads();
  if (threadIdx.x == 0) {
    unsigned* bar = b.bar;
    __builtin_amdgcn_s_waitcnt(0);
    unsigned nloc = b.st[0], nx = b.st[1];
    if (nloc == 0u) { xcd_barrier_complete(bar, b.x, nloc, nx); b.st[0] = nloc; b.st[1] = nx; }
    const unsigned old = xb_add(&bar[XB_XSUB(b.x)], 1u);
    const unsigned gen = old / nloc;
    if (old + 1u == (gen + 1u) * nloc) {
      __builtin_amdgcn_fence(__ATOMIC_RELEASE, "agent");
      asm volatile("s_waitcnt vmcnt(0)" ::: "memory");
      const unsigned og = xb_add(&bar[XB_TOP], 1u);
      const unsigned tg = og / nx;
      if (og + 1u == (tg + 1u) * nx) xb_add(&bar[XB_TOPGEN], 1u);
      else XB_SPIN(xb_ld(&bar[XB_TOPGEN]) == tg, bar);
      __builtin_amdgcn_fence(__ATOMIC_ACQUIRE, "agent");
      xb_add(&bar[XB_XGEN(b.x)], 1u);
      asm volatile("s_waitcnt vmcnt(0)" ::: "memory");
    } else {
      XB_SPIN(xb_ld(&bar[XB_XGEN(b.x)]) == gen, bar);
      __builtin_amdgcn_fence(__ATOMIC_ACQUIRE, "agent");
      asm volatile("s_waitcnt vmcnt(0)" ::: "memory");
    }
  }
  __syncthreads();
}

DEVI void run_phase(const Params& pin, int ph, h16* smem, bool dummy = false) {
  Params p = pin;
  asm volatile("" : "+s"(p.ws));
  char* ws = p.ws;
  float* mod = (float*)(ws + OFF_MOD);
  h16* xres = (h16*)(ws + OFF_XRES);
  h16* xout = xres;
  h16* hbuf = (h16*)(ws + OFF_H);
  h16* cat = (h16*)(ws + OFF_CAT);
  h16* act = (h16*)(ws + OFF_BIG);
  switch (ph) {
    case 0: phase0(p, (float*)smem); break;
    case 1: norm_mod_phase(p.x, p.ctx, TA, p.norm1_g, mod, 0, 1, hbuf); break;
    case 2: {
      EpiG1 e{(h16*)(ws + OFF_Q0), (h16*)(ws + OFF_K0), (h16*)(ws + OFF_VT0), (h16*)(ws + OFF_VCT0), (h16*)(ws + OFF_UCT), (h16*)(ws + OFF_UCTC)};
      run_gemm(smem, hbuf, (const h16*)(ws + OFF_WT_IN_AB), TA, 5632, 2048, e);
    } break;
    case 3: {
#ifdef DFT_PROBE
      const bool do_dft = true, do_na = !dummy;
#else
      const bool do_dft = !dummy, do_na = true;
#endif
      if (do_dft) {
        EpiDft e{cat, 0.0013810679320049757f, 0, 1};
        run_gemm(smem, (const h16*)(ws + OFF_DFTA), (const h16*)(ws + OFF_UCT), 2304, 2048, 8192, e);
      }
      if (do_dft) {
        EpiDft e{cat, 0.005524271728019903f, 1, 0};
        run_gemm(smem, (const h16*)(ws + OFF_DFTAC), (const h16*)(ws + OFF_UCTC), 256, 2048, 512, e, (int)((lbid() + gridDim.x - (128 % gridDim.x)) % gridDim.x));
      }
      const int xcd = lbid() & 7;
      int* ctr = (int*)(ws + OFF_CTR) + xcd * 8;
      int* su = (int*)smem;
      const int tid = tidx();
      for (; do_na;) {
        __syncthreads();
        if (tid == 0) su[0] = atomicAdd(ctr, 1);
        __syncthreads();
        const int u = su[0];
        if (u >= 204) break;
        const int bu = u < 192 ? (xcd * 192 + u) : (1536 + xcd * 12 + (u - 192));
#ifdef NA_PROBE_VAR
        if (dummy) na_block_unit<NA_PROBE_VAR>(p, bu, smem + 64); else
#endif
        na_block_unit<0>(p, bu, smem + 64);
      }
    } break;
    case 4: {
      EpiRes<float> e{p.x, p.ctx, xout, mod + 2 * 2048};
      run_gemm(smem, cat, (const h16*)(ws + OFF_WT_OUT_AB), TA, 2048, 2048, e);
      if (!dummy && gridDim.x == 256 && lbid() >= 32) prep_ffn_gu(p, 0, (float*)smem, lbid() - 32, 224);
      else if (!dummy && gridDim.x != 256) prep_ffn_gu(p, 0, (float*)smem, lbid(), (int)gridDim.x);
    } break;
    case 5: norm_mod_phase(xres, xres + (size_t)TL * 2048, TA, p.norm2_g, mod, 3, 4, hbuf); break;
    case 6: {
      EpiGU e{act};
      run_gemm(smem, hbuf, (const h16*)(ws + OFF_WT_GU0), TA, 11264, 2048, e);
      if (!dummy && gridDim.x == 256 && lbid() >= 176) prep_ffn_dn(p, 0, (float*)smem, lbid() - 176, 80);
      else if (!dummy && gridDim.x != 256) prep_ffn_dn(p, 0, (float*)smem, lbid(), (int)gridDim.x);
    } break;
    case 7: {
      EpiRes<h16> e{xres, xres + (size_t)TL * 2048, xout, mod + 5 * 2048};
      if (gridDim.x == 256) {
        run_gemm(smem, act, (const h16*)(ws + OFF_WT_D0), TL, 2048, DFF, e);
        if (!dummy) {
          const int c = lbid(), sp = c >> 5;
          if (c < 128) {
            EpiPartial ep{(float*)cat + (size_t)sp * TC * 2048};
            run_gemm(smem, act + (size_t)TL * DFF + sp * 1408, (const h16*)(ws + OFF_WT_D0) + sp * 1408, TC, 2048, 1408, ep, c & 31, DFF);
          } else {
            prep_layer1(p, (float*)smem, c - 128, 128, false);
          }
        }
      } else {
        run_gemm(smem, act, (const h16*)(ws + OFF_WT_D0), TA, 2048, DFF, e);
        if (!dummy) prep_layer1(p, (float*)smem, lbid(), (int)gridDim.x, false);
      }
    } break;
    case 8:
      if (gridDim.x == 256) {
        norm_mod_phase(xres, xres + (size_t)TL * 2048, TL, p.norm1_g + 2048, mod + 5 * 12288, 0, 1, hbuf);
        ctx_norm_partial_phase(xres + (size_t)TL * 2048, p.norm1_g + 2048, mod + 5 * 12288, 0, 1, hbuf, (const float*)cat, 4, mod + 4 * 12288 + 5 * 2048);
      } else norm_mod_phase(xres, xres + (size_t)TL * 2048, TA, p.norm1_g + 2048, mod + 5 * 12288, 0, 1, hbuf);
      break;
    case 9: {
      EpiStore e{(h16*)(ws + OFF_P1), 2048};
      run_gemm(smem, hbuf, (const h16*)(ws + OFF_WT_IN_CD), TA, 2048, 2048, e);
      if (!dummy && gridDim.x == 256 && lbid() >= 32) prep_ffn(p, 1, (float*)smem, lbid() - 32, 224);
      else if (!dummy && gridDim.x != 256) prep_ffn(p, 1, (float*)smem, lbid(), (int)gridDim.x);
    } break;
    case 10: l1_prep_phase(p); break;
    case 11: {
      EpiQ1 eq{(h16*)(ws + OFF_Q1)};
      run_gemm(smem, (const h16*)(ws + OFF_CQN), (const h16*)(ws + OFF_WT_UQ), TL, 2304, 768, eq);
      EpiKV1 ek{(h16*)(ws + OFF_KN), (h16*)(ws + OFF_VT1)};
      run_gemm(smem, (const h16*)(ws + OFF_CKVN), (const h16*)(ws + OFF_WT_UKV), TA, 3072, 512, ek, (int)((lbid() + gridDim.x - 64) % gridDim.x));
    } break;
    case 12: {
      if (gridDim.x == 256) {
        const int xcd = lbid() & 7, slot = lbid() >> 3;
        for (int i = 0; i < 3; ++i) mla_unit<0>(p, (xcd * 6 + i * 2 + (slot >> 4)) * 16 + (slot & 15), smem);
      } else {
        for (int u = lbid(); u < 768; u += gridDim.x) mla_unit<0>(p, u, smem);
      }
    } break;
#ifdef MLA_PROBE_VAR
    case 112: {
      const int xcd = lbid() & 7, slot = lbid() >> 3;
      for (int i = 0; i < 3; ++i) mla_unit<MLA_PROBE_VAR>(p, (xcd * 6 + i * 2 + (slot >> 4)) * 16 + (slot & 15), smem);
    } break;
#endif
    case 13: {
      EpiRes<h16> e{xres, xres + (size_t)TL * 2048, xout, mod + 5 * 12288 + 2 * 2048};
      run_gemm(smem, cat, (const h16*)(ws + OFF_WT_OUT_CD), TL, 2048, 2048, e);
    } break;
    case 14: norm_mod_phase(xres, xres + (size_t)TL * 2048, TL, p.norm2_g + 2048, mod + 5 * 12288, 3, 4, hbuf); break;
    case 15: {
      EpiGU e{act};
      run_gemm(smem, hbuf, (const h16*)(ws + OFF_WT_GU1), TL, 11264, 2048, e);
    } break;
    case 16: {
      EpiRes<h16> e{xres, xres + (size_t)TL * 2048, xout, mod + 5 * 12288 + 5 * 2048};
      run_gemm(smem, act, (const h16*)(ws + OFF_WT_D1), TL, 2048, DFF, e);
    } break;
    case 17: final_norm_phase(xres, p.final_g, p.out); break;
    default: break;
  }
}

__global__ void __launch_bounds__(512, 2) mega_kernel(Params p, int ph_lo, int ph_hi) {
  extern __shared__ __attribute__((aligned(16))) unsigned char shm[];
  h16* smem = (h16*)shm;
  unsigned* barw = (unsigned*)(p.ws + OFF_BAR);
  if (threadIdx.x == 0) {
    const unsigned x = xb_xcc_id();
    const unsigned r = xb_add(&barw[XCD_BAR_WORDS + (x & 15u)], 1u);
    g_sh[0] = make_uint4(0u, 0u, 0u, 0u);
    g_sh[1] = make_uint4(blockIdx.x, r, x, 0u);
  }
  __syncthreads();
  const XcdBarrier xb = xcd_barrier_post(barw, (volatile __attribute__((address_space(3))) unsigned*)&g_sh[0]);
#ifdef ONLY_PHASE
  run_phase(p, ONLY_PHASE, smem);
#else
#pragma unroll
  for (int ph = 0; ph < NPHASE; ++ph) {
    if (ph >= ph_lo && ph < ph_hi) {
      run_phase(p, ph, smem);
      if ((REPEAT_MASK >> ph) & 1) {
        xcd_barrier(xb);
        if (ph == 3) { if (blockIdx.x == 0 && threadIdx.x < 8) ((int*)(p.ws + OFF_CTR))[threadIdx.x * 8] = 0; xcd_barrier(xb); }
#ifdef MLA_PROBE_VAR
        run_phase(p, ph == 12 ? 112 : ph, smem, true);
#else
        run_phase(p, ph, smem, true);
#endif
      }
      if (ph + 1 < ph_hi) { if (ph_hi > 1000) cg::this_grid().sync(); else xcd_barrier(xb); }
      if (ph == 0) {
        if (threadIdx.x == 0) {
          bool ok = (gridDim.x == 256);
#pragma unroll
          for (unsigned j = 0; j < 16; ++j) { const unsigned cnt = xb_ld(&barw[XB_XCNT(j)]); ok = ok && (cnt == (j < 8 ? 32u : 0u)); }
          const uint4 me = g_sh[1];
          if (ok && me.z < 8u && me.y < 32u) g_sh[1].x = me.y * 8u + me.z;
        }
        __syncthreads();
      }
    }
  }
#ifdef EXTRA_SYNCS
  for (int i = 0; i < EXTRA_SYNCS; ++i) xcd_barrier(xb);
#endif
#endif
}

extern "C" void kernel_launch(void* const* d_in, const int* in_sizes, int n_in, void* d_out, int out_size, void* d_ws,
                              size_t ws_size, hipStream_t stream) {
  if (ws_size < WS_NEEDED) {
    fprintf(stderr, "workspace too small: have %zu need %zu\n", ws_size, (size_t)WS_NEEDED);
    return;
  }
  static int grid_blocks = 0;
  if (!grid_blocks) {
    int dev = 0, cus = 0, per_cu = 0;
    (void)hipGetDevice(&dev);
    (void)hipDeviceGetAttribute(&cus, hipDeviceAttributeMultiprocessorCount, dev);
    (void)hipFuncSetAttribute((const void*)mega_kernel, hipFuncAttributeMaxDynamicSharedMemorySize, SMEM_BYTES);
    (void)hipOccupancyMaxActiveBlocksPerMultiprocessor(&per_cu, mega_kernel, NTHR, SMEM_BYTES);
    if (per_cu > 1) per_cu = 1;
    grid_blocks = cus * per_cu;
  }
  Params p{};
  const float** pf = (const float**)&p;
  for (int i = 0; i < 24; ++i) pf[i] = (const float*)d_in[i];
  p.out = (float*)d_out;
  p.ws = (char*)d_ws;
  int lo = 0, hi = NPHASE;
  (void)hipMemsetAsync((char*)d_ws + OFF_BAR, 0, BAR_BYTES, stream);
  void* args[] = {&p, &lo, &hi};
  hipError_t e = hipLaunchCooperativeKernel((void*)mega_kernel, dim3(grid_blocks), dim3(NTHR), args, SMEM_BYTES, stream);
  if (e != hipSuccess) fprintf(stderr, "cooperative launch failed: %s (grid %d)\n", hipGetErrorString(e), grid_blocks);
}
```

```cpp
#include <hip/hip_runtime.h>
#include <hip/hip_cooperative_groups.h>
#include <cstdio>
#include <cstdint>
namespace cg = cooperative_groups;

typedef _Float16 h16;
typedef _Float16 h16x8 __attribute__((ext_vector_type(8)));
typedef _Float16 h16x4 __attribute__((ext_vector_type(4)));
typedef float f32x16 __attribute__((ext_vector_type(16)));
typedef float f32x4 __attribute__((ext_vector_type(4)));

#define DEVI __device__ __forceinline__

#ifndef SINGLE_LAUNCH
#define SINGLE_LAUNCH 1
#endif
#ifndef REPEAT_MASK
#define REPEAT_MASK 0x0
#endif

constexpr int DM = 2048;
constexpr int TL = 16384;
constexpr int TC = 1024;
constexpr int TA = 17408;
constexpr int DFF = 5632;
constexpr int NPHASE = 18;

constexpr size_t SZ_WT_IN_AB = (size_t)5632 * 2048 * 2;
constexpr size_t SZ_WT_OUT = (size_t)2048 * 2048 * 2;
constexpr size_t SZ_WT_GU = (size_t)11264 * 2048 * 2;
constexpr size_t SZ_WT_D = (size_t)2048 * 5632 * 2;
constexpr size_t SZ_WT_IN_CD = (size_t)2048 * 2048 * 2;
constexpr size_t SZ_WT_UQ = (size_t)2304 * 768 * 2;
constexpr size_t SZ_WT_UKV = (size_t)3072 * 512 * 2;
constexpr size_t SZ_DFTA = (size_t)4096 * 8192 * 2;
constexpr size_t SZ_DFTAC = (size_t)256 * 512 * 2;
constexpr size_t SZ_MOD = (size_t)2 * 5 * 12288 * 4;
constexpr size_t SZ_XRES = (size_t)TA * 2048 * 4;
constexpr size_t SZ_H = (size_t)TA * 2048 * 2;
constexpr size_t SZ_CAT = (size_t)TA * 2048 * 2;
constexpr size_t SZ_BIG = (size_t)TA * 5632 * 2;

constexpr size_t OFF_WT_IN_AB = 0;
constexpr size_t OFF_WT_OUT_AB = OFF_WT_IN_AB + SZ_WT_IN_AB;
constexpr size_t OFF_WT_GU0 = OFF_WT_OUT_AB + SZ_WT_OUT;
constexpr size_t OFF_WT_GU1 = OFF_WT_GU0 + SZ_WT_GU;
constexpr size_t OFF_WT_D0 = OFF_WT_GU1 + SZ_WT_GU;
constexpr size_t OFF_WT_D1 = OFF_WT_D0 + SZ_WT_D;
constexpr size_t OFF_WT_IN_CD = OFF_WT_D1 + SZ_WT_D;
constexpr size_t OFF_WT_UQ = OFF_WT_IN_CD + SZ_WT_IN_CD;
constexpr size_t OFF_WT_UKV = OFF_WT_UQ + SZ_WT_UQ;
constexpr size_t OFF_WT_OUT_CD = OFF_WT_UKV + SZ_WT_UKV;
constexpr size_t OFF_DFTA = OFF_WT_OUT_CD + SZ_WT_OUT;
constexpr size_t OFF_DFTAC = OFF_DFTA + SZ_DFTA;
constexpr size_t OFF_MOD = OFF_DFTAC + SZ_DFTAC;
constexpr size_t OFF_XRES = OFF_MOD + SZ_MOD;
constexpr size_t OFF_H = OFF_XRES + SZ_XRES;
constexpr size_t OFF_CAT = OFF_H + SZ_H;
constexpr size_t OFF_BIG = OFF_CAT + SZ_CAT;
constexpr size_t OFF_CTR = OFF_BIG + SZ_BIG;
constexpr size_t OFF_BAR = OFF_CTR + 256;
constexpr size_t BAR_BYTES = 16384;
constexpr size_t WS_NEEDED = OFF_BAR + BAR_BYTES;

constexpr size_t OFF_Q0 = OFF_BIG;
constexpr size_t OFF_K0 = OFF_Q0 + (size_t)TA * 1536 * 2;
constexpr size_t OFF_VT0 = OFF_K0 + (size_t)TA * 1536 * 2;
constexpr size_t OFF_VCT0 = OFF_VT0 + (size_t)48 * 128 * 4096 * 2;
constexpr size_t OFF_UCT = OFF_VCT0 + (size_t)48 * 128 * 256 * 2;
constexpr size_t OFF_UCTC = OFF_UCT + (size_t)2048 * 8192 * 2;
static_assert(OFF_UCTC + (size_t)2048 * 512 * 2 <= OFF_BIG + SZ_BIG, "layer0 scratch overflow");
constexpr size_t OFF_P1 = OFF_BIG;
constexpr size_t OFF_CQN = OFF_P1 + (size_t)TA * 2048 * 2;
constexpr size_t OFF_CKVN = OFF_CQN + (size_t)TL * 768 * 2;
constexpr size_t OFF_KR = OFF_CKVN + (size_t)TA * 512 * 2;
constexpr size_t OFF_Q1 = OFF_KR + (size_t)4 * 4352 * 64 * 2;
static_assert(OFF_Q1 + (size_t)TL * 2304 * 2 <= OFF_BIG + SZ_BIG, "layer1 scratch overflow");
constexpr size_t OFF_KN = OFF_H;
constexpr size_t OFF_VT1 = OFF_DFTA;
static_assert((size_t)4 * 4352 * 1536 * 2 <= SZ_H, "kn alias");
static_assert((size_t)48 * 128 * 4352 * 2 <= SZ_DFTA, "vt1 alias");

struct Params {
  const float *x, *c, *ctx, *c_ctx, *w_mod, *b_mod, *norm1_g, *norm2_g, *w_in_ab, *w_four, *na_rpb, *w_out_ab;
  const float *w_in_cd, *w_pool, *pool_scale, *mla_gq, *mla_gkv, *w_uq, *w_ukv, *w_out_cd;
  const float *w_ffn_gate, *w_ffn_up, *w_ffn_down, *final_g;
  float* out;
  char* ws;
};

constexpr int NTHR = 512;
constexpr int SMEM_BYTES = 147456;

__shared__ uint4 g_sh[2];
__device__ __forceinline__ int lbid() { return (int)g_sh[1].x; }
DEVI f32x16 mfma32(h16x8 a, h16x8 b, f32x16 c) { return __builtin_amdgcn_mfma_f32_32x32x16_f16(a, b, c, 0, 0, 0); }
DEVI f32x4 mfma16(h16x8 a, h16x8 b, f32x4 c) { return __builtin_amdgcn_mfma_f32_16x16x32_f16(a, b, c, 0, 0, 0); }
DEVI int tidx() { int t = threadIdx.x; asm volatile("" : "+v"(t)); return t; }
DEVI float wave_sum(float v) {
#pragma unroll
  for (int o = 32; o >= 1; o >>= 1) v += __shfl_xor(v, o);
  return v;
}
DEVI float fexp2(float x) { return __builtin_amdgcn_exp2f(x); }
DEVI float cos_rev(float r) { return __builtin_amdgcn_cosf(r); }
DEVI float sin_rev(float r) { return __builtin_amdgcn_sinf(r); }
DEVI float silu_f(float v) { return v * __builtin_amdgcn_rcpf(1.0f + __builtin_amdgcn_exp2f(-1.4426950408889634f * v)); }
DEVI float4 ld4f(const float* p) { return *(const float4*)p; }
DEVI float4 ldnt4(const float* p) { const f32x4 v = __builtin_nontemporal_load((const f32x4*)p); return make_float4(v[0], v[1], v[2], v[3]); }
DEVI void stnt4(float* p, const float4& v) { f32x4 t; t[0] = v.x; t[1] = v.y; t[2] = v.z; t[3] = v.w; __builtin_nontemporal_store(t, (f32x4*)p); }
DEVI float4 ld4f(const h16* p) { const h16x4 v = *(const h16x4*)p; return make_float4((float)v[0], (float)v[1], (float)v[2], (float)v[3]); }
DEVI void store_h8(h16* dst, const f32x4& a, const f32x4& b, float sc = 1.0f) {
  h16x8 v;
#pragma unroll
  for (int j = 0; j < 4; ++j) { v[j] = (h16)(a[j] * sc); v[4 + j] = (h16)(b[j] * sc); }
  *(h16x8*)dst = v;
}
DEVI void store_h4(h16* dst, float a, float b, float c, float d) {
  h16x4 v;
  v[0] = (h16)a; v[1] = (h16)b; v[2] = (h16)c; v[3] = (h16)d;
  *(h16x4*)dst = v;
}

#define LAS __attribute__((address_space(3)))
namespace g8 {
constexpr int BM = 256, BK = 64, HALF = 128, HTB = HALF * BK * 2, NXCD = 8, WGM = 8;
DEVI int lds_byte(int r, int c) { const int st = (r >> 4) * 2 + (c >> 5), rr = r & 15, cc = c & 31, ob = rr * 64 + cc * 2; return st * 1024 + (ob ^ (((ob >> 9) & 1) << 5)); }
DEVI void stage_rc(int b, int& R, int& C) { const int st = b / 1024, sb = b % 1024, swz = sb ^ (((sb >> 9) & 1) << 5); R = (st >> 1) * 16 + swz / 64; C = (st & 1) * 32 + (swz % 64) / 2; }
DEVI int perm32(int rho) { const int n = rho >> 4, i = rho & 15; return 8 * (i >> 2) + 4 * n + (i & 3); }
struct Unit { int pm, pn; };
struct Gemm { const h16* A; const h16* Bt; int M, N, K, ld; };
struct StaticOrder {
  int nM, nN, nwg, G, c;
  DEVI void init(int M, int N, int G_, int c_) { nM = M / BM; nN = N / BM; nwg = nM * nN; G = G_; c = c_; }
  DEVI bool next(int i, Unit& u) const {
    if (c < 0) return false;
    const long L = (long)i * G + c; if (L >= nwg) return false;
    int wgid = (int)L; { const int q = nwg / NXCD, r = nwg % NXCD, xcd = wgid % NXCD, off = wgid / NXCD; wgid = (xcd < r ? xcd * (q + 1) : r * (q + 1) + (xcd - r) * q) + off; }
    const int nig = WGM * nN, gid = wgid / nig, fm = gid * WGM, gsz = (nM - fm) < WGM ? (nM - fm) : WGM;
    u.pm = fm + ((wgid % nig) % gsz); u.pn = (wgid % nig) / gsz; return true;
  }
};

template <class Epi>
DEVI void gemm_phase(LAS unsigned char* lds, const Gemm g, const StaticOrder& S, const Epi& E) {
  const int tid = tidx(), wid = __builtin_amdgcn_readfirstlane(tid >> 6), lane = tid & 63, wr = wid >> 2, wc = wid & 3, fr = lane & 15, fq = lane >> 4;
  const int K = g.K, nt = K / BK;
  unsigned voffA[2], voffB[2];
#pragma unroll
  for (int i = 0; i < 2; ++i) { int R, C; stage_rc(tid * 16 + i * 8192, R, C); const int Rb = Epi::PERM ? ((R & ~31) + perm32(R & 31)) : R;
    voffA[i] = (unsigned)(R * g.ld + C) * 2u; voffB[i] = (unsigned)(Rb * g.ld + C) * 2u; }
  const size_t kstep = (size_t)(BK * 2);
  const size_t hstep = (size_t)HALF * g.ld * 2;
  const size_t tstep = 2 * hstep;
  const unsigned ldsw = (unsigned)wid * 1024u;
  const int aoff = lds_byte(wr * 64 + fr, fq * 8), boff = lds_byte(wc * 32 + fr, fq * 8);
#define G8_SA(b, h) (((b) * 2 + (h)) * HTB)
#define G8_SB(b, h) ((4 + (b) * 2 + (h)) * HTB)
#define G8_STAGE(bufoff, gbase, voff) do { _Pragma("unroll") for (int _i = 0; _i < 2; ++_i) \
    __builtin_amdgcn_global_load_lds((const unsigned*)((const char*)(gbase) + (voff)[_i]), (LAS unsigned*)(lds + (bufoff) + ldsw + _i * 8192), 16, 0, 0); } while (0)
#define G8_LDA(dst, b, h) do { _Pragma("unroll") for (int m = 0; m < 4; ++m) _Pragma("unroll") for (int k = 0; k < 2; ++k) dst[m][k] = *(const LAS h16x8*)(lds + G8_SA(b, h) + aoff + m * 2048 + k * 1024); } while (0)
#define G8_LDB(dst, b, h) do { _Pragma("unroll") for (int n = 0; n < 2; ++n) _Pragma("unroll") for (int k = 0; k < 2; ++k) dst[n][k] = *(const LAS h16x8*)(lds + G8_SB(b, h) + boff + n * 2048 + k * 1024); } while (0)
#define G8_MMA(ai, bj, At, Bt) do { __builtin_amdgcn_s_setprio(1); _Pragma("unroll") for (int m = 0; m < 4; ++m) _Pragma("unroll") for (int n = 0; n < 2; ++n) _Pragma("unroll") for (int k = 0; k < 2; ++k) \
    acc[ai][bj][m][n] = __builtin_amdgcn_mfma_f32_16x16x32_f16(Bt[n][k], At[m][k], acc[ai][bj][m][n], 0, 0, 0); __builtin_amdgcn_s_setprio(0); } while (0)
#define G8_WAIT_V(n) asm volatile("s_waitcnt vmcnt(" #n ")" ::: "memory")
#define G8_WAIT_L(n) asm volatile("s_waitcnt lgkmcnt(" #n ")" ::: "memory")
#define G8_BAR __builtin_amdgcn_s_barrier()
#define G8_SCHED __builtin_amdgcn_sched_barrier(0)
  Unit cur, nxt; int ui = 0;
  if (!S.next(0, cur)) return;
  f32x4 acc[2][2][4][2];
#pragma unroll
  for (int a = 0; a < 2; ++a)
#pragma unroll
    for (int b = 0; b < 2; ++b)
#pragma unroll
      for (int m = 0; m < 4; ++m)
#pragma unroll
        for (int n = 0; n < 2; ++n) acc[a][b][m][n] = (f32x4){0.f, 0.f, 0.f, 0.f};
  h16x8 At[4][2], B0[2][2], B1[2][2];
  const char* cA = (const char*)g.A + (size_t)cur.pm * tstep; const char* cB = (const char*)g.Bt + (size_t)cur.pn * tstep;
  G8_STAGE(G8_SB(0, 0), cB, voffB); G8_STAGE(G8_SA(0, 0), cA, voffA); G8_STAGE(G8_SB(0, 1), cB + hstep, voffB); G8_STAGE(G8_SA(0, 1), cA + hstep, voffA);
  if (wr == 1) G8_BAR;
  G8_WAIT_V(4); G8_BAR;
  G8_STAGE(G8_SB(1, 0), cB + kstep, voffB); G8_STAGE(G8_SA(1, 0), cA + kstep, voffA); G8_STAGE(G8_SB(1, 1), cB + hstep + kstep, voffB);
  G8_WAIT_V(6); G8_BAR;
  for (;;) {
    const bool has_next = S.next(ui + 1, nxt);
    const char* nA = has_next ? (const char*)g.A + (size_t)nxt.pm * tstep : cA; const char* nB = has_next ? (const char*)g.Bt + (size_t)nxt.pn * tstep : cB;
    for (int t = 0; t < nt; t += 2) {
      const bool last = (t == nt - 2);
      const char* a1 = cA + (size_t)(t + 1) * kstep;
      const char* a2 = last ? nA : cA + (size_t)(t + 2) * kstep; const char* b2 = last ? nB : cB + (size_t)(t + 2) * kstep;
      const char* a3 = a2 + kstep; const char* b3 = b2 + kstep;
      G8_LDB(B0, 0, 0); G8_SCHED; G8_LDA(At, 0, 0); G8_STAGE(G8_SA(1, 1), a1 + hstep, voffA);
      G8_WAIT_L(8); G8_BAR; G8_WAIT_L(0); G8_MMA(0, 0, At, B0); G8_BAR; G8_SCHED;
      G8_LDB(B1, 0, 1); G8_STAGE(G8_SB(0, 0), b2, voffB);
      G8_BAR; G8_WAIT_L(0); G8_MMA(0, 1, At, B1); G8_BAR;
      G8_LDA(At, 0, 1); G8_STAGE(G8_SA(0, 0), a2, voffA);
      G8_BAR; G8_WAIT_L(0); G8_MMA(1, 0, At, B0); G8_BAR; G8_SCHED;
      G8_STAGE(G8_SB(0, 1), b2 + hstep, voffB);
      G8_WAIT_V(6); G8_BAR; G8_MMA(1, 1, At, B1); G8_BAR;
      G8_LDB(B0, 1, 0); G8_SCHED; G8_LDA(At, 1, 0); G8_STAGE(G8_SA(0, 1), a2 + hstep, voffA);
      G8_WAIT_L(8); G8_BAR; G8_WAIT_L(0); G8_MMA(0, 0, At, B0); G8_BAR; G8_SCHED;
      G8_LDB(B1, 1, 1); G8_STAGE(G8_SB(1, 0), b3, voffB);
      G8_BAR; G8_WAIT_L(0); G8_MMA(0, 1, At, B1); G8_BAR;
      G8_LDA(At, 1, 1); G8_STAGE(G8_SA(1, 0), a3, voffA);
      G8_BAR; G8_WAIT_L(0); G8_MMA(1, 0, At, B0); G8_BAR; G8_SCHED;
      G8_STAGE(G8_SB(1, 1), b3 + hstep, voffB);
      G8_WAIT_V(6); G8_BAR; G8_MMA(1, 1, At, B1); G8_BAR;
    }
    E(acc, cur, wr, wc, fr, fq);
    if (!has_next) break;
#pragma unroll
    for (int a = 0; a < 2; ++a)
#pragma unroll
      for (int b = 0; b < 2; ++b)
#pragma unroll
        for (int m = 0; m < 4; ++m)
#pragma unroll
          for (int n = 0; n < 2; ++n) acc[a][b][m][n] = (f32x4){0.f, 0.f, 0.f, 0.f};
    cur = nxt; cA = nA; cB = nB; ++ui;
  }
  G8_WAIT_V(0);
  if (wr == 0) G8_BAR;
  G8_BAR;
#undef G8_SA
#undef G8_SB
#undef G8_STAGE
#undef G8_LDA
#undef G8_LDB
#undef G8_MMA
}
}
using g8::Unit;

template <class Epi>
DEVI void run_gemm(h16* smem, const h16* A, const h16* Bt, int M, int N, int K, const Epi& e, int c_override = -2, int ld = 0) {
  g8::Gemm g{A, Bt, M, N, K, ld ? ld : K};
  g8::StaticOrder S;
  S.init(M, N, (int)gridDim.x, c_override == -2 ? lbid() : c_override);
  g8::gemm_phase((LAS unsigned char*)smem, g, S, e);
}

#define E8_FOR                                      \
  _Pragma("unroll") for (int ai = 0; ai < 2; ++ai)   \
  _Pragma("unroll") for (int m = 0; m < 4; ++m)      \
  _Pragma("unroll") for (int bj = 0; bj < 2; ++bj)   \
  _Pragma("unroll") for (int n = 0; n < 2; ++n)
#define E8_ROW (u.pm * 256 + ai * 128 + wr * 64 + m * 16 + fr)
#define E8_COL (u.pn * 256 + bj * 128 + wc * 32 + n * 16 + fq * 4)
#define E8_COLP (u.pn * 256 + bj * 128 + wc * 32 + fq * 8 + n * 4)
typedef const f32x4 (&AccRef)[2][2][4][2];

#define E8P_FOR                                     \
  _Pragma("unroll") for (int ai = 0; ai < 2; ++ai)   \
  _Pragma("unroll") for (int m = 0; m < 4; ++m)      \
  _Pragma("unroll") for (int bj = 0; bj < 2; ++bj)
#define E8P_COL (u.pn * 256 + bj * 128 + wc * 32 + fq * 8)
struct EpiG1 {
  static constexpr bool PERM = true, AFTER_DRAIN = false;
  h16 *q0, *k0, *vT, *vcT, *ucT, *ucTc;
  DEVI void operator()(AccRef acc, const Unit& u, int wr, int wc, int fr, int fq) const {
    const bool isctx = u.pm >= 64;
    E8P_FOR {
      const int row = E8_ROW, col = E8P_COL;
      const f32x4 va = acc[ai][bj][m][0], vb = acc[ai][bj][m][1];
      int b, n_;
      if (!isctx) { b = row >> 12; n_ = row & 4095; } else { b = (row - TL) >> 8; n_ = (row - TL) & 255; }
      if (u.pn < 4) {
        const int g = u.pn, part = bj, mm = col & 127;
        const size_t ld = isctx ? 512 : 8192;
        h16* d = isctx ? ucTc + (size_t)((b * 4 + g) * 128 + mm) * 512 + part * 256 + n_
                       : ucT + (size_t)((b * 4 + g) * 128 + mm) * 8192 + part * 4096 + n_;
#pragma unroll
        for (int j = 0; j < 4; ++j) { d[j * ld] = (h16)va[j]; d[(4 + j) * ld] = (h16)vb[j]; }
      } else if (u.pn < 10) {
        store_h8(q0 + (size_t)row * 1536 + (col - 1024), va, vb);
      } else if (u.pn < 16) {
        store_h8(k0 + (size_t)row * 1536 + (col - 2560), va, vb);
      } else {
        const int c3 = col - 4096, hh = c3 >> 7, dv = c3 & 127;
        const size_t ld = isctx ? 256 : 4096;
        h16* d = isctx ? vcT + (size_t)((b * 12 + hh) * 128 + dv) * 256 + n_
                       : vT + (size_t)((b * 12 + hh) * 128 + dv) * 4096 + n_;
#pragma unroll
        for (int j = 0; j < 4; ++j) { d[j * ld] = (h16)va[j]; d[(4 + j) * ld] = (h16)vb[j]; }
      }
    }
  }
};

struct EpiDft {
  static constexpr bool PERM = true, AFTER_DRAIN = false;
  h16* cat; float scale; int is_ctx; int mirror;
  DEVI void operator()(AccRef acc, const Unit& u, int wr, int wc, int fr, int fq) const {
    E8P_FOR {
      const int row = E8_ROW, col = E8P_COL;
      const f32x4 va = acc[ai][bj][m][0], vb = acc[ai][bj][m][1];
      const int b = col >> 9, g = (col >> 7) & 3, mm = col & 127;
      const size_t rbase = is_ctx ? (size_t)(TL + b * 256) : (size_t)b * 4096;
      if (!mirror || row <= 2048) store_h8(cat + (rbase + row) * 2048 + g * 128 + mm, va, vb, scale);
      if (mirror && row >= 1 && row <= 2047) {
        h16* mr = cat + (rbase + (4096 - row)) * 2048 + g * 128;
        mr[(128 - mm) & 127] = (h16)(va[0] * scale);
#pragma unroll
        for (int j = 1; j < 4; ++j) mr[128 - mm - j] = (h16)(va[j] * scale);
#pragma unroll
        for (int j = 0; j < 4; ++j) mr[124 - mm - j] = (h16)(vb[j] * scale);
      }
    }
  }
};

DEVI void ld8f(const float* p, float (&o)[8]) { const float4 a = *(const float4*)p, b = *(const float4*)(p + 4); o[0] = a.x; o[1] = a.y; o[2] = a.z; o[3] = a.w; o[4] = b.x; o[5] = b.y; o[6] = b.z; o[7] = b.w; }
DEVI void ld8f(const h16* p, float (&o)[8]) { const h16x8 v = *(const h16x8*)p;
#pragma unroll
  for (int i = 0; i < 8; ++i) o[i] = (float)v[i]; }
template <class TS>
struct EpiRes {
  static constexpr bool PERM = true, AFTER_DRAIN = false;
  const TS *src_lat, *src_ctx;
  h16* xres; const float* gate;
  DEVI void operator()(AccRef acc, const Unit& u, int wr, int wc, int fr, int fq) const {
    const int midx = (u.pm < 64) ? (u.pm >> 4) : 4;
    float gt[2][8];
#pragma unroll
    for (int bj = 0; bj < 2; ++bj) ld8f(gate + midx * 12288 + u.pn * 256 + bj * 128 + wc * 32 + fq * 8, gt[bj]);
#pragma unroll
    for (int ai = 0; ai < 2; ++ai)
#pragma unroll
      for (int m = 0; m < 4; ++m)
#pragma unroll
        for (int bj = 0; bj < 2; ++bj) {
          const int row = u.pm * 256 + ai * 128 + wr * 64 + m * 16 + fr;
          const int col = u.pn * 256 + bj * 128 + wc * 32 + fq * 8;
          const f32x4 v0 = acc[ai][bj][m][0], v1 = acc[ai][bj][m][1];
          float sv[8];
          ld8f(u.pm < 64 ? src_lat + (size_t)row * 2048 + col : src_ctx + (size_t)(row - TL) * 2048 + col, sv);
          h16x8 o;
#pragma unroll
          for (int j = 0; j < 4; ++j) { o[j] = (h16)(sv[j] + gt[bj][j] * v0[j]); o[4 + j] = (h16)(sv[4 + j] + gt[bj][4 + j] * v1[j]); }
          *(h16x8*)(xres + (size_t)row * 2048 + col) = o;
        }
  }
};

struct EpiPartial {
  static constexpr bool PERM = false, AFTER_DRAIN = false;
  float* part;
  DEVI void operator()(AccRef acc, const Unit& u, int wr, int wc, int fr, int fq) const {
    E8_FOR {
      const int row = E8_ROW, col = E8_COL;
      *(f32x4*)(part + (size_t)row * 2048 + col) = acc[ai][bj][m][n];
    }
  }
};

struct EpiGU {
  static constexpr bool PERM = true, AFTER_DRAIN = false;
  h16* act;
  DEVI void operator()(AccRef acc, const Unit& u, int wr, int wc, int fr, int fq) const {
#pragma unroll
    for (int ai = 0; ai < 2; ++ai)
#pragma unroll
      for (int m = 0; m < 4; ++m) {
        const int row = u.pm * 256 + ai * 128 + wr * 64 + m * 16 + fr;
        const int ocol = u.pn * 128 + wc * 32 + fq * 8;
        const f32x4 g0 = acc[ai][0][m][0], g1 = acc[ai][0][m][1], u0 = acc[ai][1][m][0], u1 = acc[ai][1][m][1];
        h16x8 o;
#pragma unroll
        for (int j = 0; j < 4; ++j) { o[j] = (h16)(silu_f(g0[j]) * u0[j]); o[4 + j] = (h16)(silu_f(g1[j]) * u1[j]); }
        *(h16x8*)(act + (size_t)row * DFF + ocol) = o;
      }
  }
};

struct EpiStore {
  static constexpr bool PERM = true, AFTER_DRAIN = false;
  h16* dst; int ldd;
  DEVI void operator()(AccRef acc, const Unit& u, int wr, int wc, int fr, int fq) const {
    E8P_FOR {
      const int row = E8_ROW, col = E8P_COL;
      store_h8(dst + (size_t)row * ldd + col, acc[ai][bj][m][0], acc[ai][bj][m][1]);
    }
  }
};

constexpr float LOG2E = 1.4426950408889634f;

struct EpiQ1 {
  static constexpr bool PERM = false, AFTER_DRAIN = false;
  h16* q1;
  DEVI void operator()(AccRef acc, const Unit& u, int wr, int wc, int fr, int fq) const {
    const float qs = 0.07216878364870322f * LOG2E;
#pragma unroll
    for (int bj = 0; bj < 2; ++bj) {
      const int cgb = u.pn * 256 + bj * 128 + wc * 32;
      const int w = cgb % 192;
      if (w < 128) {
#pragma unroll
        for (int ai = 0; ai < 2; ++ai)
#pragma unroll
          for (int m = 0; m < 4; ++m)
#pragma unroll
            for (int n = 0; n < 2; ++n) {
              const int row = u.pm * 256 + ai * 128 + wr * 64 + m * 16 + fr;
              const f32x4 v = acc[ai][bj][m][n];
              store_h4(q1 + (size_t)row * 2304 + cgb + n * 16 + fq * 4, v[0] * qs, v[1] * qs, v[2] * qs, v[3] * qs);
            }
      } else {
        const int half = (w - 128) >> 5;
        float inv[4];
#pragma unroll
        for (int j = 0; j < 4; ++j) inv[j] = fexp2(-(float)(fq * 4 + j) * (13.287712379549449f / 16.0f)) * 0.15915494309189535f;
#pragma unroll
        for (int ai = 0; ai < 2; ++ai)
#pragma unroll
          for (int m = 0; m < 4; ++m) {
            const int row = u.pm * 256 + ai * 128 + wr * 64 + m * 16 + fr;
            const int t = row & 4095;
            const float pos = (float)(half ? (t & 63) : (t >> 6));
            const f32x4 a = acc[ai][bj][m][0], bb = acc[ai][bj][m][1];
            float o1[4], o2[4];
#pragma unroll
            for (int j = 0; j < 4; ++j) {
              const float rev = pos * inv[j];
              const float cs = cos_rev(rev), sn = sin_rev(rev);
              o1[j] = (a[j] * cs - bb[j] * sn) * qs;
              o2[j] = (a[j] * sn + bb[j] * cs) * qs;
            }
            h16* d = q1 + (size_t)row * 2304 + cgb + fq * 4;
            store_h4(d, o1[0], o1[1], o1[2], o1[3]);
            store_h4(d + 16, o2[0], o2[1], o2[2], o2[3]);
          }
      }
    }
  }
};

struct EpiKV1 {
  static constexpr bool PERM = true, AFTER_DRAIN = false;
  h16 *kn, *vT1;
  DEVI void operator()(AccRef acc, const Unit& u, int wr, int wc, int fr, int fq) const {
    const int hh = u.pn;
    E8P_FOR {
      const int row = E8_ROW;
      const f32x4 va = acc[ai][bj][m][0], vb = acc[ai][bj][m][1];
      int b, key;
      if (row < TL) { b = row >> 12; key = 256 + (row & 4095); } else { b = (row - TL) >> 8; key = (row - TL) & 255; }
      const int w = wc * 32 + fq * 8;
      if (bj == 0) {
        store_h8(kn + ((size_t)b * 4352 + key) * 1536 + hh * 128 + w, va, vb);
      } else {
        h16* d = vT1 + (size_t)((b * 12 + hh) * 128 + w) * 4352 + key;
#pragma unroll
        for (int j = 0; j < 4; ++j) { d[(size_t)j * 4352] = (h16)va[j]; d[(size_t)(4 + j) * 4352] = (h16)vb[j]; }
      }
    }
  }
};

DEVI void mod_units(const Params& p, float* smemf) {
  float* mod = (float*)(p.ws + OFF_MOD);
  const int tid = tidx();
  float* ss = smemf;
  float* red = smemf + 5 * 2048;
  for (int i = tid; i < 5 * 2048; i += NTHR) {
    const int s = i >> 11, k = i & 2047;
    const float v = s < 4 ? p.c[s * 2048 + k] : p.c_ctx[k];
    ss[i] = silu_f(v);
  }
  __syncthreads();
  for (int u = blockIdx.x; u < 768; u += gridDim.x) {
    const int l = u / 384, n0 = (u % 384) * 32;
    const int cl = (tid & 7) * 4, kg = tid >> 3;
    const float* wp = p.w_mod + ((size_t)l * 2048 + kg * 32) * 12288 + n0 + cl;
    float4 a0 = {0, 0, 0, 0}, a1 = a0, a2 = a0, a3 = a0, a4 = a0;
#pragma unroll 8
    for (int kk = 0; kk < 32; ++kk) {
      const float4 w = ldnt4(wp + (size_t)kk * 12288);
      const int k = kg * 32 + kk;
      const float s0 = ss[k], s1 = ss[2048 + k], s2 = ss[4096 + k], s3 = ss[6144 + k], s4 = ss[8192 + k];
      a0.x += s0 * w.x; a0.y += s0 * w.y; a0.z += s0 * w.z; a0.w += s0 * w.w;
      a1.x += s1 * w.x; a1.y += s1 * w.y; a1.z += s1 * w.z; a1.w += s1 * w.w;
      a2.x += s2 * w.x; a2.y += s2 * w.y; a2.z += s2 * w.z; a2.w += s2 * w.w;
      a3.x += s3 * w.x; a3.y += s3 * w.y; a3.z += s3 * w.z; a3.w += s3 * w.w;
      a4.x += s4 * w.x; a4.y += s4 * w.y; a4.z += s4 * w.z; a4.w += s4 * w.w;
    }
    *(float4*)(red + (kg * 5 + 0) * 32 + cl) = a0;
    *(float4*)(red + (kg * 5 + 1) * 32 + cl) = a1;
    *(float4*)(red + (kg * 5 + 2) * 32 + cl) = a2;
    *(float4*)(red + (kg * 5 + 3) * 32 + cl) = a3;
    *(float4*)(red + (kg * 5 + 4) * 32 + cl) = a4;
    __syncthreads();
    if (tid < 160) {
      const int s = tid >> 5, cc = tid & 31;
      float sum = 0.f;
#pragma unroll 16
      for (int g = 0; g < 64; ++g) sum += red[(g * 5 + s) * 32 + cc];
      mod[(size_t)(l * 5 + s) * 12288 + n0 + cc] = sum + p.b_mod[l * 12288 + n0 + cc];
    }
    __syncthreads();
  }
}

DEVI int maprow(int mode, int n) {
  if (mode == 0) return n;
  if (mode == 1) return (n >> 7) * 256 + (n & 127);
  return (n >> 7) * 256 + 128 + (n & 127);
}
DEVI unsigned pack_h2(float lo, float hi) {
  typedef _Float16 h16x2 __attribute__((ext_vector_type(2)));
  h16x2 v; v[0] = (h16)lo; v[1] = (h16)hi;
  return __builtin_bit_cast(unsigned, v);
}
DEVI void transpose_job(const float* __restrict__ src, int ldsrc, int K, int N, int ncol0, h16* __restrict__ dst,
                        int ldd, int dcol0, int mode, float* tile_base, int worker, int nworkers) {
  const int tid = tidx();
  const int half = tid >> 8, tl = tid & 255;
  h16* tile = (h16*)tile_base + half * (64 * 68);
  const int nkt = K >> 6, nnt = N >> 6;
  const int ntiles = nkt * nnt;
  const int kp2 = (tl >> 4) * 2, lc4 = (tl & 15) * 4;
  float4 cur[4], nxt[4];
  int t = worker * 2 + half;
  const int tstride = nworkers * 2;
  if (t < ntiles) {
    const int kt = t / nnt, nt = t - kt * nnt;
    const float* sp = src + (size_t)(kt * 64 + kp2) * ldsrc + ncol0 + nt * 64 + lc4;
    cur[0] = ldnt4(sp); cur[1] = ldnt4(sp + ldsrc);
    cur[2] = ldnt4(sp + (size_t)32 * ldsrc); cur[3] = ldnt4(sp + (size_t)33 * ldsrc);
  }
  for (int t0 = worker * 2; t0 < ntiles; t0 += tstride, t += tstride) {
    const bool active = t < ntiles;
    const int tn = t + tstride;
    if (tn < ntiles) {
      const int kt = tn / nnt, nt = tn - kt * nnt;
      const float* sp = src + (size_t)(kt * 64 + kp2) * ldsrc + ncol0 + nt * 64 + lc4;
      nxt[0] = ldnt4(sp); nxt[1] = ldnt4(sp + ldsrc);
      nxt[2] = ldnt4(sp + (size_t)32 * ldsrc); nxt[3] = ldnt4(sp + (size_t)33 * ldsrc);
    }
    const int kt = t / nnt, nt = t - kt * nnt;
    const int k0 = kt * 64, n0 = nt * 64;
    if (active) {
      unsigned* tw = (unsigned*)tile;
#pragma unroll
      for (int i = 0; i < 2; ++i) {
        const int kd = (i * 32 + kp2) >> 1;
        const float4 a = cur[2 * i], bq = cur[2 * i + 1];
        tw[(lc4 + 0) * 34 + kd] = pack_h2(a.x, bq.x);
        tw[(lc4 + 1) * 34 + kd] = pack_h2(a.y, bq.y);
        tw[(lc4 + 2) * 34 + kd] = pack_h2(a.z, bq.z);
        tw[(lc4 + 3) * 34 + kd] = pack_h2(a.w, bq.w);
      }
    }
    __syncthreads();
    if (active) {
      const int n = tl >> 2, ks = (tl & 3) * 16;
      const uint2* rp = (const uint2*)(tile + n * 68 + ks);
      const uint2 r0 = rp[0], r1 = rp[1], r2 = rp[2], r3 = rp[3];
      h16* d = dst + (size_t)maprow(mode, n0 + n) * ldd + dcol0 + k0 + ks;
      *(uint4*)d = make_uint4(r0.x, r0.y, r1.x, r1.y);
      *(uint4*)(d + 8) = make_uint4(r2.x, r2.y, r3.x, r3.y);
    }
    __syncthreads();
#pragma unroll
    for (int i = 0; i < 4; ++i) cur[i] = nxt[i];
  }
}

DEVI void dft_gen(const Params& p) {
  h16* A = (h16*)(p.ws + OFF_DFTA);
  h16* Ac = (h16*)(p.ws + OFF_DFTAC);
  const size_t nthr = (size_t)gridDim.x * NTHR;
  const size_t gtid = (size_t)blockIdx.x * NTHR + tidx();
  if (gtid < 8) ((int*)(p.ws + OFF_CTR))[gtid * 8] = 0;
  for (size_t ch = gtid; ch < (size_t)2304 * 1024; ch += nthr) {
    const int k = (int)(ch >> 10), n8 = (int)(ch & 1023) * 8;
    h16x8 o;
#pragma unroll
    for (int e = 0; e < 8; ++e) {
      const int nn = n8 + e;
      const int n = nn & 4095;
      const float rev = (float)((k * n) & 4095) * (1.0f / 4096.0f);
      o[e] = (h16)((nn < 4096) ? cos_rev(rev) : -sin_rev(rev));
    }
    *(h16x8*)(A + (size_t)k * 8192 + n8) = o;
  }
  for (size_t ch = gtid; ch < (size_t)256 * 64; ch += nthr) {
    const int k = (int)(ch >> 6), n8 = (int)(ch & 63) * 8;
    h16x8 o;
#pragma unroll
    for (int e = 0; e < 8; ++e) {
      const int nn = n8 + e;
      const int n = nn & 255;
      const float rev = (float)((k * n) & 255) * (1.0f / 256.0f);
      o[e] = (h16)((nn < 256) ? cos_rev(rev) : -sin_rev(rev));
    }
    *(h16x8*)(Ac + (size_t)k * 512 + n8) = o;
  }
  h16* z = (h16*)(p.ws + OFF_WT_IN_CD) + (size_t)1856 * 2048;
  for (size_t ch = gtid; ch < (size_t)192 * 2048 / 8; ch += nthr) {
    uint4 zz = {0, 0, 0, 0};
    *(uint4*)(z + ch * 8) = zz;
  }
}

DEVI void fold_uc(const Params& p, float* smemf) {
  h16* wt = (h16*)(p.ws + OFF_WT_IN_AB);
  float* wl = smemf;
  float* ct = smemf + 128 * 64;
  float* st = ct + 128;
  const int tid = tidx();
  for (int u = blockIdx.x; u < 128; u += gridDim.x) {
    const int kb = u >> 2, g = u & 3, k0 = kb * 64;
    for (int i = tid; i < 64 * 32; i += NTHR) {
      const int kk = i >> 5, c4 = (i & 31) * 4;
      const float4 v = *(const float4*)(p.w_in_ab + (size_t)(k0 + kk) * 5120 + g * 128 + c4);
      wl[(c4 + 0) * 64 + kk] = v.x; wl[(c4 + 1) * 64 + kk] = v.y; wl[(c4 + 2) * 64 + kk] = v.z; wl[(c4 + 3) * 64 + kk] = v.w;
    }
    if (tid < 128) { ct[tid] = cos_rev((float)tid * (1.0f / 128.0f)); st[tid] = sin_rev((float)tid * (1.0f / 128.0f)); }
    __syncthreads();
    const int kh = tid >> 8, t2 = tid & 255;
    const int part = t2 >> 7, m = t2 & 127;
    const float* tab = part ? st : ct;
    float acc[32];
#pragma unroll
    for (int i = 0; i < 32; ++i) acc[i] = 0.f;
    for (int c = 0; c < 128; ++c) {
      const float tw = tab[(c * m) & 127];
#pragma unroll
      for (int k4 = 0; k4 < 8; ++k4) {
        const float4 w = *(const float4*)(wl + c * 64 + kh * 32 + k4 * 4);
        acc[k4 * 4 + 0] += w.x * tw; acc[k4 * 4 + 1] += w.y * tw; acc[k4 * 4 + 2] += w.z * tw; acc[k4 * 4 + 3] += w.w * tw;
      }
    }
    h16* d = wt + (size_t)(g * 256 + t2) * 2048 + k0 + kh * 32;
#pragma unroll
    for (int c8 = 0; c8 < 4; ++c8) {
      h16x8 o;
#pragma unroll
      for (int e = 0; e < 8; ++e) o[e] = (h16)acc[c8 * 8 + e];
      *(h16x8*)(d + c8 * 8) = o;
    }
    __syncthreads();
  }
}

DEVI void fold_out(const float* __restrict__ wg, const float* __restrict__ ps, const float* __restrict__ w_out,
                   h16* __restrict__ wt, float* smemf, int worker, int nworkers) {
  float* wl = smemf;
  float* wgl = smemf + 128 * 64;
  const int tid = tidx();
  for (int u = worker; u < 128; u += nworkers) {
    const int g = u >> 5, j0 = (u & 31) * 64;
    for (int i = tid; i < 128 * 16; i += NTHR) {
      const int d = i >> 4, c4 = (i & 15) * 4;
      float4 v = *(const float4*)(w_out + (size_t)(g * 128 + d) * 2048 + j0 + c4);
      const float sc = ps ? ps[g * 128 + d] : 1.0f;
      v.x *= sc; v.y *= sc; v.z *= sc; v.w *= sc;
      *(float4*)(wl + d * 64 + c4) = v;
    }
    for (int i = tid; i < 128 * 32; i += NTHR) {
      const int c = i >> 5, d4 = (i & 31) * 4;
      *(float4*)(wgl + c * 132 + d4) = *(const float4*)(wg + (size_t)(g * 128 + c) * 128 + d4);
    }
    __syncthreads();
    const int j = tid & 63;
    const int cg_ = __builtin_amdgcn_readfirstlane(tid >> 6);
    float acc[16];
#pragma unroll
    for (int i = 0; i < 16; ++i) acc[i] = 0.f;
    const float* wgp = wgl + (cg_ * 16) * 132;
    for (int d4 = 0; d4 < 32; ++d4) {
      const float w0 = wl[(d4 * 4 + 0) * 64 + j], w1 = wl[(d4 * 4 + 1) * 64 + j], w2 = wl[(d4 * 4 + 2) * 64 + j], w3 = wl[(d4 * 4 + 3) * 64 + j];
#pragma unroll
      for (int cc = 0; cc < 16; ++cc) {
        const float4 gq = *(const float4*)(wgp + cc * 132 + d4 * 4);
        acc[cc] += gq.x * w0 + gq.y * w1 + gq.z * w2 + gq.w * w3;
      }
    }
    h16* dst = wt + (size_t)(j0 + j) * 2048 + g * 128 + cg_ * 16;
#pragma unroll
    for (int c8 = 0; c8 < 2; ++c8) {
      h16x8 o;
#pragma unroll
      for (int e = 0; e < 8; ++e) o[e] = (h16)acc[c8 * 8 + e];
      *(h16x8*)(dst + c8 * 8) = o;
    }
    __syncthreads();
  }
}

DEVI void phase0(const Params& p, float* smemf) {
  const int w = blockIdx.x, nw = gridDim.x;
  mod_units(p, smemf);
  dft_gen(p);
  fold_uc(p, smemf);
  fold_out(p.w_four, nullptr, p.w_out_ab, (h16*)(p.ws + OFF_WT_OUT_AB), smemf, w, nw);
  transpose_job(p.w_in_ab, 5120, 2048, 4608, 512, (h16*)(p.ws + OFF_WT_IN_AB) + (size_t)1024 * 2048, 2048, 0, 0, smemf, w, nw);
  transpose_job(p.w_out_ab + (size_t)512 * 2048, 2048, 1536, 2048, 0, (h16*)(p.ws + OFF_WT_OUT_AB), 2048, 512, 0, smemf, w, nw);
}
DEVI void prep_ffn_gu(const Params& p, int l, float* smemf, int w, int nw) {
  h16* gu = (h16*)(p.ws + (l ? OFF_WT_GU1 : OFF_WT_GU0));
  transpose_job(p.w_ffn_gate + (size_t)l * 2048 * DFF, DFF, 2048, DFF, 0, gu, 2048, 0, 1, smemf, w, nw);
  transpose_job(p.w_ffn_up + (size_t)l * 2048 * DFF, DFF, 2048, DFF, 0, gu, 2048, 0, 2, smemf, w, nw);
}
DEVI void prep_ffn_dn(const Params& p, int l, float* smemf, int w, int nw) {
  h16* dn = (h16*)(p.ws + (l ? OFF_WT_D1 : OFF_WT_D0));
  transpose_job(p.w_ffn_down + (size_t)l * DFF * 2048, 2048, DFF, 2048, 0, dn, DFF, 0, 0, smemf, w, nw);
}
DEVI void prep_ffn(const Params& p, int l, float* smemf, int w, int nw) {
  prep_ffn_gu(p, l, smemf, w, nw);
  prep_ffn_dn(p, l, smemf, w, nw);
}
DEVI void prep_layer1(const Params& p, float* smemf, int w, int nw, bool with_ffn = true) {
  fold_out(p.w_pool, p.pool_scale, p.w_out_cd, (h16*)(p.ws + OFF_WT_OUT_CD), smemf, w, nw);
  transpose_job(p.w_out_cd + (size_t)512 * 2048, 2048, 1536, 2048, 0, (h16*)(p.ws + OFF_WT_OUT_CD), 2048, 512, 0, smemf, w, nw);
  transpose_job(p.w_in_cd, 1856, 2048, 1856, 0, (h16*)(p.ws + OFF_WT_IN_CD), 2048, 0, 0, smemf, w, nw);
  transpose_job(p.w_uq, 2304, 768, 2304, 0, (h16*)(p.ws + OFF_WT_UQ), 768, 0, 0, smemf, w, nw);
  transpose_job(p.w_ukv, 3072, 512, 3072, 0, (h16*)(p.ws + OFF_WT_UKV), 512, 0, 0, smemf, w, nw);
  if (with_ffn) prep_ffn(p, 1, smemf, w, nw);
}

template <class TS>
DEVI void norm_mod_phase(const TS* src_lat, const TS* src_ctx, int nrows, const float* gvec, const float* modl,
                         int sh_idx, int sc_idx, h16* dst) {
  const int tid_ = tidx();
  const int lane = tid_ & 63, wid = tid_ >> 6;
  const int w = blockIdx.x * 8 + wid, nw = gridDim.x * 8;
  const int rbeg = (int)(((long)w * nrows) / nw), rend = (int)(((long)(w + 1) * nrows) / nw);
  if (rbeg >= rend) return;
  float4 fa[8], fb[8], v[8], vn[8];
  int cur_midx = -1;
  {
    const TS* s = rbeg < TL ? src_lat + (size_t)rbeg * 2048 : src_ctx + (size_t)(rbeg - TL) * 2048;
#pragma unroll
    for (int i = 0; i < 8; ++i) v[i] = ld4f(s + (i * 64 + lane) * 4);
  }
  for (int row = rbeg; row < rend; ++row) {
    if (row + 1 < rend) {
      const int r2 = row + 1;
      const TS* s = r2 < TL ? src_lat + (size_t)r2 * 2048 : src_ctx + (size_t)(r2 - TL) * 2048;
#pragma unroll
      for (int i = 0; i < 8; ++i) vn[i] = ld4f(s + (i * 64 + lane) * 4);
    }
    const int midx = row < TL ? (row >> 12) : 4;
    if (midx != cur_midx) {
      cur_midx = midx;
      const float* shp = modl + (size_t)midx * 12288 + sh_idx * 2048;
      const float* scp = modl + (size_t)midx * 12288 + sc_idx * 2048;
#pragma unroll
      for (int i = 0; i < 8; ++i) {
        const int col = (i * 64 + lane) * 4;
        const float4 g = *(const float4*)(gvec + col);
        const float4 sc = *(const float4*)(scp + col);
        fb[i] = *(const float4*)(shp + col);
        fa[i].x = g.x * (1.f + sc.x); fa[i].y = g.y * (1.f + sc.y); fa[i].z = g.z * (1.f + sc.z); fa[i].w = g.w * (1.f + sc.w);
      }
    }
    float ss = 0.f;
#pragma unroll
    for (int i = 0; i < 8; ++i) ss += v[i].x * v[i].x + v[i].y * v[i].y + v[i].z * v[i].z + v[i].w * v[i].w;
    ss = wave_sum(ss);
    const float rstd = rsqrtf(ss * (1.0f / 2048.0f) + 1e-6f);
#pragma unroll
    for (int i = 0; i < 8; ++i) {
      const int col = (i * 64 + lane) * 4;
      store_h4(dst + (size_t)row * 2048 + col, v[i].x * rstd * fa[i].x + fb[i].x, v[i].y * rstd * fa[i].y + fb[i].y,
               v[i].z * rstd * fa[i].z + fb[i].z, v[i].w * rstd * fa[i].w + fb[i].w);
    }
#pragma unroll
    for (int i = 0; i < 8; ++i) v[i] = vn[i];
  }
}

DEVI void ctx_norm_partial_phase(const h16* src_ctx, const float* gvec, const float* modl, int sh_idx, int sc_idx, h16* dst,
                                 const float* part, int nsplit, const float* pgate) {
  const int tid_ = tidx();
  const int lane = tid_ & 63, wid = tid_ >> 6;
  const int w = blockIdx.x * 8 + wid, nw = gridDim.x * 8;
  const float* shp = modl + (size_t)4 * 12288 + sh_idx * 2048;
  const float* scp = modl + (size_t)4 * 12288 + sc_idx * 2048;
  for (int r = w; r < TC; r += nw) {
    float4 v[8];
    float ss = 0.f;
#pragma unroll
    for (int i = 0; i < 8; ++i) {
      const int col = (i * 64 + lane) * 4;
      float4 acc = make_float4(0.f, 0.f, 0.f, 0.f);
      for (int sp = 0; sp < nsplit; ++sp) {
        const float4 q = *(const float4*)(part + ((size_t)sp * TC + r) * 2048 + col);
        acc.x += q.x; acc.y += q.y; acc.z += q.z; acc.w += q.w;
      }
      const float4 gq = *(const float4*)(pgate + col);
      const float4 x = ld4f(src_ctx + (size_t)r * 2048 + col);
      v[i].x = x.x + gq.x * acc.x; v[i].y = x.y + gq.y * acc.y; v[i].z = x.z + gq.z * acc.z; v[i].w = x.w + gq.w * acc.w;
      ss += v[i].x * v[i].x + v[i].y * v[i].y + v[i].z * v[i].z + v[i].w * v[i].w;
    }
    ss = wave_sum(ss);
    const float rstd = rsqrtf(ss * (1.0f / 2048.0f) + 1e-6f);
#pragma unroll
    for (int i = 0; i < 8; ++i) {
      const int col = (i * 64 + lane) * 4;
      const float4 g = *(const float4*)(gvec + col);
      const float4 sh = *(const float4*)(shp + col);
      const float4 sc = *(const float4*)(scp + col);
      store_h4(dst + (size_t)(TL + r) * 2048 + col, v[i].x * rstd * g.x * (1.f + sc.x) + sh.x, v[i].y * rstd * g.y * (1.f + sc.y) + sh.y,
               v[i].z * rstd * g.z * (1.f + sc.z) + sh.z, v[i].w * rstd * g.w * (1.f + sc.w) + sh.w);
    }
  }
}

DEVI void final_norm_phase(const h16* xres, const float* gvec, float* out) {
  const int tid_ = tidx();
  const int lane = tid_ & 63, wid = tid_ >> 6;
  const int w = blockIdx.x * 8 + wid, nw = gridDim.x * 8;
  const int rbeg = (int)(((long)w * TL) / nw), rend = (int)(((long)(w + 1) * TL) / nw);
  if (rbeg >= rend) return;
  float4 fa[8], v[8], vn[8];
#pragma unroll
  for (int i = 0; i < 8; ++i) {
    fa[i] = *(const float4*)(gvec + (i * 64 + lane) * 4);
    v[i] = ld4f(xres + (size_t)rbeg * 2048 + (i * 64 + lane) * 4);
  }
  for (int row = rbeg; row < rend; ++row) {
    if (row + 1 < rend) {
#pragma unroll
      for (int i = 0; i < 8; ++i) vn[i] = ld4f(xres + (size_t)(row + 1) * 2048 + (i * 64 + lane) * 4);
    }
    float ss = 0.f;
#pragma unroll
    for (int i = 0; i < 8; ++i) ss += v[i].x * v[i].x + v[i].y * v[i].y + v[i].z * v[i].z + v[i].w * v[i].w;
    ss = wave_sum(ss);
    const float rstd = rsqrtf(ss * (1.0f / 2048.0f) + 1e-6f);
#pragma unroll
    for (int i = 0; i < 8; ++i) {
      float4 o;
      o.x = v[i].x * rstd * fa[i].x; o.y = v[i].y * rstd * fa[i].y; o.z = v[i].z * rstd * fa[i].z; o.w = v[i].w * rstd * fa[i].w;
      stnt4(out + (size_t)row * 2048 + (i * 64 + lane) * 4, o);
    }
#pragma unroll
    for (int i = 0; i < 8; ++i) v[i] = vn[i];
  }
}

constexpr int NA_KS = 136;
constexpr int NA_VS = 136;
constexpr int NA_BUF = 128 * NA_KS + 128 * NA_VS;
template <int VAR>
DEVI void na_block_unit(const Params& p, int bu, h16* smem) {
  const h16* q0 = (const h16*)(p.ws + OFF_Q0);
  const h16* k0 = (const h16*)(p.ws + OFF_K0);
  const h16* vT = (const h16*)(p.ws + OFF_VT0);
  const h16* vcT = (const h16*)(p.ws + OFF_VCT0);
  h16* cat = VAR ? (h16*)p.out : (h16*)(p.ws + OFF_CAT);
  const int tid = tidx(), lane = tid & 63, wid = tid >> 6;
  const int q_ = lane & 15, g = lane >> 4;
  const bool is_ctx = bu >= 1536;
  int bh, rp = 0, half = 0;
  if (!is_ctx) { rp = bu & 31; bh = bu >> 5; } else { const int uu = bu - 1536; half = uu & 1; bh = uu >> 1; }
  const int hd = bh % 12, b = bh / 12;
  const int rw = 2 * rp + (wid >> 2), j = wid & 3;
  const size_t qrow = is_ctx ? (size_t)(TL + b * 256 + half * 128 + wid * 16 + q_) : (size_t)(b * 4096 + rw * 64 + j * 16 + q_);
  const int rs0 = min(max(2 * rp - 4, 0), 56), rs1 = min(max(2 * rp - 3, 0), 56);
  const int nrows = is_ctx ? 0 : (rs1 - rs0 + 8);
  const int nloc = (nrows + 1) >> 1;
  const int T = nloc + 2;
  const int rsw = min(max(rw - 4, 0), 56);
  const h16* qp = q0 + qrow * 1536 + hd * 128 + g * 8;
  h16x8 qf[4];
#pragma unroll
  for (int s = 0; s < 4; ++s) qf[s] = *(const h16x8*)(qp + s * 32);
  f32x4 o[8];
#pragma unroll
  for (int d = 0; d < 8; ++d) { o[d][0] = 0.f; o[d][1] = 0.f; o[d][2] = 0.f; o[d][3] = 0.f; }
  float m = -1e30f, lsum = 0.f;
  const int kstart = min(max(j * 16 - 8, 0), 32);
  const int qc = j * 16 + q_;
  const int cstart = min(max(qc - 8, 0), 48);
  const float scale = 0.08838834764831845f * LOG2E;
  float* rpb = (float*)(smem + 2 * NA_BUF);
  if (!is_ctx && tid < 465) rpb[tid] = p.na_rpb[hd * 465 + tid] * LOG2E;
  const int srow = tid >> 4, sch = tid & 15;
  const h16* kloc = k0 + (size_t)b * 4096 * 1536 + hd * 128 + (size_t)srow * 1536 + sch * 8;
  const h16* kctx = k0 + ((size_t)TL + b * 256) * 1536 + hd * 128 + (size_t)srow * 1536 + sch * 8;
  const h16* vloc = vT + ((size_t)(b * 12 + hd) * 128 + srow) * 4096 + sch * 8;
  const h16* vctx = vcT + ((size_t)(b * 12 + hd) * 128 + srow) * 256 + sch * 8;
  uint4 A0, A1, A2, A3, A4, A5, A6, A7;
#define NA_GLOAD(t, R0, R1, R2, R3, R4, R5, R6, R7)                                                    \
  {                                                                                                    \
    if ((t) < nloc) {                                                                                  \
      const int krow = rs0 + 2 * (t);                        \
      const h16* kb = kloc + (size_t)krow * 64 * 1536;                                                 \
      const h16* vb = vloc + krow * 64;                                                                \
      R0 = *(const uint4*)kb; R1 = *(const uint4*)(kb + 32 * 1536);                                    \
      R2 = *(const uint4*)(kb + 64 * 1536); R3 = *(const uint4*)(kb + 96 * 1536);                      \
      R4 = *(const uint4*)vb; R5 = *(const uint4*)(vb + (size_t)32 * 4096);                            \
      R6 = *(const uint4*)(vb + (size_t)64 * 4096); R7 = *(const uint4*)(vb + (size_t)96 * 4096);      \
    } else {                                                                                           \
      const int c = (t) - nloc;                                                                        \
      const h16* kb = kctx + (size_t)c * 128 * 1536;                                                   \
      const h16* vb = vctx + c * 128;                                                                  \
      R0 = *(const uint4*)kb; R1 = *(const uint4*)(kb + 32 * 1536);                                    \
      R2 = *(const uint4*)(kb + 64 * 1536); R3 = *(const uint4*)(kb + 96 * 1536);                      \
      R4 = *(const uint4*)vb; R5 = *(const uint4*)(vb + 32 * 256);                                     \
      R6 = *(const uint4*)(vb + 64 * 256); R7 = *(const uint4*)(vb + 96 * 256);                        \
    }                                                                                                  \
  }
#define NA_SSTORE(buf, R0, R1, R2, R3, R4, R5, R6, R7)                                                 \
  {                                                                                                    \
    h16* bk = smem + (buf) * NA_BUF;                                                                   \
    h16* bv = bk + 128 * NA_KS;                                                                        \
    *(uint4*)(bk + srow * NA_KS + sch * 8) = R0;                                                       \
    *(uint4*)(bk + (srow + 32) * NA_KS + sch * 8) = R1;                                                \
    *(uint4*)(bk + (srow + 64) * NA_KS + sch * 8) = R2;                                                \
    *(uint4*)(bk + (srow + 96) * NA_KS + sch * 8) = R3;                                                \
    *(uint4*)(bv + srow * NA_VS + sch * 8) = R4;                                                       \
    *(uint4*)(bv + (srow + 32) * NA_VS + sch * 8) = R5;                                                \
    *(uint4*)(bv + (srow + 64) * NA_VS + sch * 8) = R6;                                                \
    *(uint4*)(bv + (srow + 96) * NA_VS + sch * 8) = R7;                                                \
  }
  auto iter32 = [&](const h16* sKw, const h16* sVw, bool loc, int ridx) {
    f32x4 s0 = {0.f, 0.f, 0.f, 0.f}, s1 = {0.f, 0.f, 0.f, 0.f};
    const h16* kp = sKw + q_ * NA_KS + g * 8;
#pragma unroll
    for (int s = 0; s < 4; ++s) {
      const h16x8 ka = *(const h16x8*)(kp + s * 32);
      const h16x8 kb = *(const h16x8*)(kp + 16 * NA_KS + s * 32);
      s0 = mfma16(ka, qf[s], s0);
      s1 = mfma16(kb, qf[s], s1);
    }
    float sc[8];
#pragma unroll
    for (int i = 0; i < 4; ++i) { sc[i] = s0[i] * scale; sc[4 + i] = s1[i] * scale; }
    if (loc) {
#pragma unroll
      for (int i = 0; i < 8; ++i) {
        const int kcol = kstart + (i >> 2) * 16 + g * 4 + (i & 3);
        const bool valid = (kcol >= cstart) && (kcol < cstart + 16);
        const int cidx = min(max(kcol - qc + 15, 0), 30);
        const float bias = rpb[ridx * 31 + cidx];
        sc[i] = valid ? (sc[i] + bias) : -1e30f;
      }
    }
    float mx = sc[0];
#pragma unroll
    for (int i = 1; i < 8; ++i) mx = fmaxf(mx, sc[i]);
    mx = fmaxf(mx, __shfl_xor(mx, 16));
    mx = fmaxf(mx, __shfl_xor(mx, 32));
    const float mn = (mx > m + 8.0f) ? mx : m;
    const float alpha = fexp2(m - mn);
    m = mn;
    float ps = 0.f;
    h16x8 pf;
#pragma unroll
    for (int i = 0; i < 8; ++i) {
      const float pv = fexp2(sc[i] - mn);
      ps += pv;
      pf[i] = (h16)pv;
    }
    lsum = lsum * alpha + ps;
    if (__builtin_amdgcn_ballot_w64(alpha != 1.0f) != 0) {
#pragma unroll
      for (int d = 0; d < 8; ++d) { o[d][0] *= alpha; o[d][1] *= alpha; o[d][2] *= alpha; o[d][3] *= alpha; }
    }
#pragma unroll
    for (int d = 0; d < 8; ++d) {
      const h16* vp = sVw + (d * 16 + q_) * NA_VS + g * 4;
      const h16x4 lo = *(const h16x4*)vp;
      const h16x4 hi = *(const h16x4*)(vp + 16);
      h16x8 vf;
      vf[0] = lo[0]; vf[1] = lo[1]; vf[2] = lo[2]; vf[3] = lo[3];
      vf[4] = hi[0]; vf[5] = hi[1]; vf[6] = hi[2]; vf[7] = hi[3];
      o[d] = mfma16(vf, pf, o[d]);
    }
  };
  auto iter64 = [&](const h16* sK0, const h16* sV0, const h16* sK1, const h16* sV1, bool loc, int ridx0, int ridx1) {
    f32x4 s00 = {0.f, 0.f, 0.f, 0.f}, s01 = s00, s10 = s00, s11 = s00;
    const h16* kp0 = sK0 + q_ * NA_KS + g * 8;
    const h16* kp1 = sK1 + q_ * NA_KS + g * 8;
#pragma unroll
    for (int s = 0; s < 4; ++s) {
      s00 = mfma16(*(const h16x8*)(kp0 + s * 32), qf[s], s00);
      s01 = mfma16(*(const h16x8*)(kp0 + 16 * NA_KS + s * 32), qf[s], s01);
      s10 = mfma16(*(const h16x8*)(kp1 + s * 32), qf[s], s10);
      s11 = mfma16(*(const h16x8*)(kp1 + 16 * NA_KS + s * 32), qf[s], s11);
    }
    float sc[16];
#pragma unroll
    for (int i = 0; i < 4; ++i) { sc[i] = s00[i] * scale; sc[4 + i] = s01[i] * scale; sc[8 + i] = s10[i] * scale; sc[12 + i] = s11[i] * scale; }
    if (loc) {
#pragma unroll
      for (int i = 0; i < 8; ++i) {
        const int kcol = kstart + (i >> 2) * 16 + g * 4 + (i & 3);
        const bool valid = (kcol >= cstart) && (kcol < cstart + 16);
        const int cidx = min(max(kcol - qc + 15, 0), 30);
        sc[i] = valid ? (sc[i] + rpb[ridx0 * 31 + cidx]) : -1e30f;
        sc[8 + i] = valid ? (sc[8 + i] + rpb[ridx1 * 31 + cidx]) : -1e30f;
      }
    }
    float mx = sc[0];
#pragma unroll
    for (int i = 1; i < 16; ++i) mx = fmaxf(mx, sc[i]);
    mx = fmaxf(mx, __shfl_xor(mx, 16));
    mx = fmaxf(mx, __shfl_xor(mx, 32));
    const float mn = (mx > m + 8.0f) ? mx : m;
    const float alpha = fexp2(m - mn);
    m = mn;
    float ps = 0.f;
    h16x8 pf0, pf1;
#pragma unroll
    for (int i = 0; i < 8; ++i) {
      const float pa = fexp2(sc[i] - mn), pb = fexp2(sc[8 + i] - mn);
      ps += pa + pb;
      pf0[i] = (h16)pa; pf1[i] = (h16)pb;
    }
    lsum = lsum * alpha + ps;
    if (__builtin_amdgcn_ballot_w64(alpha != 1.0f) != 0) {
#pragma unroll
      for (int d = 0; d < 8; ++d) { o[d][0] *= alpha; o[d][1] *= alpha; o[d][2] *= alpha; o[d][3] *= alpha; }
    }
#pragma unroll
    for (int d = 0; d < 8; ++d) {
      const h16* vp0 = sV0 + (d * 16 + q_) * NA_VS + g * 4;
      const h16* vp1 = sV1 + (d * 16 + q_) * NA_VS + g * 4;
      const h16x4 lo0 = *(const h16x4*)vp0, hi0 = *(const h16x4*)(vp0 + 16);
      const h16x4 lo1 = *(const h16x4*)vp1, hi1 = *(const h16x4*)(vp1 + 16);
      h16x8 vf0, vf1;
      vf0[0] = lo0[0]; vf0[1] = lo0[1]; vf0[2] = lo0[2]; vf0[3] = lo0[3]; vf0[4] = hi0[0]; vf0[5] = hi0[1]; vf0[6] = hi0[2]; vf0[7] = hi0[3];
      vf1[0] = lo1[0]; vf1[1] = lo1[1]; vf1[2] = lo1[2]; vf1[3] = lo1[3]; vf1[4] = hi1[0]; vf1[5] = hi1[1]; vf1[6] = hi1[2]; vf1[7] = hi1[3];
      o[d] = mfma16(vf0, pf0, o[d]);
      o[d] = mfma16(vf1, pf1, o[d]);
    }
  };
  auto compute = [&](int t) {
    const h16* sK = smem + (t & 1) * NA_BUF;
    const h16* sV = sK + 128 * NA_KS;
    if (t < nloc) {
      const int kr0 = rs0 + 2 * t, kr1 = kr0 + 1;
      const bool m0 = (kr0 >= rsw) && (kr0 < rsw + 8);
      const bool m1 = (kr1 >= rsw) && (kr1 < rsw + 8);
      if (m0 && m1) iter64(sK + kstart * NA_KS, sV + kstart, sK + (64 + kstart) * NA_KS, sV + 64 + kstart, true, kr0 - rw + 7, kr1 - rw + 7);
      else if (m0) iter32(sK + kstart * NA_KS, sV + kstart, true, kr0 - rw + 7);
      else if (m1) iter32(sK + (64 + kstart) * NA_KS, sV + 64 + kstart, true, kr1 - rw + 7);
    } else {
      iter64(sK, sV, sK + 32 * NA_KS, sV + 32, false, 0, 0);
      iter64(sK + 64 * NA_KS, sV + 64, sK + 96 * NA_KS, sV + 96, false, 0, 0);
    }
  };
  NA_GLOAD(0, A0, A1, A2, A3, A4, A5, A6, A7);
  NA_SSTORE(0, A0, A1, A2, A3, A4, A5, A6, A7);
  NA_GLOAD(1, A0, A1, A2, A3, A4, A5, A6, A7);
  __syncthreads();
  for (int t = 0; t < T; ++t) {
    if (VAR != 1) compute(t);
    if (t + 1 < T && VAR != 2) NA_SSTORE((t + 1) & 1, A0, A1, A2, A3, A4, A5, A6, A7);
    if (t + 2 < T && VAR != 2) NA_GLOAD(t + 2, A0, A1, A2, A3, A4, A5, A6, A7);
    __syncthreads();
  }
  lsum += __shfl_xor(lsum, 16);
  lsum += __shfl_xor(lsum, 32);
  const float rl = 1.0f / lsum;
  h16* op = cat + qrow * 2048 + 512 + hd * 128 + g * 4;
#pragma unroll
  for (int d = 0; d < 8; ++d) store_h4(op + d * 16, o[d][0] * rl, o[d][1] * rl, o[d][2] * rl, o[d][3] * rl);
#undef NA_GLOAD
#undef NA_SSTORE
}

constexpr int MLA_KS = 200;
constexpr int MLA_VS = 72;
constexpr int MLA_BUF = 64 * MLA_KS + 128 * MLA_VS;
template <int VAR>
DEVI void mla_unit(const Params& p, int unit, h16* smem) {
  const h16* q1 = (const h16*)(p.ws + OFF_Q1);
  const h16* kn = (const h16*)(p.ws + OFF_KN);
  const h16* kr = (const h16*)(p.ws + OFF_KR);
  const h16* vT1 = (const h16*)(p.ws + OFF_VT1);
  h16* cat = VAR ? (h16*)p.out : (h16*)(p.ws + OFF_CAT);
  const int tid = tidx(), lane = tid & 63, wid = tid >> 6;
  const int qblk = unit & 15, bh = unit >> 4, hd = bh % 12, b = bh / 12;
  const int q_ = lane & 31, hh = lane >> 5;
  const size_t qrow = (size_t)b * 4096 + qblk * 256 + wid * 32 + q_;
  const h16* qp = q1 + qrow * 2304 + hd * 192 + hh * 8;
  h16x8 qf[12];
#pragma unroll
  for (int s = 0; s < 12; ++s) qf[s] = *(const h16x8*)(qp + s * 16);
  const int skey = tid >> 3, sc0 = tid & 7;
  const h16* gk = kn + ((size_t)b * 4352 + skey) * 1536 + hd * 128 + sc0 * 8;
  const h16* gr = kr + ((size_t)b * 4352 + skey) * 64 + sc0 * 8;
  const h16* gv = vT1 + ((size_t)(b * 12 + hd) * 128 + skey) * 4352 + sc0 * 8;
  uint4 rk0, rk1, rk2, rv0, rv1;
#define MLA_GLOAD(KT)                                             \
  {                                                               \
    const size_t key0 = (size_t)(KT) * 64;                        \
    rk0 = *(const uint4*)(gk + key0 * 1536);                      \
    rk1 = *(const uint4*)(gk + key0 * 1536 + 64);                 \
    rk2 = *(const uint4*)(gr + key0 * 64);                        \
    rv0 = *(const uint4*)(gv + key0);                             \
    rv1 = *(const uint4*)(gv + (size_t)64 * 4352 + key0);         \
  }
#define MLA_SSTORE(BUF)                                           \
  {                                                               \
    h16* bk = smem + (BUF) * MLA_BUF;                             \
    h16* bv = bk + 64 * MLA_KS;                                   \
    *(uint4*)(bk + skey * MLA_KS + sc0 * 8) = rk0;                \
    *(uint4*)(bk + skey * MLA_KS + 64 + sc0 * 8) = rk1;           \
    *(uint4*)(bk + skey * MLA_KS + 128 + sc0 * 8) = rk2;          \
    h16* d0 = bv + skey * MLA_VS + (sc0 >> 1) * 16 + (sc0 & 1) * 4;  \
    *(uint2*)d0 = make_uint2(rv0.x, rv0.y);                       \
    *(uint2*)(d0 + 8) = make_uint2(rv0.z, rv0.w);                 \
    h16* d1 = d0 + 64 * MLA_VS;                                   \
    *(uint2*)d1 = make_uint2(rv1.x, rv1.y);                       \
    *(uint2*)(d1 + 8) = make_uint2(rv1.z, rv1.w);                 \
  }
  f32x16 o[4];
#pragma unroll
  for (int d = 0; d < 4; ++d)
#pragma unroll
    for (int i = 0; i < 16; ++i) o[d][i] = 0.f;
  float m = -1e30f, lsum = 0.f;
  f32x16 sc, sn;
#define MLA_SUBSTEP(HAVE_NEXT, KNEXT, VCUR)                                                       \
  {                                                                                               \
    _Pragma("unroll") for (int i = 0; i < 16; ++i) sn[i] = 0.f;                                   \
    if (HAVE_NEXT) {                                                                              \
      const h16* kp = (KNEXT) + q_ * MLA_KS + hh * 8;                                             \
      _Pragma("unroll") for (int st = 0; st < 12; ++st) sn = mfma32(*(const h16x8*)(kp + st * 16), qf[st], sn); \
    }                                                                                             \
    float mx = sc[0];                                                                             \
    _Pragma("unroll") for (int i = 1; i < 16; ++i) mx = fmaxf(mx, sc[i]);                         \
    mx = fmaxf(mx, __shfl_xor(mx, 32));                                                           \
    const float mn = (mx > m + 8.0f) ? mx : m;     \
    const float alpha = fexp2(m - mn);                                                            \
    m = mn;                                                                                       \
    float ps = 0.f;                                                                               \
    h16x8 pf0, pf1;                                                                               \
    _Pragma("unroll") for (int i = 0; i < 8; ++i) {                                               \
      const float pa = (VAR == 2) ? (sc[i] - mn) : fexp2(sc[i] - mn), pb = (VAR == 2) ? (sc[8 + i] - mn) : fexp2(sc[8 + i] - mn); \
      ps += pa + pb;                                                                              \
      pf0[i] = (h16)pa; pf1[i] = (h16)pb;                                                         \
    }                                                                                             \
    lsum = lsum * alpha + ps;                                                                     \
    __builtin_amdgcn_sched_group_barrier(0x100, 4, 0);                                            \
    _Pragma("unroll") for (int i = 0; i < 12; ++i) {                                              \
      __builtin_amdgcn_sched_group_barrier(0x008, 1, 0);                                          \
      __builtin_amdgcn_sched_group_barrier(0x002, 7, 0);                                          \
      __builtin_amdgcn_sched_group_barrier(0x100, 1, 0);                                          \
    }                                                                                             \
    if (__builtin_amdgcn_ballot_w64(alpha != 1.0f) != 0) {                                        \
      _Pragma("unroll") for (int d = 0; d < 4; ++d)                                               \
        _Pragma("unroll") for (int i = 0; i < 16; ++i) o[d][i] *= alpha;                          \
    }                                                                                             \
    _Pragma("unroll") for (int s2 = 0; s2 < 2; ++s2) {                                            \
      _Pragma("unroll") for (int d = 0; d < 4; ++d) {                                             \
        const h16x8 vf = *(const h16x8*)((VCUR) + (d * 32 + q_) * MLA_VS + s2 * 16 + hh * 8);     \
        if (VAR != 3) o[d] = mfma32(vf, s2 ? pf1 : pf0, o[d]); else o[d][0] += (float)vf[0] * (float)pf0[0]; \
      }                                                                                           \
    }                                                                                             \
    sc = sn;                                                                                      \
  }
  constexpr int NT = 4352 / 64;
  MLA_GLOAD(0);
  MLA_SSTORE(0);
  MLA_GLOAD(1);
  MLA_SSTORE(1);
  __syncthreads();
  {
#pragma unroll
    for (int i = 0; i < 16; ++i) sc[i] = 0.f;
    const h16* kp = smem + q_ * MLA_KS + hh * 8;
#pragma unroll
    for (int st = 0; st < 12; ++st) sc = mfma32(*(const h16x8*)(kp + st * 16), qf[st], sc);
  }
  int bc = 0;
  for (int kt = 0; kt < NT; ++kt) {
    const int bn = (bc == 2) ? 0 : bc + 1;
    const int bw = (bn == 2) ? 0 : bn + 1;
    const bool pre = kt + 2 < NT;
    if (pre && VAR != 1) MLA_GLOAD(kt + 2);
    const h16* sK = smem + bc * MLA_BUF;
    const h16* sV = sK + 64 * MLA_KS;
    const h16* sKn = smem + bn * MLA_BUF;
    MLA_SUBSTEP(true, sK + 32 * MLA_KS, sV);
    MLA_SUBSTEP(kt + 1 < NT, sKn, sV + 32);
    if (pre && VAR != 1) MLA_SSTORE(bw);
    __syncthreads();
    bc = bn;
  }
  lsum += __shfl_xor(lsum, 32);
  const float rl = 1.0f / lsum;
  h16* op = cat + qrow * 2048 + 512 + hd * 128 + hh * 4;
#pragma unroll
  for (int d = 0; d < 4; ++d)
#pragma unroll
    for (int i4 = 0; i4 < 4; ++i4)
      store_h4(op + d * 32 + i4 * 8, o[d][i4 * 4 + 0] * rl, o[d][i4 * 4 + 1] * rl, o[d][i4 * 4 + 2] * rl, o[d][i4 * 4 + 3] * rl);
#undef MLA_GLOAD
#undef MLA_SSTORE
#undef MLA_SUBSTEP
}

DEVI void l1_prep_phase(const Params& p) {
  const h16* p1 = (const h16*)(p.ws + OFF_P1);
  h16* cqn = (h16*)(p.ws + OFF_CQN);
  h16* ckvn = (h16*)(p.ws + OFF_CKVN);
  h16* kr = (h16*)(p.ws + OFF_KR);
  h16* cat = (h16*)(p.ws + OFF_CAT);
  const int tid_ = tidx(); const int lane = tid_ & 63, wid = tid_ >> 6;
  for (int row = blockIdx.x * 8 + wid; row < TA; row += gridDim.x * 8) {
    const h16* pr = p1 + (size_t)row * 2048;
    const bool lat = row < TL;
    {
      const h16x8 v = *(const h16x8*)(pr + 1280 + lane * 8);
      float f[8], ss = 0.f;
#pragma unroll
      for (int e = 0; e < 8; ++e) { f[e] = (float)v[e]; ss += f[e] * f[e]; }
      ss = wave_sum(ss);
      const float rstd = rsqrtf(ss * (1.0f / 512.0f) + 1e-6f);
      h16x8 o;
#pragma unroll
      for (int e = 0; e < 8; ++e) o[e] = (h16)(f[e] * rstd * p.mla_gkv[lane * 8 + e]);
      *(h16x8*)(ckvn + (size_t)row * 512 + lane * 8) = o;
    }
    {
      const float xv = (float)pr[1792 + lane];
      const float xo = __shfl_xor(xv, 16);
      float outv = xv;
      int b, key;
      if (lat) {
        const int t = row & 4095;
        b = row >> 12; key = 256 + t;
        const int fi = lane & 15;
        const int pos = (lane < 32) ? (t >> 6) : (t & 63);
        const float inv = fexp2(-(float)fi * (13.287712379549449f / 16.0f));
        const float rev = (float)pos * inv * 0.15915494309189535f;
        const float cs = cos_rev(rev), sn = sin_rev(rev);
        outv = (lane & 16) ? (xo * sn + xv * cs) : (xv * cs - xo * sn);
      } else {
        b = (row - TL) >> 8; key = (row - TL) & 255;
      }
      kr[((size_t)b * 4352 + key) * 64 + lane] = (h16)outv;
    }
    if (lat) {
      {
        float f[12], ss = 0.f;
#pragma unroll
        for (int i = 0; i < 3; ++i) {
          const h16x4 v = *(const h16x4*)(pr + 512 + (i * 64 + lane) * 4);
#pragma unroll
          for (int e = 0; e < 4; ++e) { f[i * 4 + e] = (float)v[e]; ss += f[i * 4 + e] * f[i * 4 + e]; }
        }
        ss = wave_sum(ss);
        const float rstd = rsqrtf(ss * (1.0f / 768.0f) + 1e-6f);
#pragma unroll
        for (int i = 0; i < 3; ++i) {
          const int col = (i * 64 + lane) * 4;
          store_h4(cqn + (size_t)row * 768 + col, f[i * 4 + 0] * rstd * p.mla_gq[col + 0], f[i * 4 + 1] * rstd * p.mla_gq[col + 1],
                   f[i * 4 + 2] * rstd * p.mla_gq[col + 2], f[i * 4 + 3] * rstd * p.mla_gq[col + 3]);
        }
      }
      {
        const int t = row & 4095;
        const int grp = lane >> 4;
        const int hw = 1 << grp;
        const int lo = max(t - hw, 0), hi = min(t + hw, 4096);
        float acc[8];
#pragma unroll
        for (int e = 0; e < 8; ++e) acc[e] = 0.f;
        const h16* base = p1 + (size_t)(row - t) * 2048 + lane * 8;
        for (int tt = lo; tt < hi; ++tt) {
          const h16x8 v = *(const h16x8*)(base + (size_t)tt * 2048);
#pragma unroll
          for (int e = 0; e < 8; ++e) acc[e] += (float)v[e];
        }
        const h16x8 self = *(const h16x8*)(pr + lane * 8);
        const float rc = 1.0f / (float)(hi - lo);
        h16x8 o;
#pragma unroll
        for (int e = 0; e < 8; ++e) o[e] = (h16)(acc[e] * rc - (float)self[e]);
        *(h16x8*)(cat + (size_t)row * 2048 + lane * 8) = o;
      }
    }
  }
}

#define XB_TMO      128
#define XB_XCNT(j)  (256  + 64 * (j))
#define XB_XSUB(j)  (1280 + 64 * (j))
#define XB_XGEN(j)  (2304 + 64 * (j))
#define XB_TOP      3328
#define XB_TOPGEN   3392
#define XCD_BAR_WORDS 3456
#define XB_SPIN_CAP (1u << 20)
DEVI unsigned xb_ld(unsigned* p) { return __hip_atomic_load(p, __ATOMIC_RELAXED, __HIP_MEMORY_SCOPE_AGENT); }
DEVI unsigned xb_add(unsigned* p, unsigned v) { return __hip_atomic_fetch_add(p, v, __ATOMIC_RELAXED, __HIP_MEMORY_SCOPE_AGENT); }
DEVI unsigned xb_xcc_id() { return (unsigned)__builtin_amdgcn_s_getreg((3 << 11) | 20) & 0xFu; }
#define XB_SPIN(cond, bar) do { unsigned _sp = 0; while (cond) { __builtin_amdgcn_s_sleep(0); \
    if ((++_sp & 255u) == 0u) { if (xb_ld(&(bar)[XB_TMO])) break; if (_sp > XB_SPIN_CAP) { atomicAdd(&(bar)[XB_TMO], 1u); break; } } } } while (0)
struct XcdBarrier { unsigned* bar; unsigned x; volatile __attribute__((address_space(3))) unsigned* st; };
DEVI XcdBarrier xcd_barrier_post(unsigned* bar, volatile __attribute__((address_space(3))) unsigned* st) {
  XcdBarrier b; b.bar = bar; b.x = xb_xcc_id(); b.st = st;
  if (threadIdx.x == 0) (void)xb_add(&bar[XB_XCNT(b.x)], 1u);
  return b;
}
DEVI void xcd_barrier_complete(unsigned* bar, unsigned x, unsigned& nloc, unsigned& nx) {
  const unsigned G = gridDim.x * gridDim.y * gridDim.z;
  unsigned sum, cnt, mine, sp = 0u;
  for (;;) {
    sum = 0u; cnt = 0u; mine = 0u;
#pragma unroll
    for (unsigned j = 0; j < 16; ++j) { const unsigned c = xb_ld(&bar[XB_XCNT(j)]); sum += c; cnt += (c > 0u) ? 1u : 0u; mine = (j == x) ? c : mine; }
    if (sum == G) break;
    __builtin_amdgcn_s_sleep(1);
    if ((++sp & 255u) == 0u) { if (xb_ld(&bar[XB_TMO])) break; if (sp > XB_SPIN_CAP) { atomicAdd(&bar[XB_TMO], 1u); break; } }
  }
  nloc = mine > 0u ? mine : 1u; nx = cnt > 0u ? cnt : 1u;
}
DEVI void xcd_barrier(const XcdBarrier& b) {
  asm volatile("s_waitcnt vmcnt(0)" ::: "memory");
  __syncthreads();
  if (threadIdx.x == 0) {
    unsigned* bar = b.bar;
    __builtin_amdgcn_s_waitcnt(0);
    unsigned nloc = b.st[0], nx = b.st[1];
    if (nloc == 0u) { xcd_barrier_complete(bar, b.x, nloc, nx); b.st[0] = nloc; b.st[1] = nx; }
    const unsigned old = xb_add(&bar[XB_XSUB(b.x)], 1u);
    const unsigned gen = old / nloc;
    if (old + 1u == (gen + 1u) * nloc) {
      __builtin_amdgcn_fence(__ATOMIC_RELEASE, "agent");
      asm volatile("s_waitcnt vmcnt(0)" ::: "memory");
      const unsigned og = xb_add(&bar[XB_TOP], 1u);
      const unsigned tg = og / nx;
      if (og + 1u == (tg + 1u) * nx) xb_add(&bar[XB_TOPGEN], 1u);
      else XB_SPIN(xb_ld(&bar[XB_TOPGEN]) == tg, bar);
      __builtin_amdgcn_fence(__ATOMIC_ACQUIRE, "agent");
      xb_add(&bar[XB_XGEN(b.x)], 1u);
      asm volatile("s_waitcnt vmcnt(0)" ::: "memory");
    } else {
      XB_SPIN(xb_ld(&bar[XB_XGEN(b.x)]) == gen, bar);
      __builtin_amdgcn_fence(__ATOMIC_ACQUIRE, "agent");
      asm volatile("s_waitcnt vmcnt(0)" ::: "memory");
    }
  }
  __syncthreads();
}

DEVI void run_phase(const Params& pin, int ph, h16* smem, bool dummy = false) {
  Params p = pin;
  asm volatile("" : "+s"(p.ws));
  char* ws = p.ws;
  float* mod = (float*)(ws + OFF_MOD);
  h16* xres = (h16*)(ws + OFF_XRES);
  h16* xout = xres;
  h16* hbuf = (h16*)(ws + OFF_H);
  h16* cat = (h16*)(ws + OFF_CAT);
  h16* act = (h16*)(ws + OFF_BIG);
  switch (ph) {
    case 0: phase0(p, (float*)smem); break;
    case 1: norm_mod_phase(p.x, p.ctx, TA, p.norm1_g, mod, 0, 1, hbuf); break;
    case 2: {
      EpiG1 e{(h16*)(ws + OFF_Q0), (h16*)(ws + OFF_K0), (h16*)(ws + OFF_VT0), (h16*)(ws + OFF_VCT0), (h16*)(ws + OFF_UCT), (h16*)(ws + OFF_UCTC)};
      run_gemm(smem, hbuf, (const h16*)(ws + OFF_WT_IN_AB), TA, 5632, 2048, e);
    } break;
    case 3: {
#ifdef DFT_PROBE
      const bool do_dft = true, do_na = !dummy;
#else
      const bool do_dft = !dummy, do_na = true;
#endif
      if (do_dft) {
        EpiDft e{cat, 0.0013810679320049757f, 0, 1};
        run_gemm(smem, (const h16*)(ws + OFF_DFTA), (const h16*)(ws + OFF_UCT), 2304, 2048, 8192, e);
      }
      if (do_dft) {
        EpiDft e{cat, 0.005524271728019903f, 1, 0};
        run_gemm(smem, (const h16*)(ws + OFF_DFTAC), (const h16*)(ws + OFF_UCTC), 256, 2048, 512, e, (int)((lbid() + gridDim.x - (128 % gridDim.x)) % gridDim.x));
      }
      const int xcd = lbid() & 7;
      int* ctr = (int*)(ws + OFF_CTR) + xcd * 8;
      int* su = (int*)smem;
      const int tid = tidx();
      for (; do_na;) {
        __syncthreads();
        if (tid == 0) su[0] = atomicAdd(ctr, 1);
        __syncthreads();
        const int u = su[0];
        if (u >= 204) break;
        const int bu = u < 192 ? (xcd * 192 + u) : (1536 + xcd * 12 + (u - 192));
#ifdef NA_PROBE_VAR
        if (dummy) na_block_unit<NA_PROBE_VAR>(p, bu, smem + 64); else
#endif
        na_block_unit<0>(p, bu, smem + 64);
      }
    } break;
    case 4: {
      EpiRes<float> e{p.x, p.ctx, xout, mod + 2 * 2048};
      run_gemm(smem, cat, (const h16*)(ws + OFF_WT_OUT_AB), TA, 2048, 2048, e);
      if (!dummy && gridDim.x == 256 && lbid() >= 32) prep_ffn_gu(p, 0, (float*)smem, lbid() - 32, 224);
      else if (!dummy && gridDim.x != 256) prep_ffn_gu(p, 0, (float*)smem, lbid(), (int)gridDim.x);
    } break;
    case 5: norm_mod_phase(xres, xres + (size_t)TL * 2048, TA, p.norm2_g, mod, 3, 4, hbuf); break;
    case 6: {
      EpiGU e{act};
      run_gemm(smem, hbuf, (const h16*)(ws + OFF_WT_GU0), TA, 11264, 2048, e);
      if (!dummy && gridDim.x == 256 && lbid() >= 176) prep_ffn_dn(p, 0, (float*)smem, lbid() - 176, 80);
      else if (!dummy && gridDim.x != 256) prep_ffn_dn(p, 0, (float*)smem, lbid(), (int)gridDim.x);
    } break;
    case 7: {
      EpiRes<h16> e{xres, xres + (size_t)TL * 2048, xout, mod + 5 * 2048};
      if (gridDim.x == 256) {
        run_gemm(smem, act, (const h16*)(ws + OFF_WT_D0), TL, 2048, DFF, e);
        if (!dummy) {
          const int c = lbid(), sp = c >> 5;
          if (c < 128) {
            EpiPartial ep{(float*)cat + (size_t)sp * TC * 2048};
            run_gemm(smem, act + (size_t)TL * DFF + sp * 1408, (const h16*)(ws + OFF_WT_D0) + sp * 1408, TC, 2048, 1408, ep, c & 31, DFF);
          } else {
            prep_layer1(p, (float*)smem, c - 128, 128, false);
          }
        }
      } else {
        run_gemm(smem, act, (const h16*)(ws + OFF_WT_D0), TA, 2048, DFF, e);
        if (!dummy) prep_layer1(p, (float*)smem, lbid(), (int)gridDim.x, false);
      }
    } break;
    case 8:
      if (gridDim.x == 256) {
        norm_mod_phase(xres, xres + (size_t)TL * 2048, TL, p.norm1_g + 2048, mod + 5 * 12288, 0, 1, hbuf);
        ctx_norm_partial_phase(xres + (size_t)TL * 2048, p.norm1_g + 2048, mod + 5 * 12288, 0, 1, hbuf, (const float*)cat, 4, mod + 4 * 12288 + 5 * 2048);
      } else norm_mod_phase(xres, xres + (size_t)TL * 2048, TA, p.norm1_g + 2048, mod + 5 * 12288, 0, 1, hbuf);
      break;
    case 9: {
      EpiStore e{(h16*)(ws + OFF_P1), 2048};
      run_gemm(smem, hbuf, (const h16*)(ws + OFF_WT_IN_CD), TA, 2048, 2048, e);
      if (!dummy && gridDim.x == 256 && lbid() >= 32) prep_ffn(p, 1, (float*)smem, lbid() - 32, 224);
      else if (!dummy && gridDim.x != 256) prep_ffn(p, 1, (float*)smem, lbid(), (int)gridDim.x);
    } break;
    case 10: l1_prep_phase(p); break;
    case 11: {
      EpiQ1 eq{(h16*)(ws + OFF_Q1)};
      run_gemm(smem, (const h16*)(ws + OFF_CQN), (const h16*)(ws + OFF_WT_UQ), TL, 2304, 768, eq);
      EpiKV1 ek{(h16*)(ws + OFF_KN), (h16*)(ws + OFF_VT1)};
      run_gemm(smem, (const h16*)(ws + OFF_CKVN), (const h16*)(ws + OFF_WT_UKV), TA, 3072, 512, ek, (int)((lbid() + gridDim.x - 64) % gridDim.x));
    } break;
    case 12: {
      if (gridDim.x == 256) {
        const int xcd = lbid() & 7, slot = lbid() >> 3;
        for (int i = 0; i < 3; ++i) mla_unit<0>(p, (xcd * 6 + i * 2 + (slot >> 4)) * 16 + (slot & 15), smem);
      } else {
        for (int u = lbid(); u < 768; u += gridDim.x) mla_unit<0>(p, u, smem);
      }
    } break;
#ifdef MLA_PROBE_VAR
    case 112: {
      const int xcd = lbid() & 7, slot = lbid() >> 3;
      for (int i = 0; i < 3; ++i) mla_unit<MLA_PROBE_VAR>(p, (xcd * 6 + i * 2 + (slot >> 4)) * 16 + (slot & 15), smem);
    } break;
#endif
    case 13: {
      EpiRes<h16> e{xres, xres + (size_t)TL * 2048, xout, mod + 5 * 12288 + 2 * 2048};
      run_gemm(smem, cat, (const h16*)(ws + OFF_WT_OUT_CD), TL, 2048, 2048, e);
    } break;
    case 14: norm_mod_phase(xres, xres + (size_t)TL * 2048, TL, p.norm2_g + 2048, mod + 5 * 12288, 3, 4, hbuf); break;
    case 15: {
      EpiGU e{act};
      run_gemm(smem, hbuf, (const h16*)(ws + OFF_WT_GU1), TL, 11264, 2048, e);
    } break;
    case 16: {
      EpiRes<h16> e{xres, xres + (size_t)TL * 2048, xout, mod + 5 * 12288 + 5 * 2048};
      run_gemm(smem, act, (const h16*)(ws + OFF_WT_D1), TL, 2048, DFF, e);
    } break;
    case 17: final_norm_phase(xres, p.final_g, p.out); break;
    default: break;
  }
}

__global__ void __launch_bounds__(512, 2) mega_kernel(Params p, int ph_lo, int ph_hi) {
  extern __shared__ __attribute__((aligned(16))) unsigned char shm[];
  h16* smem = (h16*)shm;
  unsigned* barw = (unsigned*)(p.ws + OFF_BAR);
  if (threadIdx.x == 0) {
    const unsigned x = xb_xcc_id();
    const unsigned r = xb_add(&barw[XCD_BAR_WORDS + (x & 15u)], 1u);
    g_sh[0] = make_uint4(0u, 0u, 0u, 0u);
    g_sh[1] = make_uint4(blockIdx.x, r, x, 0u);
  }
  __syncthreads();
  const XcdBarrier xb = xcd_barrier_post(barw, (volatile __attribute__((address_space(3))) unsigned*)&g_sh[0]);
#ifdef ONLY_PHASE
  run_phase(p, ONLY_PHASE, smem);
#else
#pragma unroll
  for (int ph = 0; ph < NPHASE; ++ph) {
    if (ph >= ph_lo && ph < ph_hi) {
      run_phase(p, ph, smem);
      if ((REPEAT_MASK >> ph) & 1) {
        xcd_barrier(xb);
        if (ph == 3) { if (blockIdx.x == 0 && threadIdx.x < 8) ((int*)(p.ws + OFF_CTR))[threadIdx.x * 8] = 0; xcd_barrier(xb); }
#ifdef MLA_PROBE_VAR
        run_phase(p, ph == 12 ? 112 : ph, smem, true);
#else
        run_phase(p, ph, smem, true);
#endif
      }
      if (ph + 1 < ph_hi) { if (ph_hi > 1000) cg::this_grid().sync(); else xcd_barrier(xb); }
      if (ph == 0) {
        if (threadIdx.x == 0) {
          bool ok = (gridDim.x == 256);
#pragma unroll
          for (unsigned j = 0; j < 16; ++j) { const unsigned cnt = xb_ld(&barw[XB_XCNT(j)]); ok = ok && (cnt == (j < 8 ? 32u : 0u)); }
          const uint4 me = g_sh[1];
          if (ok && me.z < 8u && me.y < 32u) g_sh[1].x = me.y * 8u + me.z;
        }
        __syncthreads();
      }
    }
  }
#ifdef EXTRA_SYNCS
  for (int i = 0; i < EXTRA_SYNCS; ++i) xcd_barrier(xb);
#endif
#endif
}

extern "C" void kernel_launch(void* const* d_in, const int* in_sizes, int n_in, void* d_out, int out_size, void* d_ws,
                              size_t ws_size, hipStream_t stream) {
  if (ws_size < WS_NEEDED) {
    fprintf(stderr, "workspace too small: have %zu need %zu\n", ws_size, (size_t)WS_NEEDED);
    return;
  }
  static int grid_blocks = 0;
  if (!grid_blocks) {
    int dev = 0, cus = 0, per_cu = 0;
    (void)hipGetDevice(&dev);
    (void)hipDeviceGetAttribute(&cus, hipDeviceAttributeMultiprocessorCount, dev);
    (void)hipFuncSetAttribute((const void*)mega_kernel, hipFuncAttributeMaxDynamicSharedMemorySize, SMEM_BYTES);
    (void)hipOccupancyMaxActiveBlocksPerMultiprocessor(&per_cu, mega_kernel, NTHR, SMEM_BYTES);
    if (per_cu > 1) per_cu = 1;
    grid_blocks = cus * per_cu;
  }
  Params p{};
  const float** pf = (const float**)&p;
  for (int i = 0; i < 24; ++i) pf[i] = (const float*)d_in[i];
  p.out = (float*)d_out;
  p.ws = (char*)d_ws;
  int lo = 0, hi = NPHASE;
  (void)hipMemsetAsync((char*)d_ws + OFF_BAR, 0, BAR_BYTES, stream);
  void* args[] = {&p, &lo, &hi};
  hipError_t e = hipLaunchCooperativeKernel((void*)mega_kernel, dim3(grid_blocks), dim3(NTHR), args, SMEM_BYTES, stream);
  if (e != hipSuccess) fprintf(stderr, "cooperative launch failed: %s (grid %d)\n", hipGetErrorString(e), grid_blocks);
}
```

```cpp
#include <hip/hip_runtime.h>
#include <hip/hip_cooperative_groups.h>
#include <cstdio>
#include <cstdint>
namespace cg = cooperative_groups;

typedef _Float16 h16;
typedef _Float16 h16x8 __attribute__((ext_vector_type(8)));
typedef _Float16 h16x4 __attribute__((ext_vector_type(4)));
typedef float f32x16 __attribute__((ext_vector_type(16)));
typedef float f32x4 __attribute__((ext_vector_type(4)));

#define DEVI __device__ __forceinline__

#ifndef SINGLE_LAUNCH
#define SINGLE_LAUNCH 1
#endif
#ifndef REPEAT_MASK
#define REPEAT_MASK 0x0
#endif

constexpr int DM = 2048;
constexpr int TL = 16384;
constexpr int TC = 1024;
constexpr int TA = 17408;
constexpr int DFF = 5632;
constexpr int NPHASE = 18;

constexpr size_t SZ_WT_IN_AB = (size_t)5632 * 2048 * 2;
constexpr size_t SZ_WT_OUT = (size_t)2048 * 2048 * 2;
constexpr size_t SZ_WT_GU = (size_t)11264 * 2048 * 2;
constexpr size_t SZ_WT_D = (size_t)2048 * 5632 * 2;
constexpr size_t SZ_WT_IN_CD = (size_t)2048 * 2048 * 2;
constexpr size_t SZ_WT_UQ = (size_t)2304 * 768 * 2;
constexpr size_t SZ_WT_UKV = (size_t)3072 * 512 * 2;
constexpr size_t SZ_DFTA = (size_t)4096 * 8192 * 2;
constexpr size_t SZ_DFTAC = (size_t)256 * 512 * 2;
constexpr size_t SZ_MOD = (size_t)2 * 5 * 12288 * 4;
constexpr size_t SZ_XRES = (size_t)TA * 2048 * 4;
constexpr size_t SZ_H = (size_t)TA * 2048 * 2;
constexpr size_t SZ_CAT = (size_t)TA * 2048 * 2;
constexpr size_t SZ_BIG = (size_t)TA * 5632 * 2;

constexpr size_t OFF_WT_IN_AB = 0;
constexpr size_t OFF_WT_OUT_AB = OFF_WT_IN_AB + SZ_WT_IN_AB;
constexpr size_t OFF_WT_GU0 = OFF_WT_OUT_AB + SZ_WT_OUT;
constexpr size_t OFF_WT_GU1 = OFF_WT_GU0 + SZ_WT_GU;
constexpr size_t OFF_WT_D0 = OFF_WT_GU1 + SZ_WT_GU;
constexpr size_t OFF_WT_D1 = OFF_WT_D0 + SZ_WT_D;
constexpr size_t OFF_WT_IN_CD = OFF_WT_D1 + SZ_WT_D;
constexpr size_t OFF_WT_UQ = OFF_WT_IN_CD + SZ_WT_IN_CD;
constexpr size_t OFF_WT_UKV = OFF_WT_UQ + SZ_WT_UQ;
constexpr size_t OFF_WT_OUT_CD = OFF_WT_UKV + SZ_WT_UKV;
constexpr size_t OFF_DFTA = OFF_WT_OUT_CD + SZ_WT_OUT;
constexpr size_t OFF_DFTAC = OFF_DFTA + SZ_DFTA;
constexpr size_t OFF_MOD = OFF_DFTAC + SZ_DFTAC;
constexpr size_t OFF_XRES = OFF_MOD + SZ_MOD;
constexpr size_t OFF_H = OFF_XRES + SZ_XRES;
constexpr size_t OFF_CAT = OFF_H + SZ_H;
constexpr size_t OFF_BIG = OFF_CAT + SZ_CAT;
constexpr size_t OFF_CTR = OFF_BIG + SZ_BIG;
constexpr size_t OFF_BAR = OFF_CTR + 256;
constexpr size_t BAR_BYTES = 16384;
constexpr size_t WS_NEEDED = OFF_BAR + BAR_BYTES;

constexpr size_t OFF_Q0 = OFF_BIG;
constexpr size_t OFF_K0 = OFF_Q0 + (size_t)TA * 1536 * 2;
constexpr size_t OFF_VT0 = OFF_K0 + (size_t)TA * 1536 * 2;
constexpr size_t OFF_VCT0 = OFF_VT0 + (size_t)48 * 128 * 4096 * 2;
constexpr size_t OFF_UCT = OFF_VCT0 + (size_t)48 * 128 * 256 * 2;
constexpr size_t OFF_UCTC = OFF_UCT + (size_t)2048 * 8192 * 2;
static_assert(OFF_UCTC + (size_t)2048 * 512 * 2 <= OFF_BIG + SZ_BIG, "layer0 scratch overflow");
constexpr size_t OFF_P1 = OFF_BIG;
constexpr size_t OFF_CQN = OFF_P1 + (size_t)TA * 2048 * 2;
constexpr size_t OFF_CKVN = OFF_CQN + (size_t)TL * 768 * 2;
constexpr size_t OFF_KR = OFF_CKVN + (size_t)TA * 512 * 2;
constexpr size_t OFF_Q1 = OFF_KR + (size_t)4 * 4352 * 64 * 2;
static_assert(OFF_Q1 + (size_t)TL * 2304 * 2 <= OFF_BIG + SZ_BIG, "layer1 scratch overflow");
constexpr size_t OFF_KN = OFF_H;
constexpr size_t OFF_VT1 = OFF_DFTA;
static_assert((size_t)4 * 4352 * 1536 * 2 <= SZ_H, "kn alias");
static_assert((size_t)48 * 128 * 4352 * 2 <= SZ_DFTA, "vt1 alias");

struct Params {
  const float *x, *c, *ctx, *c_ctx, *w_mod, *b_mod, *norm1_g, *norm2_g, *w_in_ab, *w_four, *na_rpb, *w_out_ab;
  const float *w_in_cd, *w_pool, *pool_scale, *mla_gq, *mla_gkv, *w_uq, *w_ukv, *w_out_cd;
  const float *w_ffn_gate, *w_ffn_up, *w_ffn_down, *final_g;
  float* out;
  char* ws;
};

constexpr int NTHR = 512;
constexpr int SMEM_BYTES = 147456;

__shared__ uint4 g_sh[2];
__device__ __forceinline__ int lbid() { return (int)g_sh[1].x; }
DEVI f32x16 mfma32(h16x8 a, h16x8 b, f32x16 c) { return __builtin_amdgcn_mfma_f32_32x32x16_f16(a, b, c, 0, 0, 0); }
DEVI f32x4 mfma16(h16x8 a, h16x8 b, f32x4 c) { return __builtin_amdgcn_mfma_f32_16x16x32_f16(a, b, c, 0, 0, 0); }
DEVI int tidx() { int t = threadIdx.x; asm volatile("" : "+v"(t)); return t; }
DEVI float wave_sum(float v) {
#pragma unroll
  for (int o = 32; o >= 1; o >>= 1) v += __shfl_xor(v, o);
  return v;
}
DEVI float fexp2(float x) { return __builtin_amdgcn_exp2f(x); }
DEVI float cos_rev(float r) { return __builtin_amdgcn_cosf(r); }
DEVI float sin_rev(float r) { return __builtin_amdgcn_sinf(r); }
DEVI float silu_f(float v) { return v * __builtin_amdgcn_rcpf(1.0f + __builtin_amdgcn_exp2f(-1.4426950408889634f * v)); }
DEVI float4 ld4f(const float* p) { return *(const float4*)p; }
DEVI float4 ldnt4(const float* p) { const f32x4 v = __builtin_nontemporal_load((const f32x4*)p); return make_float4(v[0], v[1], v[2], v[3]); }
DEVI void stnt4(float* p, const float4& v) { f32x4 t; t[0] = v.x; t[1] = v.y; t[2] = v.z; t[3] = v.w; __builtin_nontemporal_store(t, (f32x4*)p); }
DEVI float4 ld4f(const h16* p) { const h16x4 v = *(const h16x4*)p; return make_float4((float)v[0], (float)v[1], (float)v[2], (float)v[3]); }
DEVI void store_h8(h16* dst, const f32x4& a, const f32x4& b, float sc = 1.0f) {
  h16x8 v;
#pragma unroll
  for (int j = 0; j < 4; ++j) { v[j] = (h16)(a[j] * sc); v[4 + j] = (h16)(b[j] * sc); }
  *(h16x8*)dst = v;
}
DEVI void store_h4(h16* dst, float a, float b, float c, float d) {
  h16x4 v;
  v[0] = (h16)a; v[1] = (h16)b; v[2] = (h16)c; v[3] = (h16)d;
  *(h16x4*)dst = v;
}

#define LAS __attribute__((address_space(3)))
namespace g8 {
constexpr int BM = 256, BK = 64, HALF = 128, HTB = HALF * BK * 2, NXCD = 8, WGM = 8;
DEVI int lds_byte(int r, int c) { const int st = (r >> 4) * 2 + (c >> 5), rr = r & 15, cc = c & 31, ob = rr * 64 + cc * 2; return st * 1024 + (ob ^ (((ob >> 9) & 1) << 5)); }
DEVI void stage_rc(int b, int& R, int& C) { const int st = b / 1024, sb = b % 1024, swz = sb ^ (((sb >> 9) & 1) << 5); R = (st >> 1) * 16 + swz / 64; C = (st & 1) * 32 + (swz % 64) / 2; }
DEVI int perm32(int rho) { const int n = rho >> 4, i = rho & 15; return 8 * (i >> 2) + 4 * n + (i & 3); }
struct Unit { int pm, pn; };
struct Gemm { const h16* A; const h16* Bt; int M, N, K, ld; };
struct StaticOrder {
  int nM, nN, nwg, G, c;
  DEVI void init(int M, int N, int G_, int c_) { nM = M / BM; nN = N / BM; nwg = nM * nN; G = G_; c = c_; }
  DEVI bool next(int i, Unit& u) const {
    if (c < 0) return false;
    const long L = (long)i * G + c; if (L >= nwg) return false;
    int wgid = (int)L; { const int q = nwg / NXCD, r = nwg % NXCD, xcd = wgid % NXCD, off = wgid / NXCD; wgid = (xcd < r ? xcd * (q + 1) : r * (q + 1) + (xcd - r) * q) + off; }
    const int nig = WGM * nN, gid = wgid / nig, fm = gid * WGM, gsz = (nM - fm) < WGM ? (nM - fm) : WGM;
    u.pm = fm + ((wgid % nig) % gsz); u.pn = (wgid % nig) / gsz; return true;
  }
};

template <class Epi>
DEVI void gemm_phase(LAS unsigned char* lds, const Gemm g, const StaticOrder& S, const Epi& E) {
  const int tid = tidx(), wid = __builtin_amdgcn_readfirstlane(tid >> 6), lane = tid & 63, wr = wid >> 2, wc = wid & 3, fr = lane & 15, fq = lane >> 4;
  const int K = g.K, nt = K / BK;
  unsigned voffA[2], voffB[2];
#pragma unroll
  for (int i = 0; i < 2; ++i) { int R, C; stage_rc(tid * 16 + i * 8192, R, C); const int Rb = Epi::PERM ? ((R & ~31) + perm32(R & 31)) : R;
    voffA[i] = (unsigned)(R * g.ld + C) * 2u; voffB[i] = (unsigned)(Rb * g.ld + C) * 2u; }
  const size_t kstep = (size_t)(BK * 2);
  const size_t hstep = (size_t)HALF * g.ld * 2;
  const size_t tstep = 2 * hstep;
  const unsigned ldsw = (unsigned)wid * 1024u;
  const int aoff = lds_byte(wr * 64 + fr, fq * 8), boff = lds_byte(wc * 32 + fr, fq * 8);
#define G8_SA(b, h) (((b) * 2 + (h)) * HTB)
#define G8_SB(b, h) ((4 + (b) * 2 + (h)) * HTB)
#define G8_STAGE(bufoff, gbase, voff) do { _Pragma("unroll") for (int _i = 0; _i < 2; ++_i) \
    __builtin_amdgcn_global_load_lds((const unsigned*)((const char*)(gbase) + (voff)[_i]), (LAS unsigned*)(lds + (bufoff) + ldsw + _i * 8192), 16, 0, 0); } while (0)
#define G8_LDA(dst, b, h) do { _Pragma("unroll") for (int m = 0; m < 4; ++m) _Pragma("unroll") for (int k = 0; k < 2; ++k) dst[m][k] = *(const LAS h16x8*)(lds + G8_SA(b, h) + aoff + m * 2048 + k * 1024); } while (0)
#define G8_LDB(dst, b, h) do { _Pragma("unroll") for (int n = 0; n < 2; ++n) _Pragma("unroll") for (int k = 0; k < 2; ++k) dst[n][k] = *(const LAS h16x8*)(lds + G8_SB(b, h) + boff + n * 2048 + k * 1024); } while (0)
#define G8_MMA(ai, bj, At, Bt) do { __builtin_amdgcn_s_setprio(1); _Pragma("unroll") for (int m = 0; m < 4; ++m) _Pragma("unroll") for (int n = 0; n < 2; ++n) _Pragma("unroll") for (int k = 0; k < 2; ++k) \
    acc[ai][bj][m][n] = __builtin_amdgcn_mfma_f32_16x16x32_f16(Bt[n][k], At[m][k], acc[ai][bj][m][n], 0, 0, 0); __builtin_amdgcn_s_setprio(0); } while (0)
#define G8_WAIT_V(n) asm volatile("s_waitcnt vmcnt(" #n ")" ::: "memory")
#define G8_WAIT_L(n) asm volatile("s_waitcnt lgkmcnt(" #n ")" ::: "memory")
#define G8_BAR __builtin_amdgcn_s_barrier()
#define G8_SCHED __builtin_amdgcn_sched_barrier(0)
  Unit cur, nxt; int ui = 0;
  if (!S.next(0, cur)) return;
  f32x4 acc[2][2][4][2];
#pragma unroll
  for (int a = 0; a < 2; ++a)
#pragma unroll
    for (int b = 0; b < 2; ++b)
#pragma unroll
      for (int m = 0; m < 4; ++m)
#pragma unroll
        for (int n = 0; n < 2; ++n) acc[a][b][m][n] = (f32x4){0.f, 0.f, 0.f, 0.f};
  h16x8 At[4][2], B0[2][2], B1[2][2];
  const char* cA = (const char*)g.A + (size_t)cur.pm * tstep; const char* cB = (const char*)g.Bt + (size_t)cur.pn * tstep;
  G8_STAGE(G8_SB(0, 0), cB, voffB); G8_STAGE(G8_SA(0, 0), cA, voffA); G8_STAGE(G8_SB(0, 1), cB + hstep, voffB); G8_STAGE(G8_SA(0, 1), cA + hstep, voffA);
  if (wr == 1) G8_BAR;
  G8_WAIT_V(4); G8_BAR;
  G8_STAGE(G8_SB(1, 0), cB + kstep, voffB); G8_STAGE(G8_SA(1, 0), cA + kstep, voffA); G8_STAGE(G8_SB(1, 1), cB + hstep + kstep, voffB);
  G8_WAIT_V(6); G8_BAR;
  for (;;) {
    const bool has_next = S.next(ui + 1, nxt);
    const char* nA = has_next ? (const char*)g.A + (size_t)nxt.pm * tstep : cA; const char* nB = has_next ? (const char*)g.Bt + (size_t)nxt.pn * tstep : cB;
    for (int t = 0; t < nt; t += 2) {
      const bool last = (t == nt - 2);
      const char* a1 = cA + (size_t)(t + 1) * kstep;
      const char* a2 = last ? nA : cA + (size_t)(t + 2) * kstep; const char* b2 = last ? nB : cB + (size_t)(t + 2) * kstep;
      const char* a3 = a2 + kstep; const char* b3 = b2 + kstep;
      G8_LDB(B0, 0, 0); G8_SCHED; G8_LDA(At, 0, 0); G8_STAGE(G8_SA(1, 1), a1 + hstep, voffA);
      G8_WAIT_L(8); G8_BAR; G8_WAIT_L(0); G8_MMA(0, 0, At, B0); G8_BAR; G8_SCHED;
      G8_LDB(B1, 0, 1); G8_STAGE(G8_SB(0, 0), b2, voffB);
      G8_BAR; G8_WAIT_L(0); G8_MMA(0, 1, At, B1); G8_BAR;
      G8_LDA(At, 0, 1); G8_STAGE(G8_SA(0, 0), a2, voffA);
      G8_BAR; G8_WAIT_L(0); G8_MMA(1, 0, At, B0); G8_BAR; G8_SCHED;
      G8_STAGE(G8_SB(0, 1), b2 + hstep, voffB);
      G8_WAIT_V(6); G8_BAR; G8_MMA(1, 1, At, B1); G8_BAR;
      G8_LDB(B0, 1, 0); G8_SCHED; G8_LDA(At, 1, 0); G8_STAGE(G8_SA(0, 1), a2 + hstep, voffA);
      G8_WAIT_L(8); G8_BAR; G8_WAIT_L(0); G8_MMA(0, 0, At, B0); G8_BAR; G8_SCHED;
      G8_LDB(B1, 1, 1); G8_STAGE(G8_SB(1, 0), b3, voffB);
      G8_BAR; G8_WAIT_L(0); G8_MMA(0, 1, At, B1); G8_BAR;
      G8_LDA(At, 1, 1); G8_STAGE(G8_SA(1, 0), a3, voffA);
      G8_BAR; G8_WAIT_L(0); G8_MMA(1, 0, At, B0); G8_BAR; G8_SCHED;
      G8_STAGE(G8_SB(1, 1), b3 + hstep, voffB);
      G8_WAIT_V(6); G8_BAR; G8_MMA(1, 1, At, B1); G8_BAR;
    }
    E(acc, cur, wr, wc, fr, fq);
    if (!has_next) break;
#pragma unroll
    for (int a = 0; a < 2; ++a)
#pragma unroll
      for (int b = 0; b < 2; ++b)
#pragma unroll
        for (int m = 0; m < 4; ++m)
#pragma unroll
          for (int n = 0; n < 2; ++n) acc[a][b][m][n] = (f32x4){0.f, 0.f, 0.f, 0.f};
    cur = nxt; cA = nA; cB = nB; ++ui;
  }
  G8_WAIT_V(0);
  if (wr == 0) G8_BAR;
  G8_BAR;
#undef G8_SA
#undef G8_SB
#undef G8_STAGE
#undef G8_LDA
#undef G8_LDB
#undef G8_MMA
}
}
using g8::Unit;

template <class Epi>
DEVI void run_gemm(h16* smem, const h16* A, const h16* Bt, int M, int N, int K, const Epi& e, int c_override = -2, int ld = 0) {
  g8::Gemm g{A, Bt, M, N, K, ld ? ld : K};
  g8::StaticOrder S;
  S.init(M, N, (int)gridDim.x, c_override == -2 ? lbid() : c_override);
  g8::gemm_phase((LAS unsigned char*)smem, g, S, e);
}

#define E8_FOR                                      \
  _Pragma("unroll") for (int ai = 0; ai < 2; ++ai)   \
  _Pragma("unroll") for (int m = 0; m < 4; ++m)      \
  _Pragma("unroll") for (int bj = 0; bj < 2; ++bj)   \
  _Pragma("unroll") for (int n = 0; n < 2; ++n)
#define E8_ROW (u.pm * 256 + ai * 128 + wr * 64 + m * 16 + fr)
#define E8_COL (u.pn * 256 + bj * 128 + wc * 32 + n * 16 + fq * 4)
#define E8_COLP (u.pn * 256 + bj * 128 + wc * 32 + fq * 8 + n * 4)
typedef const f32x4 (&AccRef)[2][2][4][2];

#define E8P_FOR                                     \
  _Pragma("unroll") for (int ai = 0; ai < 2; ++ai)   \
  _Pragma("unroll") for (int m = 0; m < 4; ++m)      \
  _Pragma("unroll") for (int bj = 0; bj < 2; ++bj)
#define E8P_COL (u.pn * 256 + bj * 128 + wc * 32 + fq * 8)
struct EpiG1 {
  static constexpr bool PERM = true, AFTER_DRAIN = false;
  h16 *q0, *k0, *vT, *vcT, *ucT, *ucTc;
  DEVI void operator()(AccRef acc, const Unit& u, int wr, int wc, int fr, int fq) const {
    const bool isctx = u.pm >= 64;
    E8P_FOR {
      const int row = E8_ROW, col = E8P_COL;
      const f32x4 va = acc[ai][bj][m][0], vb = acc[ai][bj][m][1];
      int b, n_;
      if (!isctx) { b = row >> 12; n_ = row & 4095; } else { b = (row - TL) >> 8; n_ = (row - TL) & 255; }
      if (u.pn < 4) {
        const int g = u.pn, part = bj, mm = col & 127;
        const size_t ld = isctx ? 512 : 8192;
        h16* d = isctx ? ucTc + (size_t)((b * 4 + g) * 128 + mm) * 512 + part * 256 + n_
                       : ucT + (size_t)((b * 4 + g) * 128 + mm) * 8192 + part * 4096 + n_;
#pragma unroll
        for (int j = 0; j < 4; ++j) { d[j * ld] = (h16)va[j]; d[(4 + j) * ld] = (h16)vb[j]; }
      } else if (u.pn < 10) {
        store_h8(q0 + (size_t)row * 1536 + (col - 1024), va, vb);
      } else if (u.pn < 16) {
        store_h8(k0 + (size_t)row * 1536 + (col - 2560), va, vb);
      } else {
        const int c3 = col - 4096, hh = c3 >> 7, dv = c3 & 127;
        const size_t ld = isctx ? 256 : 4096;
        h16* d = isctx ? vcT + (size_t)((b * 12 + hh) * 128 + dv) * 256 + n_
                       : vT + (size_t)((b * 12 + hh) * 128 + dv) * 4096 + n_;
#pragma unroll
        for (int j = 0; j < 4; ++j) { d[j * ld] = (h16)va[j]; d[(4 + j) * ld] = (h16)vb[j]; }
      }
    }
  }
};

struct EpiDft {
  static constexpr bool PERM = true, AFTER_DRAIN = false;
  h16* cat; float scale; int is_ctx; int mirror;
  DEVI void operator()(AccRef acc, const Unit& u, int wr, int wc, int fr, int fq) const {
    E8P_FOR {
      const int row = E8_ROW, col = E8P_COL;
      const f32x4 va = acc[ai][bj][m][0], vb = acc[ai][bj][m][1];
      const int b = col >> 9, g = (col >> 7) & 3, mm = col & 127;
      const size_t rbase = is_ctx ? (size_t)(TL + b * 256) : (size_t)b * 4096;
      if (!mirror || row <= 2048) store_h8(cat + (rbase + row) * 2048 + g * 128 + mm, va, vb, scale);
      if (mirror && row >= 1 && row <= 2047) {
        h16* mr = cat + (rbase + (4096 - row)) * 2048 + g * 128;
        mr[(128 - mm) & 127] = (h16)(va[0] * scale);
#pragma unroll
        for (int j = 1; j < 4; ++j) mr[128 - mm - j] = (h16)(va[j] * scale);
#pragma unroll
        for (int j = 0; j < 4; ++j) mr[124 - mm - j] = (h16)(vb[j] * scale);
      }
    }
  }
};

DEVI void ld8f(const float* p, float (&o)[8]) { const float4 a = *(const float4*)p, b = *(const float4*)(p + 4); o[0] = a.x; o[1] = a.y; o[2] = a.z; o[3] = a.w; o[4] = b.x; o[5] = b.y; o[6] = b.z; o[7] = b.w; }
DEVI void ld8f(const h16* p, float (&o)[8]) { const h16x8 v = *(const h16x8*)p;
#pragma unroll
  for (int i = 0; i < 8; ++i) o[i] = (float)v[i]; }
template <class TS>
struct EpiRes {
  static constexpr bool PERM = true, AFTER_DRAIN = false;
  const TS *src_lat, *src_ctx;
  h16* xres; const float* gate;
  DEVI void operator()(AccRef acc, const Unit& u, int wr, int wc, int fr, int fq) const {
    const int midx = (u.pm < 64) ? (u.pm >> 4) : 4;
    float gt[2][8];
#pragma unroll
    for (int bj = 0; bj < 2; ++bj) ld8f(gate + midx * 12288 + u.pn * 256 + bj * 128 + wc * 32 + fq * 8, gt[bj]);
#pragma unroll
    for (int ai = 0; ai < 2; ++ai)
#pragma unroll
      for (int m = 0; m < 4; ++m)
#pragma unroll
        for (int bj = 0; bj < 2; ++bj) {
          const int row = u.pm * 256 + ai * 128 + wr * 64 + m * 16 + fr;
          const int col = u.pn * 256 + bj * 128 + wc * 32 + fq * 8;
          const f32x4 v0 = acc[ai][bj][m][0], v1 = acc[ai][bj][m][1];
          float sv[8];
          ld8f(u.pm < 64 ? src_lat + (size_t)row * 2048 + col : src_ctx + (size_t)(row - TL) * 2048 + col, sv);
          h16x8 o;
#pragma unroll
          for (int j = 0; j < 4; ++j) { o[j] = (h16)(sv[j] + gt[bj][j] * v0[j]); o[4 + j] = (h16)(sv[4 + j] + gt[bj][4 + j] * v1[j]); }
          *(h16x8*)(xres + (size_t)row * 2048 + col) = o;
        }
  }
};

struct EpiPartial {
  static constexpr bool PERM = false, AFTER_DRAIN = false;
  float* part;
  DEVI void operator()(AccRef acc, const Unit& u, int wr, int wc, int fr, int fq) const {
    E8_FOR {
      const int row = E8_ROW, col = E8_COL;
      *(f32x4*)(part + (size_t)row * 2048 + col) = acc[ai][bj][m][n];
    }
  }
};

struct EpiGU {
  static constexpr bool PERM = true, AFTER_DRAIN = false;
  h16* act;
  DEVI void operator()(AccRef acc, const Unit& u, int wr, int wc, int fr, int fq) const {
#pragma unroll
    for (int ai = 0; ai < 2; ++ai)
#pragma unroll
      for (int m = 0; m < 4; ++m) {
        const int row = u.pm * 256 + ai * 128 + wr * 64 + m * 16 + fr;
        const int ocol = u.pn * 128 + wc * 32 + fq * 8;
        const f32x4 g0 = acc[ai][0][m][0], g1 = acc[ai][0][m][1], u0 = acc[ai][1][m][0], u1 = acc[ai][1][m][1];
        h16x8 o;
#pragma unroll
        for (int j = 0; j < 4; ++j) { o[j] = (h16)(silu_f(g0[j]) * u0[j]); o[4 + j] = (h16)(silu_f(g1[j]) * u1[j]); }
        *(h16x8*)(act + (size_t)row * DFF + ocol) = o;
      }
  }
};

struct EpiStore {
  static constexpr bool PERM = true, AFTER_DRAIN = false;
  h16* dst; int ldd;
  DEVI void operator()(AccRef acc, const Unit& u, int wr, int wc, int fr, int fq) const {
    E8P_FOR {
      const int row = E8_ROW, col = E8P_COL;
      store_h8(dst + (size_t)row * ldd + col, acc[ai][bj][m][0], acc[ai][bj][m][1]);
    }
  }
};

constexpr float LOG2E = 1.4426950408889634f;

struct EpiQ1 {
  static constexpr bool PERM = false, AFTER_DRAIN = false;
  h16* q1;
  DEVI void operator()(AccRef acc, const Unit& u, int wr, int wc, int fr, int fq) const {
    const float qs = 0.07216878364870322f * LOG2E;
#pragma unroll
    for (int bj = 0; bj < 2; ++bj) {
      const int cgb = u.pn * 256 + bj * 128 + wc * 32;
      const int w = cgb % 192;
      if (w < 128) {
#pragma unroll
        for (int ai = 0; ai < 2; ++ai)
#pragma unroll
          for (int m = 0; m < 4; ++m)
#pragma unroll
            for (int n = 0; n < 2; ++n) {
              const int row = u.pm * 256 + ai * 128 + wr * 64 + m * 16 + fr;
              const f32x4 v = acc[ai][bj][m][n];
              store_h4(q1 + (size_t)row * 2304 + cgb + n * 16 + fq * 4, v[0] * qs, v[1] * qs, v[2] * qs, v[3] * qs);
            }
      } else {
        const int half = (w - 128) >> 5;
        float inv[4];
#pragma unroll
        for (int j = 0; j < 4; ++j) inv[j] = fexp2(-(float)(fq * 4 + j) * (13.287712379549449f / 16.0f)) * 0.15915494309189535f;
#pragma unroll
        for (int ai = 0; ai < 2; ++ai)
#pragma unroll
          for (int m = 0; m < 4; ++m) {
            const int row = u.pm * 256 + ai * 128 + wr * 64 + m * 16 + fr;
            const int t = row & 4095;
            const float pos = (float)(half ? (t & 63) : (t >> 6));
            const f32x4 a = acc[ai][bj][m][0], bb = acc[ai][bj][m][1];
            float o1[4], o2[4];
#pragma unroll
            for (int j = 0; j < 4; ++j) {
              const float rev = pos * inv[j];
              const float cs = cos_rev(rev), sn = sin_rev(rev);
              o1[j] = (a[j] * cs - bb[j] * sn) * qs;
              o2[j] = (a[j] * sn + bb[j] * cs) * qs;
            }
            h16* d = q1 + (size_t)row * 2304 + cgb + fq * 4;
            store_h4(d, o1[0], o1[1], o1[2], o1[3]);
            store_h4(d + 16, o2[0], o2[1], o2[2], o2[3]);
          }
      }
    }
  }
};

struct EpiKV1 {
  static constexpr bool PERM = true, AFTER_DRAIN = false;
  h16 *kn, *vT1;
  DEVI void operator()(AccRef acc, const Unit& u, int wr, int wc, int fr, int fq) const {
    const int hh = u.pn;
    E8P_FOR {
      const int row = E8_ROW;
      const f32x4 va = acc[ai][bj][m][0], vb = acc[ai][bj][m][1];
      int b, key;
      if (row < TL) { b = row >> 12; key = 256 + (row & 4095); } else { b = (row - TL) >> 8; key = (row - TL) & 255; }
      const int w = wc * 32 + fq * 8;
      if (bj == 0) {
        store_h8(kn + ((size_t)b * 4352 + key) * 1536 + hh * 128 + w, va, vb);
      } else {
        h16* d = vT1 + (size_t)((b * 12 + hh) * 128 + w) * 4352 + key;
#pragma unroll
        for (int j = 0; j < 4; ++j) { d[(size_t)j * 4352] = (h16)va[j]; d[(size_t)(4 + j) * 4352] = (h16)vb[j]; }
      }
    }
  }
};

DEVI void mod_units(const Params& p, float* smemf) {
  float* mod = (float*)(p.ws + OFF_MOD);
  const int tid = tidx();
  float* ss = smemf;
  float* red = smemf + 5 * 2048;
  for (int i = tid; i < 5 * 2048; i += NTHR) {
    const int s = i >> 11, k = i & 2047;
    const float v = s < 4 ? p.c[s * 2048 + k] : p.c_ctx[k];
    ss[i] = silu_f(v);
  }
  __syncthreads();
  for (int u = blockIdx.x; u < 768; u += gridDim.x) {
    const int l = u / 384, n0 = (u % 384) * 32;
    const int cl = (tid & 7) * 4, kg = tid >> 3;
    const float* wp = p.w_mod + ((size_t)l * 2048 + kg * 32) * 12288 + n0 + cl;
    float4 a0 = {0, 0, 0, 0}, a1 = a0, a2 = a0, a3 = a0, a4 = a0;
#pragma unroll 8
    for (int kk = 0; kk < 32; ++kk) {
      const float4 w = ldnt4(wp + (size_t)kk * 12288);
      const int k = kg * 32 + kk;
      const float s0 = ss[k], s1 = ss[2048 + k], s2 = ss[4096 + k], s3 = ss[6144 + k], s4 = ss[8192 + k];
      a0.x += s0 * w.x; a0.y += s0 * w.y; a0.z += s0 * w.z; a0.w += s0 * w.w;
      a1.x += s1 * w.x; a1.y += s1 * w.y; a1.z += s1 * w.z; a1.w += s1 * w.w;
      a2.x += s2 * w.x; a2.y += s2 * w.y; a2.z += s2 * w.z; a2.w += s2 * w.w;
      a3.x += s3 * w.x; a3.y += s3 * w.y; a3.z += s3 * w.z; a3.w += s3 * w.w;
      a4.x += s4 * w.x; a4.y += s4 * w.y; a4.z += s4 * w.z; a4.w += s4 * w.w;
    }
    *(float4*)(red + (kg * 5 + 0) * 32 + cl) = a0;
    *(float4*)(red + (kg * 5 + 1) * 32 + cl) = a1;
    *(float4*)(red + (kg * 5 + 2) * 32 + cl) = a2;
    *(float4*)(red + (kg * 5 + 3) * 32 + cl) = a3;
    *(float4*)(red + (kg * 5 + 4) * 32 + cl) = a4;
    __syncthreads();
    if (tid < 160) {
      const int s = tid >> 5, cc = tid & 31;
      float sum = 0.f;
#pragma unroll 16
      for (int g = 0; g < 64; ++g) sum += red[(g * 5 + s) * 32 + cc];
      mod[(size_t)(l * 5 + s) * 12288 + n0 + cc] = sum + p.b_mod[l * 12288 + n0 + cc];
    }
    __syncthreads();
  }
}

DEVI int maprow(int mode, int n) {
  if (mode == 0) return n;
  if (mode == 1) return (n >> 7) * 256 + (n & 127);
  return (n >> 7) * 256 + 128 + (n & 127);
}
DEVI unsigned pack_h2(float lo, float hi) {
  typedef _Float16 h16x2 __attribute__((ext_vector_type(2)));
  h16x2 v; v[0] = (h16)lo; v[1] = (h16)hi;
  return __builtin_bit_cast(unsigned, v);
}
DEVI void transpose_job(const float* __restrict__ src, int ldsrc, int K, int N, int ncol0, h16* __restrict__ dst,
                        int ldd, int dcol0, int mode, float* tile_base, int worker, int nworkers) {
  const int tid = tidx();
  const int half = tid >> 8, tl = tid & 255;
  h16* tile = (h16*)tile_base + half * (64 * 68);
  const int nkt = K >> 6, nnt = N >> 6;
  const int ntiles = nkt * nnt;
  const int kp2 = (tl >> 4) * 2, lc4 = (tl & 15) * 4;
  float4 cur[4], nxt[4];
  int t = worker * 2 + half;
  const int tstride = nworkers * 2;
  if (t < ntiles) {
    const int kt = t / nnt, nt = t - kt * nnt;
    const float* sp = src + (size_t)(kt * 64 + kp2) * ldsrc + ncol0 + nt * 64 + lc4;
    cur[0] = ldnt4(sp); cur[1] = ldnt4(sp + ldsrc);
    cur[2] = ldnt4(sp + (size_t)32 * ldsrc); cur[3] = ldnt4(sp + (size_t)33 * ldsrc);
  }
  for (int t0 = worker * 2; t0 < ntiles; t0 += tstride, t += tstride) {
    const bool active = t < ntiles;
    const int tn = t + tstride;
    if (tn < ntiles) {
      const int kt = tn / nnt, nt = tn - kt * nnt;
      const float* sp = src + (size_t)(kt * 64 + kp2) * ldsrc + ncol0 + nt * 64 + lc4;
      nxt[0] = ldnt4(sp); nxt[1] = ldnt4(sp + ldsrc);
      nxt[2] = ldnt4(sp + (size_t)32 * ldsrc); nxt[3] = ldnt4(sp + (size_t)33 * ldsrc);
    }
    const int kt = t / nnt, nt = t - kt * nnt;
    const int k0 = kt * 64, n0 = nt * 64;
    if (active) {
      unsigned* tw = (unsigned*)tile;
#pragma unroll
      for (int i = 0; i < 2; ++i) {
        const int kd = (i * 32 + kp2) >> 1;
        const float4 a = cur[2 * i], bq = cur[2 * i + 1];
        tw[(lc4 + 0) * 34 + kd] = pack_h2(a.x, bq.x);
        tw[(lc4 + 1) * 34 + kd] = pack_h2(a.y, bq.y);
        tw[(lc4 + 2) * 34 + kd] = pack_h2(a.z, bq.z);
        tw[(lc4 + 3) * 34 + kd] = pack_h2(a.w, bq.w);
      }
    }
    __syncthreads();
    if (active) {
      const int n = tl >> 2, ks = (tl & 3) * 16;
      const uint2* rp = (const uint2*)(tile + n * 68 + ks);
      const uint2 r0 = rp[0], r1 = rp[1], r2 = rp[2], r3 = rp[3];
      h16* d = dst + (size_t)maprow(mode, n0 + n) * ldd + dcol0 + k0 + ks;
      *(uint4*)d = make_uint4(r0.x, r0.y, r1.x, r1.y);
      *(uint4*)(d + 8) = make_uint4(r2.x, r2.y, r3.x, r3.y);
    }
    __syncthreads();
#pragma unroll
    for (int i = 0; i < 4; ++i) cur[i] = nxt[i];
  }
}

DEVI void dft_gen(const Params& p) {
  h16* A = (h16*)(p.ws + OFF_DFTA);
  h16* Ac = (h16*)(p.ws + OFF_DFTAC);
  const size_t nthr = (size_t)gridDim.x * NTHR;
  const size_t gtid = (size_t)blockIdx.x * NTHR + tidx();
  if (gtid < 8) ((int*)(p.ws + OFF_CTR))[gtid * 8] = 0;
  for (size_t ch = gtid; ch < (size_t)2304 * 1024; ch += nthr) {
    const int k = (int)(ch >> 10), n8 = (int)(ch & 1023) * 8;
    h16x8 o;
#pragma unroll
    for (int e = 0; e < 8; ++e) {
      const int nn = n8 + e;
      const int n = nn & 4095;
      const float rev = (float)((k * n) & 4095) * (1.0f / 4096.0f);
      o[e] = (h16)((nn < 4096) ? cos_rev(rev) : -sin_rev(rev));
    }
    *(h16x8*)(A + (size_t)k * 8192 + n8) = o;
  }
  for (size_t ch = gtid; ch < (size_t)256 * 64; ch += nthr) {
    const int k = (int)(ch >> 6), n8 = (int)(ch & 63) * 8;
    h16x8 o;
#pragma unroll
    for (int e = 0; e < 8; ++e) {
      const int nn = n8 + e;
      const int n = nn & 255;
      const float rev = (float)((k * n) & 255) * (1.0f / 256.0f);
      o[e] = (h16)((nn < 256) ? cos_rev(rev) : -sin_rev(rev));
    }
    *(h16x8*)(Ac + (size_t)k * 512 + n8) = o;
  }
  h16* z = (h16*)(p.ws + OFF_WT_IN_CD) + (size_t)1856 * 2048;
  for (size_t ch = gtid; ch < (size_t)192 * 2048 / 8; ch += nthr) {
    uint4 zz = {0, 0, 0, 0};
    *(uint4*)(z + ch * 8) = zz;
  }
}

DEVI void fold_uc(const Params& p, float* smemf) {
  h16* wt = (h16*)(p.ws + OFF_WT_IN_AB);
  float* wl = smemf;
  float* ct = smemf + 128 * 64;
  float* st = ct + 128;
  const int tid = tidx();
  for (int u = blockIdx.x; u < 128; u += gridDim.x) {
    const int kb = u >> 2, g = u & 3, k0 = kb * 64;
    for (int i = tid; i < 64 * 32; i += NTHR) {
      const int kk = i >> 5, c4 = (i & 31) * 4;
      const float4 v = *(const float4*)(p.w_in_ab + (size_t)(k0 + kk) * 5120 + g * 128 + c4);
      wl[(c4 + 0) * 64 + kk] = v.x; wl[(c4 + 1) * 64 + kk] = v.y; wl[(c4 + 2) * 64 + kk] = v.z; wl[(c4 + 3) * 64 + kk] = v.w;
    }
    if (tid < 128) { ct[tid] = cos_rev((float)tid * (1.0f / 128.0f)); st[tid] = sin_rev((float)tid * (1.0f / 128.0f)); }
    __syncthreads();
    const int kh = tid >> 8, t2 = tid & 255;
    const int part = t2 >> 7, m = t2 & 127;
    const float* tab = part ? st : ct;
    float acc[32];
#pragma unroll
    for (int i = 0; i < 32; ++i) acc[i] = 0.f;
    for (int c = 0; c < 128; ++c) {
      const float tw = tab[(c * m) & 127];
#pragma unroll
      for (int k4 = 0; k4 < 8; ++k4) {
        const float4 w = *(const float4*)(wl + c * 64 + kh * 32 + k4 * 4);
        acc[k4 * 4 + 0] += w.x * tw; acc[k4 * 4 + 1] += w.y * tw; acc[k4 * 4 + 2] += w.z * tw; acc[k4 * 4 + 3] += w.w * tw;
      }
    }
    h16* d = wt + (size_t)(g * 256 + t2) * 2048 + k0 + kh * 32;
#pragma unroll
    for (int c8 = 0; c8 < 4; ++c8) {
      h16x8 o;
#pragma unroll
      for (int e = 0; e < 8; ++e) o[e] = (h16)acc[c8 * 8 + e];
      *(h16x8*)(d + c8 * 8) = o;
    }
    __syncthreads();
  }
}

DEVI void fold_out(const float* __restrict__ wg, const float* __restrict__ ps, const float* __restrict__ w_out,
                   h16* __restrict__ wt, float* smemf, int worker, int nworkers) {
  float* wl = smemf;
  float* wgl = smemf + 128 * 64;
  const int tid = tidx();
  for (int u = worker; u < 128; u += nworkers) {
    const int g = u >> 5, j0 = (u & 31) * 64;
    for (int i = tid; i < 128 * 16; i += NTHR) {
      const int d = i >> 4, c4 = (i & 15) * 4;
      float4 v = *(const float4*)(w_out + (size_t)(g * 128 + d) * 2048 + j0 + c4);
      const float sc = ps ? ps[g * 128 + d] : 1.0f;
      v.x *= sc; v.y *= sc; v.z *= sc; v.w *= sc;
      *(float4*)(wl + d * 64 + c4) = v;
    }
    for (int i = tid; i < 128 * 32; i += NTHR) {
      const int c = i >> 5, d4 = (i & 31) * 4;
      *(float4*)(wgl + c * 132 + d4) = *(const float4*)(wg + (size_t)(g * 128 + c) * 128 + d4);
    }
    __syncthreads();
    const int j = tid & 63;
    const int cg_ = __builtin_amdgcn_readfirstlane(tid >> 6);
    float acc[16];
#pragma unroll
    for (int i = 0; i < 16; ++i) acc[i] = 0.f;
    const float* wgp = wgl + (cg_ * 16) * 132;
    for (int d4 = 0; d4 < 32; ++d4) {
      const float w0 = wl[(d4 * 4 + 0) * 64 + j], w1 = wl[(d4 * 4 + 1) * 64 + j], w2 = wl[(d4 * 4 + 2) * 64 + j], w3 = wl[(d4 * 4 + 3) * 64 + j];
#pragma unroll
      for (int cc = 0; cc < 16; ++cc) {
        const float4 gq = *(const float4*)(wgp + cc * 132 + d4 * 4);
        acc[cc] += gq.x * w0 + gq.y * w1 + gq.z * w2 + gq.w * w3;
      }
    }
    h16* dst = wt + (size_t)(j0 + j) * 2048 + g * 128 + cg_ * 16;
#pragma unroll
    for (int c8 = 0; c8 < 2; ++c8) {
      h16x8 o;
#pragma unroll
      for (int e = 0; e < 8; ++e) o[e] = (h16)acc[c8 * 8 + e];
      *(h16x8*)(dst + c8 * 8) = o;
    }
    __syncthreads();
  }
}

DEVI void phase0(const Params& p, float* smemf) {
  const int w = blockIdx.x, nw = gridDim.x;
  mod_units(p, smemf);
  dft_gen(p);
  fold_uc(p, smemf);
  fold_out(p.w_four, nullptr, p.w_out_ab, (h16*)(p.ws + OFF_WT_OUT_AB), smemf, w, nw);
  transpose_job(p.w_in_ab, 5120, 2048, 4608, 512, (h16*)(p.ws + OFF_WT_IN_AB) + (size_t)1024 * 2048, 2048, 0, 0, smemf, w, nw);
  transpose_job(p.w_out_ab + (size_t)512 * 2048, 2048, 1536, 2048, 0, (h16*)(p.ws + OFF_WT_OUT_AB), 2048, 512, 0, smemf, w, nw);
}
DEVI void prep_ffn_gu(const Params& p, int l, float* smemf, int w, int nw) {
  h16* gu = (h16*)(p.ws + (l ? OFF_WT_GU1 : OFF_WT_GU0));
  transpose_job(p.w_ffn_gate + (size_t)l * 2048 * DFF, DFF, 2048, DFF, 0, gu, 2048, 0, 1, smemf, w, nw);
  transpose_job(p.w_ffn_up + (size_t)l * 2048 * DFF, DFF, 2048, DFF, 0, gu, 2048, 0, 2, smemf, w, nw);
}
DEVI void prep_ffn_dn(const Params& p, int l, float* smemf, int w, int nw) {
  h16* dn = (h16*)(p.ws + (l ? OFF_WT_D1 : OFF_WT_D0));
  transpose_job(p.w_ffn_down + (size_t)l * DFF * 2048, 2048, DFF, 2048, 0, dn, DFF, 0, 0, smemf, w, nw);
}
DEVI void prep_ffn(const Params& p, int l, float* smemf, int w, int nw) {
  prep_ffn_gu(p, l, smemf, w, nw);
  prep_ffn_dn(p, l, smemf, w, nw);
}
DEVI void prep_layer1(const Params& p, float* smemf, int w, int nw, bool with_ffn = true) {
  fold_out(p.w_pool, p.pool_scale, p.w_out_cd, (h16*)(p.ws + OFF_WT_OUT_CD), smemf, w, nw);
  transpose_job(p.w_out_cd + (size_t)512 * 2048, 2048, 1536, 2048, 0, (h16*)(p.ws + OFF_WT_OUT_CD), 2048, 512, 0, smemf, w, nw);
  transpose_job(p.w_in_cd, 1856, 2048, 1856, 0, (h16*)(p.ws + OFF_WT_IN_CD), 2048, 0, 0, smemf, w, nw);
  transpose_job(p.w_uq, 2304, 768, 2304, 0, (h16*)(p.ws + OFF_WT_UQ), 768, 0, 0, smemf, w, nw);
  transpose_job(p.w_ukv, 3072, 512, 3072, 0, (h16*)(p.ws + OFF_WT_UKV), 512, 0, 0, smemf, w, nw);
  if (with_ffn) prep_ffn(p, 1, smemf, w, nw);
}

template <class TS>
DEVI void norm_mod_phase(const TS* src_lat, const TS* src_ctx, int nrows, const float* gvec, const float* modl,
                         int sh_idx, int sc_idx, h16* dst) {
  const int tid_ = tidx();
  const int lane = tid_ & 63, wid = tid_ >> 6;
  const int w = blockIdx.x * 8 + wid, nw = gridDim.x * 8;
  const int rbeg = (int)(((long)w * nrows) / nw), rend = (int)(((long)(w + 1) * nrows) / nw);
  if (rbeg >= rend) return;
  float4 fa[8], fb[8], v[8], vn[8];
  int cur_midx = -1;
  {
    const TS* s = rbeg < TL ? src_lat + (size_t)rbeg * 2048 : src_ctx + (size_t)(rbeg - TL) * 2048;
#pragma unroll
    for (int i = 0; i < 8; ++i) v[i] = ld4f(s + (i * 64 + lane) * 4);
  }
  for (int row = rbeg; row < rend; ++row) {
    if (row + 1 < rend) {
      const int r2 = row + 1;
      const TS* s = r2 < TL ? src_lat + (size_t)r2 * 2048 : src_ctx + (size_t)(r2 - TL) * 2048;
#pragma unroll
      for (int i = 0; i < 8; ++i) vn[i] = ld4f(s + (i * 64 + lane) * 4);
    }
    const int midx = row < TL ? (row >> 12) : 4;
    if (midx != cur_midx) {
      cur_midx = midx;
      const float* shp = modl + (size_t)midx * 12288 + sh_idx * 2048;
      const float* scp = modl + (size_t)midx * 12288 + sc_idx * 2048;
#pragma unroll
      for (int i = 0; i < 8; ++i) {
        const int col = (i * 64 + lane) * 4;
        const float4 g = *(const float4*)(gvec + col);
        const float4 sc = *(const float4*)(scp + col);
        fb[i] = *(const float4*)(shp + col);
        fa[i].x = g.x * (1.f + sc.x); fa[i].y = g.y * (1.f + sc.y); fa[i].z = g.z * (1.f + sc.z); fa[i].w = g.w * (1.f + sc.w);
      }
    }
    float ss = 0.f;
#pragma unroll
    for (int i = 0; i < 8; ++i) ss += v[i].x * v[i].x + v[i].y * v[i].y + v[i].z * v[i].z + v[i].w * v[i].w;
    ss = wave_sum(ss);
    const float rstd = rsqrtf(ss * (1.0f / 2048.0f) + 1e-6f);
#pragma unroll
    for (int i = 0; i < 8; ++i) {
      const int col = (i * 64 + lane) * 4;
      store_h4(dst + (size_t)row * 2048 + col, v[i].x * rstd * fa[i].x + fb[i].x, v[i].y * rstd * fa[i].y + fb[i].y,
               v[i].z * rstd * fa[i].z + fb[i].z, v[i].w * rstd * fa[i].w + fb[i].w);
    }
#pragma unroll
    for (int i = 0; i < 8; ++i) v[i] = vn[i];
  }
}

DEVI void ctx_norm_partial_phase(const h16* src_ctx, const float* gvec, const float* modl, int sh_idx, int sc_idx, h16* dst,
                                 const float* part, int nsplit, const float* pgate) {
  const int tid_ = tidx();
  const int lane = tid_ & 63, wid = tid_ >> 6;
  const int w = blockIdx.x * 8 + wid, nw = gridDim.x * 8;
  const float* shp = modl + (size_t)4 * 12288 + sh_idx * 2048;
  const float* scp = modl + (size_t)4 * 12288 + sc_idx * 2048;
  for (int r = w; r < TC; r += nw) {
    float4 v[8];
    float ss = 0.f;
#pragma unroll
    for (int i = 0; i < 8; ++i) {
      const int col = (i * 64 + lane) * 4;
      float4 acc = make_float4(0.f, 0.f, 0.f, 0.f);
      for (int sp = 0; sp < nsplit; ++sp) {
        const float4 q = *(const float4*)(part + ((size_t)sp * TC + r) * 2048 + col);
        acc.x += q.x; acc.y += q.y; acc.z += q.z; acc.w += q.w;
      }
      const float4 gq = *(const float4*)(pgate + col);
      const float4 x = ld4f(src_ctx + (size_t)r * 2048 + col);
      v[i].x = x.x + gq.x * acc.x; v[i].y = x.y + gq.y * acc.y; v[i].z = x.z + gq.z * acc.z; v[i].w = x.w + gq.w * acc.w;
      ss += v[i].x * v[i].x + v[i].y * v[i].y + v[i].z * v[i].z + v[i].w * v[i].w;
    }
    ss = wave_sum(ss);
    const float rstd = rsqrtf(ss * (1.0f / 2048.0f) + 1e-6f);
#pragma unroll
    for (int i = 0; i < 8; ++i) {
      const int col = (i * 64 + lane) * 4;
      const float4 g = *(const float4*)(gvec + col);
      const float4 sh = *(const float4*)(shp + col);
      const float4 sc = *(const float4*)(scp + col);
      store_h4(dst + (size_t)(TL + r) * 2048 + col, v[i].x * rstd * g.x * (1.f + sc.x) + sh.x, v[i].y * rstd * g.y * (1.f + sc.y) + sh.y,
               v[i].z * rstd * g.z * (1.f + sc.z) + sh.z, v[i].w * rstd * g.w * (1.f + sc.w) + sh.w);
    }
  }
}

DEVI void final_norm_phase(const h16* xres, const float* gvec, float* out) {
  const int tid_ = tidx();
  const int lane = tid_ & 63, wid = tid_ >> 6;
  const int w = blockIdx.x * 8 + wid, nw = gridDim.x * 8;
  const int rbeg = (int)(((long)w * TL) / nw), rend = (int)(((long)(w + 1) * TL) / nw);
  if (rbeg >= rend) return;
  float4 fa[8], v[8], vn[8];
#pragma unroll
  for (int i = 0; i < 8; ++i) {
    fa[i] = *(const float4*)(gvec + (i * 64 + lane) * 4);
    v[i] = ld4f(xres + (size_t)rbeg * 2048 + (i * 64 + lane) * 4);
  }
  for (int row = rbeg; row < rend; ++row) {
    if (row + 1 < rend) {
#pragma unroll
      for (int i = 0; i < 8; ++i) vn[i] = ld4f(xres + (size_t)(row + 1) * 2048 + (i * 64 + lane) * 4);
    }
    float ss = 0.f;
#pragma unroll
    for (int i = 0; i < 8; ++i) ss += v[i].x * v[i].x + v[i].y * v[i].y + v[i].z * v[i].z + v[i].w * v[i].w;
    ss = wave_sum(ss);
    const float rstd = rsqrtf(ss * (1.0f / 2048.0f) + 1e-6f);
#pragma unroll
    for (int i = 0; i < 8; ++i) {
      float4 o;
      o.x = v[i].x * rstd * fa[i].x; o.y = v[i].y * rstd * fa[i].y; o.z = v[i].z * rstd * fa[i].z; o.w = v[i].w * rstd * fa[i].w;
      stnt4(out + (size_t)row * 2048 + (i * 64 + lane) * 4, o);
    }
#pragma unroll
    for (int i = 0; i < 8; ++i) v[i] = vn[i];
  }
}

constexpr int NA_KS = 136;
constexpr int NA_VS = 136;
constexpr int NA_BUF = 128 * NA_KS + 128 * NA_VS;
template <int VAR>
DEVI void na_block_unit(const Params& p, int bu, h16* smem) {
  const h16* q0 = (const h16*)(p.ws + OFF_Q0);
  const h16* k0 = (const h16*)(p.ws + OFF_K0);
  const h16* vT = (const h16*)(p.ws + OFF_VT0);
  const h16* vcT = (const h16*)(p.ws + OFF_VCT0);
  h16* cat = VAR ? (h16*)p.out : (h16*)(p.ws + OFF_CAT);
  const int tid = tidx(), lane = tid & 63, wid = tid >> 6;
  const int q_ = lane & 15, g = lane >> 4;
  const bool is_ctx = bu >= 1536;
  int bh, rp = 0, half = 0;
  if (!is_ctx) { rp = bu & 31; bh = bu >> 5; } else { const int uu = bu - 1536; half = uu & 1; bh = uu >> 1; }
  const int hd = bh % 12, b = bh / 12;
  const int rw = 2 * rp + (wid >> 2), j = wid & 3;
  const size_t qrow = is_ctx ? (size_t)(TL + b * 256 + half * 128 + wid * 16 + q_) : (size_t)(b * 4096 + rw * 64 + j * 16 + q_);
  const int rs0 = min(max(2 * rp - 4, 0), 56), rs1 = min(max(2 * rp - 3, 0), 56);
  const int nrows = is_ctx ? 0 : (rs1 - rs0 + 8);
  const int nloc = (nrows + 1) >> 1;
  const int T = nloc + 2;
  const int rsw = min(max(rw - 4, 0), 56);
  const h16* qp = q0 + qrow * 1536 + hd * 128 + g * 8;
  h16x8 qf[4];
#pragma unroll
  for (int s = 0; s < 4; ++s) qf[s] = *(const h16x8*)(qp + s * 32);
  f32x4 o[8];
#pragma unroll
  for (int d = 0; d < 8; ++d) { o[d][0] = 0.f; o[d][1] = 0.f; o[d][2] = 0.f; o[d][3] = 0.f; }
  float m = -1e30f, lsum = 0.f;
  const int kstart = min(max(j * 16 - 8, 0), 32);
  const int qc = j * 16 + q_;
  const int cstart = min(max(qc - 8, 0), 48);
  const float scale = 0.08838834764831845f * LOG2E;
  float* rpb = (float*)(smem + 2 * NA_BUF);
  if (!is_ctx && tid < 465) rpb[tid] = p.na_rpb[hd * 465 + tid] * LOG2E;
  const int srow = tid >> 4, sch = tid & 15;
  const h16* kloc = k0 + (size_t)b * 4096 * 1536 + hd * 128 + (size_t)srow * 1536 + sch * 8;
  const h16* kctx = k0 + ((size_t)TL + b * 256) * 1536 + hd * 128 + (size_t)srow * 1536 + sch * 8;
  const h16* vloc = vT + ((size_t)(b * 12 + hd) * 128 + srow) * 4096 + sch * 8;
  const h16* vctx = vcT + ((size_t)(b * 12 + hd) * 128 + srow) * 256 + sch * 8;
  uint4 A0, A1, A2, A3, A4, A5, A6, A7;
#define NA_GLOAD(t, R0, R1, R2, R3, R4, R5, R6, R7)                                                    \
  {                                                                                                    \
    if ((t) < nloc) {                                                                                  \
      const int krow = rs0 + 2 * (t);                        \
      const h16* kb = kloc + (size_t)krow * 64 * 1536;                                                 \
      const h16* vb = vloc + krow * 64;                                                                \
      R0 = *(const uint4*)kb; R1 = *(const uint4*)(kb + 32 * 1536);                                    \
      R2 = *(const uint4*)(kb + 64 * 1536); R3 = *(const uint4*)(kb + 96 * 1536);                      \
      R4 = *(const uint4*)vb; R5 = *(const uint4*)(vb + (size_t)32 * 4096);                            \
      R6 = *(const uint4*)(vb + (size_t)64 * 4096); R7 = *(const uint4*)(vb + (size_t)96 * 4096);      \
    } else {                                                                                           \
      const int c = (t) - nloc;                                                                        \
      const h16* kb = kctx + (size_t)c * 128 * 1536;                                                   \
      const h16* vb = vctx + c * 128;                                                                  \
      R0 = *(const uint4*)kb; R1 = *(const uint4*)(kb + 32 * 1536);                                    \
      R2 = *(const uint4*)(kb + 64 * 1536); R3 = *(const uint4*)(kb + 96 * 1536);                      \
      R4 = *(const uint4*)vb; R5 = *(const uint4*)(vb + 32 * 256);                                     \
      R6 = *(const uint4*)(vb + 64 * 256); R7 = *(const uint4*)(vb + 96 * 256);                        \
    }                                                                                                  \
  }
#define NA_SSTORE(buf, R0, R1, R2, R3, R4, R5, R6, R7)                                                 \
  {                                                                                                    \
    h16* bk = smem + (buf) * NA_BUF;                                                                   \
    h16* bv = bk + 128 * NA_KS;                                                                        \
    *(uint4*)(bk + srow * NA_KS + sch * 8) = R0;                                                       \
    *(uint4*)(bk + (srow + 32) * NA_KS + sch * 8) = R1;                                                \
    *(uint4*)(bk + (srow + 64) * NA_KS + sch * 8) = R2;                                                \
    *(uint4*)(bk + (srow + 96) * NA_KS + sch * 8) = R3;                                                \
    *(uint4*)(bv + srow * NA_VS + sch * 8) = R4;                                                       \
    *(uint4*)(bv + (srow + 32) * NA_VS + sch * 8) = R5;                                                \
    *(uint4*)(bv + (srow + 64) * NA_VS + sch * 8) = R6;                                                \
    *(uint4*)(bv + (srow + 96) * NA_VS + sch * 8) = R7;                                                \
  }
  auto iter32 = [&](const h16* sKw, const h16* sVw, bool loc, int ridx) {
    f32x4 s0 = {0.f, 0.f, 0.f, 0.f}, s1 = {0.f, 0.f, 0.f, 0.f};
    const h16* kp = sKw + q_ * NA_KS + g * 8;
#pragma unroll
    for (int s = 0; s < 4; ++s) {
      const h16x8 ka = *(const h16x8*)(kp + s * 32);
      const h16x8 kb = *(const h16x8*)(kp + 16 * NA_KS + s * 32);
      s0 = mfma16(ka, qf[s], s0);
      s1 = mfma16(kb, qf[s], s1);
    }
    float sc[8];
#pragma unroll
    for (int i = 0; i < 4; ++i) { sc[i] = s0[i] * scale; sc[4 + i] = s1[i] * scale; }
    if (loc) {
#pragma unroll
      for (int i = 0; i < 8; ++i) {
        const int kcol = kstart + (i >> 2) * 16 + g * 4 + (i & 3);
        const bool valid = (kcol >= cstart) && (kcol < cstart + 16);
        const int cidx = min(max(kcol - qc + 15, 0), 30);
        const float bias = rpb[ridx * 31 + cidx];
        sc[i] = valid ? (sc[i] + bias) : -1e30f;
      }
    }
    float mx = sc[0];
#pragma unroll
    for (int i = 1; i < 8; ++i) mx = fmaxf(mx, sc[i]);
    mx = fmaxf(mx, __shfl_xor(mx, 16));
    mx = fmaxf(mx, __shfl_xor(mx, 32));
    const float mn = (mx > m + 8.0f) ? mx : m;
    const float alpha = fexp2(m - mn);
    m = mn;
    float ps = 0.f;
    h16x8 pf;
#pragma unroll
    for (int i = 0; i < 8; ++i) {
      const float pv = fexp2(sc[i] - mn);
      ps += pv;
      pf[i] = (h16)pv;
    }
    lsum = lsum * alpha + ps;
    if (__builtin_amdgcn_ballot_w64(alpha != 1.0f) != 0) {
#pragma unroll
      for (int d = 0; d < 8; ++d) { o[d][0] *= alpha; o[d][1] *= alpha; o[d][2] *= alpha; o[d][3] *= alpha; }
    }
#pragma unroll
    for (int d = 0; d < 8; ++d) {
      const h16* vp = sVw + (d * 16 + q_) * NA_VS + g * 4;
      const h16x4 lo = *(const h16x4*)vp;
      const h16x4 hi = *(const h16x4*)(vp + 16);
      h16x8 vf;
      vf[0] = lo[0]; vf[1] = lo[1]; vf[2] = lo[2]; vf[3] = lo[3];
      vf[4] = hi[0]; vf[5] = hi[1]; vf[6] = hi[2]; vf[7] = hi[3];
      o[d] = mfma16(vf, pf, o[d]);
    }
  };
  auto iter64 = [&](const h16* sK0, const h16* sV0, const h16* sK1, const h16* sV1, bool loc, int ridx0, int ridx1) {
    f32x4 s00 = {0.f, 0.f, 0.f, 0.f}, s01 = s00, s10 = s00, s11 = s00;
    const h16* kp0 = sK0 + q_ * NA_KS + g * 8;
    const h16* kp1 = sK1 + q_ * NA_KS + g * 8;
#pragma unroll
    for (int s = 0; s < 4; ++s) {
      s00 = mfma16(*(const h16x8*)(kp0 + s * 32), qf[s], s00);
      s01 = mfma16(*(const h16x8*)(kp0 + 16 * NA_KS + s * 32), qf[s], s01);
      s10 = mfma16(*(const h16x8*)(kp1 + s * 32), qf[s], s10);
      s11 = mfma16(*(const h16x8*)(kp1 + 16 * NA_KS + s * 32), qf[s], s11);
    }
    float sc[16];
#pragma unroll
    for (int i = 0; i < 4; ++i) { sc[i] = s00[i] * scale; sc[4 + i] = s01[i] * scale; sc[8 + i] = s10[i] * scale; sc[12 + i] = s11[i] * scale; }
    if (loc) {
#pragma unroll
      for (int i = 0; i < 8; ++i) {
        const int kcol = kstart + (i >> 2) * 16 + g * 4 + (i & 3);
        const bool valid = (kcol >= cstart) && (kcol < cstart + 16);
        const int cidx = min(max(kcol - qc + 15, 0), 30);
        sc[i] = valid ? (sc[i] + rpb[ridx0 * 31 + cidx]) : -1e30f;
        sc[8 + i] = valid ? (sc[8 + i] + rpb[ridx1 * 31 + cidx]) : -1e30f;
      }
    }
    float mx = sc[0];
#pragma unroll
    for (int i = 1; i < 16; ++i) mx = fmaxf(mx, sc[i]);
    mx = fmaxf(mx, __shfl_xor(mx, 16));
    mx = fmaxf(mx, __shfl_xor(mx, 32));
    const float mn = (mx > m + 8.0f) ? mx : m;
    const float alpha = fexp2(m - mn);
    m = mn;
    float ps = 0.f;
    h16x8 pf0, pf1;
#pragma unroll
    for (int i = 0; i < 8; ++i) {
      const float pa = fexp2(sc[i] - mn), pb = fexp2(sc[8 + i] - mn);
      ps += pa + pb;
      pf0[i] = (h16)pa; pf1[i] = (h16)pb;
    }
    lsum = lsum * alpha + ps;
    if (__builtin_amdgcn_ballot_w64(alpha != 1.0f) != 0) {
#pragma unroll
      for (int d = 0; d < 8; ++d) { o[d][0] *= alpha; o[d][1] *= alpha; o[d][2] *= alpha; o[d][3] *= alpha; }
    }
#pragma unroll
    for (int d = 0; d < 8; ++d) {
      const h16* vp0 = sV0 + (d * 16 + q_) * NA_VS + g * 4;
      const h16* vp1 = sV1 + (d * 16 + q_) * NA_VS + g * 4;
      const h16x4 lo0 = *(const h16x4*)vp0, hi0 = *(const h16x4*)(vp0 + 16);
      const h16x4 lo1 = *(const h16x4*)vp1, hi1 = *(const h16x4*)(vp1 + 16);
      h16x8 vf0, vf1;
      vf0[0] = lo0[0]; vf0[1] = lo0[1]; vf0[2] = lo0[2]; vf0[3] = lo0[3]; vf0[4] = hi0[0]; vf0[5] = hi0[1]; vf0[6] = hi0[2]; vf0[7] = hi0[3];
      vf1[0] = lo1[0]; vf1[1] = lo1[1]; vf1[2] = lo1[2]; vf1[3] = lo1[3]; vf1[4] = hi1[0]; vf1[5] = hi1[1]; vf1[6] = hi1[2]; vf1[7] = hi1[3];
      o[d] = mfma16(vf0, pf0, o[d]);
      o[d] = mfma16(vf1, pf1, o[d]);
    }
  };
  auto compute = [&](int t) {
    const h16* sK = smem + (t & 1) * NA_BUF;
    const h16* sV = sK + 128 * NA_KS;
    if (t < nloc) {
      const int kr0 = rs0 + 2 * t, kr1 = kr0 + 1;
      const bool m0 = (kr0 >= rsw) && (kr0 < rsw + 8);
      const bool m1 = (kr1 >= rsw) && (kr1 < rsw + 8);
      if (m0 && m1) iter64(sK + kstart * NA_KS, sV + kstart, sK + (64 + kstart) * NA_KS, sV + 64 + kstart, true, kr0 - rw + 7, kr1 - rw + 7);
      else if (m0) iter32(sK + kstart * NA_KS, sV + kstart, true, kr0 - rw + 7);
      else if (m1) iter32(sK + (64 + kstart) * NA_KS, sV + 64 + kstart, true, kr1 - rw + 7);
    } else {
      iter64(sK, sV, sK + 32 * NA_KS, sV + 32, false, 0, 0);
      iter64(sK + 64 * NA_KS, sV + 64, sK + 96 * NA_KS, sV + 96, false, 0, 0);
    }
  };
  NA_GLOAD(0, A0, A1, A2, A3, A4, A5, A6, A7);
  NA_SSTORE(0, A0, A1, A2, A3, A4, A5, A6, A7);
  NA_GLOAD(1, A0, A1, A2, A3, A4, A5, A6, A7);
  __syncthreads();
  for (int t = 0; t < T; ++t) {
    if (VAR != 1) compute(t);
    if (t + 1 < T && VAR != 2) NA_SSTORE((t + 1) & 1, A0, A1, A2, A3, A4, A5, A6, A7);
    if (t + 2 < T && VAR != 2) NA_GLOAD(t + 2, A0, A1, A2, A3, A4, A5, A6, A7);
    __syncthreads();
  }
  lsum += __shfl_xor(lsum, 16);
  lsum += __shfl_xor(lsum, 32);
  const float rl = 1.0f / lsum;
  h16* op = cat + qrow * 2048 + 512 + hd * 128 + g * 4;
#pragma unroll
  for (int d = 0; d < 8; ++d) store_h4(op + d * 16, o[d][0] * rl, o[d][1] * rl, o[d][2] * rl, o[d][3] * rl);
#undef NA_GLOAD
#undef NA_SSTORE
}

constexpr int MLA_KS = 200;
constexpr int MLA_VS = 72;
constexpr int MLA_BUF = 64 * MLA_KS + 128 * MLA_VS;
template <int VAR>
DEVI void mla_unit(const Params& p, int unit, h16* smem) {
  const h16* q1 = (const h16*)(p.ws + OFF_Q1);
  const h16* kn = (const h16*)(p.ws + OFF_KN);
  const h16* kr = (const h16*)(p.ws + OFF_KR);
  const h16* vT1 = (const h16*)(p.ws + OFF_VT1);
  h16* cat = VAR ? (h16*)p.out : (h16*)(p.ws + OFF_CAT);
  const int tid = tidx(), lane = tid & 63, wid = tid >> 6;
  const int qblk = unit & 15, bh = unit >> 4, hd = bh % 12, b = bh / 12;
  const int q_ = lane & 31, hh = lane >> 5;
  const size_t qrow = (size_t)b * 4096 + qblk * 256 + wid * 32 + q_;
  const h16* qp = q1 + qrow * 2304 + hd * 192 + hh * 8;
  h16x8 qf[12];
#pragma unroll
  for (int s = 0; s < 12; ++s) qf[s] = *(const h16x8*)(qp + s * 16);
  const int skey = tid >> 3, sc0 = tid & 7;
  const h16* gk = kn + ((size_t)b * 4352 + skey) * 1536 + hd * 128 + sc0 * 8;
  const h16* gr = kr + ((size_t)b * 4352 + skey) * 64 + sc0 * 8;
  const h16* gv = vT1 + ((size_t)(b * 12 + hd) * 128 + skey) * 4352 + sc0 * 8;
  uint4 rk0, rk1, rk2, rv0, rv1;
#define MLA_GLOAD(KT)                                             \
  {                                                               \
    const size_t key0 = (size_t)(KT) * 64;                        \
    rk0 = *(const uint4*)(gk + key0 * 1536);                      \
    rk1 = *(const uint4*)(gk + key0 * 1536 + 64);                 \
    rk2 = *(const uint4*)(gr + key0 * 64);                        \
    rv0 = *(const uint4*)(gv + key0);                             \
    rv1 = *(const uint4*)(gv + (size_t)64 * 4352 + key0);         \
  }
#define MLA_SSTORE(BUF)                                           \
  {                                                               \
    h16* bk = smem + (BUF) * MLA_BUF;                             \
    h16* bv = bk + 64 * MLA_KS;                                   \
    *(uint4*)(bk + skey * MLA_KS + sc0 * 8) = rk0;                \
    *(uint4*)(bk + skey * MLA_KS + 64 + sc0 * 8) = rk1;           \
    *(uint4*)(bk + skey * MLA_KS + 128 + sc0 * 8) = rk2;          \
    h16* d0 = bv + skey * MLA_VS + (sc0 >> 1) * 16 + (sc0 & 1) * 4;  \
    *(uint2*)d0 = make_uint2(rv0.x, rv0.y);                       \
    *(uint2*)(d0 + 8) = make_uint2(rv0.z, rv0.w);                 \
    h16* d1 = d0 + 64 * MLA_VS;                                   \
    *(uint2*)d1 = make_uint2(rv1.x, rv1.y);                       \
    *(uint2*)(d1 + 8) = make_uint2(rv1.z, rv1.w);                 \
  }
  f32x16 o[4];
#pragma unroll
  for (int d = 0; d < 4; ++d)
#pragma unroll
    for (int i = 0; i < 16; ++i) o[d][i] = 0.f;
  float m = -1e30f, lsum = 0.f;
  f32x16 sc, sn;
#define MLA_SUBSTEP(HAVE_NEXT, KNEXT, VCUR)                                                       \
  {                                                                                               \
    _Pragma("unroll") for (int i = 0; i < 16; ++i) sn[i] = 0.f;                                   \
    if (HAVE_NEXT) {                                                                              \
      const h16* kp = (KNEXT) + q_ * MLA_KS + hh * 8;                                             \
      _Pragma("unroll") for (int st = 0; st < 12; ++st) sn = mfma32(*(const h16x8*)(kp + st * 16), qf[st], sn); \
    }                                                                                             \
    float mx = sc[0];                                                                             \
    _Pragma("unroll") for (int i = 1; i < 16; ++i) mx = fmaxf(mx, sc[i]);                         \
    mx = fmaxf(mx, __shfl_xor(mx, 32));                                                           \
    const float mn = (mx > m + 8.0f) ? mx : m;     \
    const float alpha = fexp2(m - mn);                                                            \
    m = mn;                                                                                       \
    float ps = 0.f;                                                                               \
    h16x8 pf0, pf1;                                                                               \
    _Pragma("unroll") for (int i = 0; i < 8; ++i) {                                               \
      const float pa = (VAR == 2) ? (sc[i] - mn) : fexp2(sc[i] - mn), pb = (VAR == 2) ? (sc[8 + i] - mn) : fexp2(sc[8 + i] - mn); \
      ps += pa + pb;                                                                              \
      pf0[i] = (h16)pa; pf1[i] = (h16)pb;                                                         \
    }                                                                                             \
    lsum = lsum * alpha + ps;                                                                     \
    if (__builtin_amdgcn_ballot_w64(alpha != 1.0f) != 0) {                                        \
      _Pragma("unroll") for (int d = 0; d < 4; ++d)                                               \
        _Pragma("unroll") for (int i = 0; i < 16; ++i) o[d][i] *= alpha;                          \
    }                                                                                             \
    _Pragma("unroll") for (int s2 = 0; s2 < 2; ++s2) {                                            \
      _Pragma("unroll") for (int d = 0; d < 4; ++d) {                                             \
        const h16x8 vf = *(const h16x8*)((VCUR) + (d * 32 + q_) * MLA_VS + s2 * 16 + hh * 8);     \
        if (VAR != 3) o[d] = mfma32(vf, s2 ? pf1 : pf0, o[d]); else o[d][0] += (float)vf[0] * (float)pf0[0]; \
      }                                                                                           \
    }                                                                                             \
    sc = sn;                                                                                      \
  }
  constexpr int NT = 4352 / 64;
  MLA_GLOAD(0);
  MLA_SSTORE(0);
  MLA_GLOAD(1);
  MLA_SSTORE(1);
  __syncthreads();
  {
#pragma unroll
    for (int i = 0; i < 16; ++i) sc[i] = 0.f;
    const h16* kp = smem + q_ * MLA_KS + hh * 8;
#pragma unroll
    for (int st = 0; st < 12; ++st) sc = mfma32(*(const h16x8*)(kp + st * 16), qf[st], sc);
  }
  int bc = 0;
  for (int kt = 0; kt < NT; ++kt) {
    const int bn = (bc == 2) ? 0 : bc + 1;
    const int bw = (bn == 2) ? 0 : bn + 1;
    const bool pre = kt + 2 < NT;
    if (pre && VAR != 1) MLA_GLOAD(kt + 2);
    const h16* sK = smem + bc * MLA_BUF;
    const h16* sV = sK + 64 * MLA_KS;
    const h16* sKn = smem + bn * MLA_BUF;
    MLA_SUBSTEP(true, sK + 32 * MLA_KS, sV);
    MLA_SUBSTEP(kt + 1 < NT, sKn, sV + 32);
    if (pre && VAR != 1) MLA_SSTORE(bw);
    __syncthreads();
    bc = bn;
  }
  lsum += __shfl_xor(lsum, 32);
  const float rl = 1.0f / lsum;
  h16* op = cat + qrow * 2048 + 512 + hd * 128 + hh * 4;
#pragma unroll
  for (int d = 0; d < 4; ++d)
#pragma unroll
    for (int i4 = 0; i4 < 4; ++i4)
      store_h4(op + d * 32 + i4 * 8, o[d][i4 * 4 + 0] * rl, o[d][i4 * 4 + 1] * rl, o[d][i4 * 4 + 2] * rl, o[d][i4 * 4 + 3] * rl);
#undef MLA_GLOAD
#undef MLA_SSTORE
#undef MLA_SUBSTEP
}

DEVI void l1_prep_phase(const Params& p) {
  const h16* p1 = (const h16*)(p.ws + OFF_P1);
  h16* cqn = (h16*)(p.ws + OFF_CQN);
  h16* ckvn = (h16*)(p.ws + OFF_CKVN);
  h16* kr = (h16*)(p.ws + OFF_KR);
  h16* cat = (h16*)(p.ws + OFF_CAT);
  const int tid_ = tidx(); const int lane = tid_ & 63, wid = tid_ >> 6;
  for (int row = blockIdx.x * 8 + wid; row < TA; row += gridDim.x * 8) {
    const h16* pr = p1 + (size_t)row * 2048;
    const bool lat = row < TL;
    {
      const h16x8 v = *(const h16x8*)(pr + 1280 + lane * 8);
      float f[8], ss = 0.f;
#pragma unroll
      for (int e = 0; e < 8; ++e) { f[e] = (float)v[e]; ss += f[e] * f[e]; }
      ss = wave_sum(ss);
      const float rstd = rsqrtf(ss * (1.0f / 512.0f) + 1e-6f);
      h16x8 o;
#pragma unroll
      for (int e = 0; e < 8; ++e) o[e] = (h16)(f[e] * rstd * p.mla_gkv[lane * 8 + e]);
      *(h16x8*)(ckvn + (size_t)row * 512 + lane * 8) = o;
    }
    {
      const float xv = (float)pr[1792 + lane];
      const float xo = __shfl_xor(xv, 16);
      float outv = xv;
      int b, key;
      if (lat) {
        const int t = row & 4095;
        b = row >> 12; key = 256 + t;
        const int fi = lane & 15;
        const int pos = (lane < 32) ? (t >> 6) : (t & 63);
        const float inv = fexp2(-(float)fi * (13.287712379549449f / 16.0f));
        const float rev = (float)pos * inv * 0.15915494309189535f;
        const float cs = cos_rev(rev), sn = sin_rev(rev);
        outv = (lane & 16) ? (xo * sn + xv * cs) : (xv * cs - xo * sn);
      } else {
        b = (row - TL) >> 8; key = (row - TL) & 255;
      }
      kr[((size_t)b * 4352 + key) * 64 + lane] = (h16)outv;
    }
    if (lat) {
      {
        float f[12], ss = 0.f;
#pragma unroll
        for (int i = 0; i < 3; ++i) {
          const h16x4 v = *(const h16x4*)(pr + 512 + (i * 64 + lane) * 4);
#pragma unroll
          for (int e = 0; e < 4; ++e) { f[i * 4 + e] = (float)v[e]; ss += f[i * 4 + e] * f[i * 4 + e]; }
        }
        ss = wave_sum(ss);
        const float rstd = rsqrtf(ss * (1.0f / 768.0f) + 1e-6f);
#pragma unroll
        for (int i = 0; i < 3; ++i) {
          const int col = (i * 64 + lane) * 4;
          store_h4(cqn + (size_t)row * 768 + col, f[i * 4 + 0] * rstd * p.mla_gq[col + 0], f[i * 4 + 1] * rstd * p.mla_gq[col + 1],
                   f[i * 4 + 2] * rstd * p.mla_gq[col + 2], f[i * 4 + 3] * rstd * p.mla_gq[col + 3]);
        }
      }
      {
        const int t = row & 4095;
        const int grp = lane >> 4;
        const int hw = 1 << grp;
        const int lo = max(t - hw, 0), hi = min(t + hw, 4096);
        float acc[8];
#pragma unroll
        for (int e = 0; e < 8; ++e) acc[e] = 0.f;
        const h16* base = p1 + (size_t)(row - t) * 2048 + lane * 8;
        for (int tt = lo; tt < hi; ++tt) {
          const h16x8 v = *(const h16x8*)(base + (size_t)tt * 2048);
#pragma unroll
          for (int e = 0; e < 8; ++e) acc[e] += (float)v[e];
        }
        const h16x8 self = *(const h16x8*)(pr + lane * 8);
        const float rc = 1.0f / (float)(hi - lo);
        h16x8 o;
#pragma unroll
        for (int e = 0; e < 8; ++e) o[e] = (h16)(acc[e] * rc - (float)self[e]);
        *(h16x8*)(cat + (size_t)row * 2048 + lane * 8) = o;
      }
    }
  }
}

#define XB_TMO      128
#define XB_XCNT(j)  (256  + 64 * (j))
#define XB_XSUB(j)  (1280 + 64 * (j))
#define XB_XGEN(j)  (2304 + 64 * (j))
#define XB_TOP      3328
#define XB_TOPGEN   3392
#define XCD_BAR_WORDS 3456
#define XB_SPIN_CAP (1u << 20)
DEVI unsigned xb_ld(unsigned* p) { return __hip_atomic_load(p, __ATOMIC_RELAXED, __HIP_MEMORY_SCOPE_AGENT); }
DEVI unsigned xb_add(unsigned* p, unsigned v) { return __hip_atomic_fetch_add(p, v, __ATOMIC_RELAXED, __HIP_MEMORY_SCOPE_AGENT); }
DEVI unsigned xb_xcc_id() { return (unsigned)__builtin_amdgcn_s_getreg((3 << 11) | 20) & 0xFu; }
#define XB_SPIN(cond, bar) do { unsigned _sp = 0; while (cond) { __builtin_amdgcn_s_sleep(0); \
    if ((++_sp & 255u) == 0u) { if (xb_ld(&(bar)[XB_TMO])) break; if (_sp > XB_SPIN_CAP) { atomicAdd(&(bar)[XB_TMO], 1u); break; } } } } while (0)
struct XcdBarrier { unsigned* bar; unsigned x; volatile __attribute__((address_space(3))) unsigned* st; };
DEVI XcdBarrier xcd_barrier_post(unsigned* bar, volatile __attribute__((address_space(3))) unsigned* st) {
  XcdBarrier b; b.bar = bar; b.x = xb_xcc_id(); b.st = st;
  if (threadIdx.x == 0) (void)xb_add(&bar[XB_XCNT(b.x)], 1u);
  return b;
}
DEVI void xcd_barrier_complete(unsigned* bar, unsigned x, unsigned& nloc, unsigned& nx) {
  const unsigned G = gridDim.x * gridDim.y * gridDim.z;
  unsigned sum, cnt, mine, sp = 0u;
  for (;;) {
    sum = 0u; cnt = 0u; mine = 0u;
#pragma unroll
    for (unsigned j = 0; j < 16; ++j) { const unsigned c = xb_ld(&bar[XB_XCNT(j)]); sum += c; cnt += (c > 0u) ? 1u : 0u; mine = (j == x) ? c : mine; }
    if (sum == G) break;
    __builtin_amdgcn_s_sleep(1);
    if ((++sp & 255u) == 0u) { if (xb_ld(&bar[XB_TMO])) break; if (sp > XB_SPIN_CAP) { atomicAdd(&bar[XB_TMO], 1u); break; } }
  }
  nloc = mine > 0u ? mine : 1u; nx = cnt > 0u ? cnt : 1u;
}
DEVI void xcd_barrier(const XcdBarrier& b) {
  asm volatile("s_waitcnt vmcnt(0)" ::: "memory");
  __syncthreads();
  if (threadIdx.x == 0) {
    unsigned* bar = b.bar;
    __builtin_amdgcn_s_waitcnt(0);
    unsigned nloc = b.st[0], nx = b.st[1];
    if (nloc == 0u) { xcd_barrier_complete(bar, b.x, nloc, nx); b.st[0] = nloc; b.st[1] = nx; }
    const unsigned old = xb_add(&bar[XB_XSUB(b.x)], 1u);
    const unsigned gen = old / nloc;
    if (old + 1u == (gen + 1u) * nloc) {
      __builtin_amdgcn_fence(__ATOMIC_RELEASE, "agent");
      asm volatile("s_waitcnt vmcnt(0)" ::: "memory");
      const unsigned og = xb_add(&bar[XB_TOP], 1u);
      const unsigned tg = og / nx;
      if (og + 1u == (tg + 1u) * nx) xb_add(&bar[XB_TOPGEN], 1u);
      else XB_SPIN(xb_ld(&bar[XB_TOPGEN]) == tg, bar);
      __builtin_amdgcn_fence(__ATOMIC_ACQUIRE, "agent");
      xb_add(&bar[XB_XGEN(b.x)], 1u);
      asm volatile("s_waitcnt vmcnt(0)" ::: "memory");
    } else {
      XB_SPIN(xb_ld(&bar[XB_XGEN(b.x)]) == gen, bar);
      __builtin_amdgcn_fence(__ATOMIC_ACQUIRE, "agent");
      asm volatile("s_waitcnt vmcnt(0)" ::: "memory");
    }
  }
  __syncthreads();
}

DEVI void run_phase(const Params& pin, int ph, h16* smem, bool dummy = false) {
  Params p = pin;
  asm volatile("" : "+s"(p.ws));
  char* ws = p.ws;
  float* mod = (float*)(ws + OFF_MOD);
  h16* xres = (h16*)(ws + OFF_XRES);
  h16* xout = xres;
  h16* hbuf = (h16*)(ws + OFF_H);
  h16* cat = (h16*)(ws + OFF_CAT);
  h16* act = (h16*)(ws + OFF_BIG);
  switch (ph) {
    case 0: phase0(p, (float*)smem); break;
    case 1: norm_mod_phase(p.x, p.ctx, TA, p.norm1_g, mod, 0, 1, hbuf); break;
    case 2: {
      EpiG1 e{(h16*)(ws + OFF_Q0), (h16*)(ws + OFF_K0), (h16*)(ws + OFF_VT0), (h16*)(ws + OFF_VCT0), (h16*)(ws + OFF_UCT), (h16*)(ws + OFF_UCTC)};
      run_gemm(smem, hbuf, (const h16*)(ws + OFF_WT_IN_AB), TA, 5632, 2048, e);
    } break;
    case 3: {
#ifdef DFT_PROBE
      const bool do_dft = true, do_na = !dummy;
#else
      const bool do_dft = !dummy, do_na = true;
#endif
      if (do_dft) {
        EpiDft e{cat, 0.0013810679320049757f, 0, 1};
        run_gemm(smem, (const h16*)(ws + OFF_DFTA), (const h16*)(ws + OFF_UCT), 2304, 2048, 8192, e);
      }
      if (do_dft) {
        EpiDft e{cat, 0.005524271728019903f, 1, 0};
        run_gemm(smem, (const h16*)(ws + OFF_DFTAC), (const h16*)(ws + OFF_UCTC), 256, 2048, 512, e, (int)((lbid() + gridDim.x - (128 % gridDim.x)) % gridDim.x));
      }
      const int xcd = lbid() & 7;
      int* ctr = (int*)(ws + OFF_CTR) + xcd * 8;
      int* su = (int*)smem;
      const int tid = tidx();
      for (; do_na;) {
        __syncthreads();
        if (tid == 0) su[0] = atomicAdd(ctr, 1);
        __syncthreads();
        const int u = su[0];
        if (u >= 204) break;
        const int bu = u < 192 ? (xcd * 192 + u) : (1536 + xcd * 12 + (u - 192));
#ifdef NA_PROBE_VAR
        if (dummy) na_block_unit<NA_PROBE_VAR>(p, bu, smem + 64); else
#endif
        na_block_unit<0>(p, bu, smem + 64);
      }
    } break;
    case 4: {
      EpiRes<float> e{p.x, p.ctx, xout, mod + 2 * 2048};
      run_gemm(smem, cat, (const h16*)(ws + OFF_WT_OUT_AB), TA, 2048, 2048, e);
      if (!dummy && gridDim.x == 256 && lbid() >= 32) prep_ffn_gu(p, 0, (float*)smem, lbid() - 32, 224);
      else if (!dummy && gridDim.x != 256) prep_ffn_gu(p, 0, (float*)smem, lbid(), (int)gridDim.x);
    } break;
    case 5: norm_mod_phase(xres, xres + (size_t)TL * 2048, TA, p.norm2_g, mod, 3, 4, hbuf); break;
    case 6: {
      EpiGU e{act};
      run_gemm(smem, hbuf, (const h16*)(ws + OFF_WT_GU0), TA, 11264, 2048, e);
      if (!dummy && gridDim.x == 256 && lbid() >= 176) prep_ffn_dn(p, 0, (float*)smem, lbid() - 176, 80);
      else if (!dummy && gridDim.x != 256) prep_ffn_dn(p, 0, (float*)smem, lbid(), (int)gridDim.x);
    } break;
    case 7: {
      EpiRes<h16> e{xres, xres + (size_t)TL * 2048, xout, mod + 5 * 2048};
      if (gridDim.x == 256) {
        run_gemm(smem, act, (const h16*)(ws + OFF_WT_D0), TL, 2048, DFF, e);
        if (!dummy) {
          const int c = lbid(), sp = c >> 5;
          if (c < 128) {
            EpiPartial ep{(float*)cat + (size_t)sp * TC * 2048};
            run_gemm(smem, act + (size_t)TL * DFF + sp * 1408, (const h16*)(ws + OFF_WT_D0) + sp * 1408, TC, 2048, 1408, ep, c & 31, DFF);
          } else {
            prep_layer1(p, (float*)smem, c - 128, 128, false);
          }
        }
      } else {
        run_gemm(smem, act, (const h16*)(ws + OFF_WT_D0), TA, 2048, DFF, e);
        if (!dummy) prep_layer1(p, (float*)smem, lbid(), (int)gridDim.x, false);
      }
    } break;
    case 8:
      if (gridDim.x == 256) {
        norm_mod_phase(xres, xres + (size_t)TL * 2048, TL, p.norm1_g + 2048, mod + 5 * 12288, 0, 1, hbuf);
        ctx_norm_partial_phase(xres + (size_t)TL * 2048, p.norm1_g + 2048, mod + 5 * 12288, 0, 1, hbuf, (const float*)cat, 4, mod + 4 * 12288 + 5 * 2048);
      } else norm_mod_phase(xres, xres + (size_t)TL * 2048, TA, p.norm1_g + 2048, mod + 5 * 12288, 0, 1, hbuf);
      break;
    case 9: {
      EpiStore e{(h16*)(ws + OFF_P1), 2048};
      run_gemm(smem, hbuf, (const h16*)(ws + OFF_WT_IN_CD), TA, 2048, 2048, e);
      if (!dummy && gridDim.x == 256 && lbid() >= 32) prep_ffn(p, 1, (float*)smem, lbid() - 32, 224);
      else if (!dummy && gridDim.x != 256) prep_ffn(p, 1, (float*)smem, lbid(), (int)gridDim.x);
    } break;
    case 10: l1_prep_phase(p); break;
    case 11: {
      EpiQ1 eq{(h16*)(ws + OFF_Q1)};
      run_gemm(smem, (const h16*)(ws + OFF_CQN), (const h16*)(ws + OFF_WT_UQ), TL, 2304, 768, eq);
      EpiKV1 ek{(h16*)(ws + OFF_KN), (h16*)(ws + OFF_VT1)};
      run_gemm(smem, (const h16*)(ws + OFF_CKVN), (const h16*)(ws + OFF_WT_UKV), TA, 3072, 512, ek, (int)((lbid() + gridDim.x - 64) % gridDim.x));
    } break;
    case 12: {
      if (gridDim.x == 256) {
        const int xcd = lbid() & 7, slot = lbid() >> 3;
        for (int i = 0; i < 3; ++i) mla_unit<0>(p, (xcd * 6 + i * 2 + (slot >> 4)) * 16 + (slot & 15), smem);
      } else {
        for (int u = lbid(); u < 768; u += gridDim.x) mla_unit<0>(p, u, smem);
      }
    } break;
#ifdef MLA_PROBE_VAR
    case 112: {
      const int xcd = lbid() & 7, slot = lbid() >> 3;
      for (int i = 0; i < 3; ++i) mla_unit<MLA_PROBE_VAR>(p, (xcd * 6 + i * 2 + (slot >> 4)) * 16 + (slot & 15), smem);
    } break;
#endif
    case 13: {
      EpiRes<h16> e{xres, xres + (size_t)TL * 2048, xout, mod + 5 * 12288 + 2 * 2048};
      run_gemm(smem, cat, (const h16*)(ws + OFF_WT_OUT_CD), TL, 2048, 2048, e);
    } break;
    case 14: norm_mod_phase(xres, xres + (size_t)TL * 2048, TL, p.norm2_g + 2048, mod + 5 * 12288, 3, 4, hbuf); break;
    case 15: {
      EpiGU e{act};
      run_gemm(smem, hbuf, (const h16*)(ws + OFF_WT_GU1), TL, 11264, 2048, e);
    } break;
    case 16: {
      EpiRes<h16> e{xres, xres + (size_t)TL * 2048, xout, mod + 5 * 12288 + 5 * 2048};
      run_gemm(smem, act, (const h16*)(ws + OFF_WT_D1), TL, 2048, DFF, e);
    } break;
    case 17: final_norm_phase(xres, p.final_g, p.out); break;
    default: break;
  }
}

__global__ void __launch_bounds__(512, 2) mega_kernel(Params p, int ph_lo, int ph_hi) {
  extern __shared__ __attribute__((aligned(16))) unsigned char shm[];
  h16* smem = (h16*)shm;
  unsigned* barw = (unsigned*)(p.ws + OFF_BAR);
  if (threadIdx.x == 0) {
    const unsigned x = xb_xcc_id();
    const unsigned r = xb_add(&barw[XCD_BAR_WORDS + (x & 15u)], 1u);
    g_sh[0] = make_uint4(0u, 0u, 0u, 0u);
    g_sh[1] = make_uint4(blockIdx.x, r, x, 0u);
  }
  __syncthreads();
  const XcdBarrier xb = xcd_barrier_post(barw, (volatile __attribute__((address_space(3))) unsigned*)&g_sh[0]);
#ifdef ONLY_PHASE
  run_phase(p, ONLY_PHASE, smem);
#else
#pragma unroll
  for (int ph = 0; ph < NPHASE; ++ph) {
    if (ph >= ph_lo && ph < ph_hi) {
      run_phase(p, ph, smem);
      if ((REPEAT_MASK >> ph) & 1) {
        xcd_barrier(xb);
        if (ph == 3) { if (blockIdx.x == 0 && threadIdx.x < 8) ((int*)(p.ws + OFF_CTR))[threadIdx.x * 8] = 0; xcd_barrier(xb); }
#ifdef MLA_PROBE_VAR
        run_phase(p, ph == 12 ? 112 : ph, smem, true);
#else
        run_phase(p, ph, smem, true);
#endif
      }
      if (ph + 1 < ph_hi) { if (ph_hi > 1000) cg::this_grid().sync(); else xcd_barrier(xb); }
      if (ph == 0) {
        if (threadIdx.x == 0) {
          bool ok = (gridDim.x == 256);
#pragma unroll
          for (unsigned j = 0; j < 16; ++j) { const unsigned cnt = xb_ld(&barw[XB_XCNT(j)]); ok = ok && (cnt == (j < 8 ? 32u : 0u)); }
          const uint4 me = g_sh[1];
          if (ok && me.z < 8u && me.y < 32u) g_sh[1].x = me.y * 8u + me.z;
        }
        __syncthreads();
      }
    }
  }
#ifdef EXTRA_SYNCS
  for (int i = 0; i < EXTRA_SYNCS; ++i) xcd_barrier(xb);
#endif
#endif
}

extern "C" void kernel_launch(void* const* d_in, const int* in_sizes, int n_in, void* d_out, int out_size, void* d_ws,
                              size_t ws_size, hipStream_t stream) {
  if (ws_size < WS_NEEDED) {
    fprintf(stderr, "workspace too small: have %zu need %zu\n", ws_size, (size_t)WS_NEEDED);
    return;
  }
  static int grid_blocks = 0;
  if (!grid_blocks) {
    int dev = 0, cus = 0, per_cu = 0;
    (void)hipGetDevice(&dev);
    (void)hipDeviceGetAttribute(&cus, hipDeviceAttributeMultiprocessorCount, dev);
    (void)hipFuncSetAttribute((const void*)mega_kernel, hipFuncAttributeMaxDynamicSharedMemorySize, SMEM_BYTES);
    (void)hipOccupancyMaxActiveBlocksPerMultiprocessor(&per_cu, mega_kernel, NTHR, SMEM_BYTES);
    if (per_cu > 1) per_cu = 1;
    grid_blocks = cus * per_cu;
  }
  Params p{};
  const float** pf = (const float**)&p;
  for (int i = 0; i < 24; ++i) pf[i] = (const float*)d_in[i];
  p.out = (float*)d_out;
  p.ws = (char*)d_ws;
  int lo = 0, hi = NPHASE;
  (void)hipMemsetAsync((char*)d_ws + OFF_BAR, 0, BAR_BYTES, stream);
  void* args[] = {&p, &lo, &hi};
  hipError_t e = hipLaunchCooperativeKernel((void*)mega_kernel, dim3(grid_blocks), dim3(NTHR), args, SMEM_BYTES, stream);
  if (e != hipSuccess) fprintf(stderr, "cooperative launch failed: %s (grid %d)\n", hipGetErrorString(e), grid_blocks);
}
```
